# Optimizing an MI355X kernel written in HIP

```python
import jax, jax.numpy as jnp
from jax import lax
import numpy as np

D_MODEL = 2048
BATCH = 4
SEQ = 2048
DEPTH = 2

D_FF = 5632
SSD_HEADS = 32
SSD_HEAD_DIM = 64
SSD_D = SSD_HEADS * SSD_HEAD_DIM
SSD_GROUPS = 8
SSD_STATE = 128
SSD_CONV = 4
SSD_CHUNK = 128
SSD_XBC = SSD_D + 2 * SSD_GROUPS * SSD_STATE
RET_HEADS = 8
RET_QK_DIM = 256
RET_V_DIM = 256
RET_D = RET_HEADS * RET_V_DIM
RET_CHUNK = 128
RET_THETA = 10000.0
ATT_HEADS = 16
ATT_HEAD_DIM = 128
IDX_HEADS = 16
IDX_DIM = 64
TOPK_MAX = 256
Q_BLOCK = 128
ROPE_THETA = 500000.0
ROPE_FRACTION = 4
EPS = 1e-6

IN0_WIDTHS = (SSD_D, SSD_XBC, SSD_HEADS, RET_HEADS * RET_QK_DIM, RET_HEADS * RET_QK_DIM, RET_D, RET_D)
IN0 = sum(IN0_WIDTHS)
IN1_WIDTHS = (ATT_HEADS * ATT_HEAD_DIM, ATT_HEAD_DIM, ATT_HEAD_DIM, IDX_HEADS * IDX_DIM, IDX_DIM, IDX_HEADS)
IN1 = sum(IN1_WIDTHS)
N_EVEN = (DEPTH + 1) // 2
N_ODD = DEPTH // 2

kernel_name = "hybrid_ssd_retention_dsa_macaron_adaln"


def split_cols(a, widths):
    return jnp.split(a, [int(o) for o in np.cumsum(widths)[:-1]], axis=-1)


def rms_norm(x, w):
    xf = x.astype(jnp.float32)
    y = xf * lax.rsqrt(jnp.mean(xf * xf, axis=-1, keepdims=True) + EPS)
    return (y * w.astype(jnp.float32)).astype(x.dtype)


def rope(x, positions, rot_dim, theta):
    half = rot_dim // 2
    inv = theta ** (-jnp.arange(half, dtype=jnp.float32) / half)
    ang = positions.astype(jnp.float32)[..., None] * inv
    cos, sin = jnp.cos(ang)[:, :, None, :], jnp.sin(ang)[:, :, None, :]
    xr = x[..., :rot_dim].astype(jnp.float32)
    x1, x2 = xr[..., :half], xr[..., half:]
    rot = jnp.concatenate([x1 * cos - x2 * sin, x1 * sin + x2 * cos], axis=-1).astype(x.dtype)
    return jnp.concatenate([rot, x[..., rot_dim:]], axis=-1)


def swiglu(h, w_gate, w_up, w_down):
    return (jax.nn.silu(h @ w_gate) * (h @ w_up)) @ w_down


def causal_depthwise_conv(u, w, b):
    ch = u.shape[-1]
    out = lax.conv_general_dilated(u, w[:, None, :], (1,), [(w.shape[0] - 1, 0)],
                                   dimension_numbers=('NWC', 'WIO', 'NWC'), feature_group_count=ch)
    return out + b


def ssd_mixer(z, xbc, dt_raw, conv_w, conv_b, A_log, dt_bias, D_skip, norm_w):
    Bsz, L, _ = xbc.shape
    Q, G, R, P, N = SSD_CHUNK, SSD_GROUPS, SSD_HEADS // SSD_GROUPS, SSD_HEAD_DIM, SSD_STATE
    NC = L // Q
    xbc = jax.nn.silu(causal_depthwise_conv(xbc, conv_w, conv_b))
    xs, Bm, Cm = split_cols(xbc, (SSD_D, G * N, G * N))
    xs = xs.reshape(Bsz, NC, Q, G, R, P)
    Bm = Bm.reshape(Bsz, NC, Q, G, N)
    Cm = Cm.reshape(Bsz, NC, Q, G, N)
    dt = jax.nn.softplus(dt_raw.astype(jnp.float32) + dt_bias.astype(jnp.float32))
    A = -jnp.exp(A_log.astype(jnp.float32))
    dA = (dt * A).reshape(Bsz, NC, Q, G, R)
    dt = dt.reshape(Bsz, NC, Q, G, R)
    cum = jnp.cumsum(dA, axis=2)
    xdt = xs * dt[..., None]
    seg = cum[:, :, :, None] - cum[:, :, None, :]
    causal = jnp.tril(jnp.ones((Q, Q), dtype=bool))[:, :, None, None]
    decay = jnp.exp(jnp.where(causal, seg, -jnp.inf))
    CB = jnp.einsum('bclgn,bcsgn->bclsg', Cm, Bm)
    y_diag = jnp.einsum('bclsg,bclsgr,bcsgrp->bclgrp', CB, decay, xdt)
    decay_s = jnp.exp(cum[:, :, -1:] - cum)
    states = jnp.einsum('bcsgn,bcsgr,bcsgrp->bcgrpn', Bm, decay_s, xdt)
    chunk_decay = jnp.exp(cum[:, :, -1])

    def step(h, inp):
        s_c, a_c = inp
        return h * a_c[..., None, None] + s_c, h

    h0 = jnp.zeros((Bsz, G, R, P, N), jnp.float32)
    _, h_prev = lax.scan(step, h0, (jnp.moveaxis(states, 1, 0), jnp.moveaxis(chunk_decay, 1, 0)))
    h_prev = jnp.moveaxis(h_prev, 0, 1)
    y_off = jnp.einsum('bclgn,bcgrpn,bclgr->bclgrp', Cm, h_prev, jnp.exp(cum))
    y = y_diag + y_off + xs * D_skip.reshape(G, R)[:, :, None].astype(jnp.float32)
    y = y.reshape(Bsz, L, SSD_D)
    y = rms_norm(y * jax.nn.silu(z.astype(jnp.float32)), norm_w)
    return y.astype(z.dtype)


def retention_mixer(q, k, v, g, positions, norm_w):
    Bsz, L, _ = q.shape
    H, Q = RET_HEADS, RET_CHUNK
    NC = L // Q
    q = rope(q.reshape(Bsz, L, H, RET_QK_DIM), positions, RET_QK_DIM, RET_THETA)
    k = rope(k.reshape(Bsz, L, H, RET_QK_DIM), positions, RET_QK_DIM, RET_THETA) * (RET_QK_DIM ** -0.5)
    v = v.reshape(Bsz, L, H, RET_V_DIM)
    q = q.reshape(Bsz, NC, Q, H, RET_QK_DIM)
    k = k.reshape(Bsz, NC, Q, H, RET_QK_DIM)
    v = v.reshape(Bsz, NC, Q, H, RET_V_DIM)
    log_gamma = jnp.log(1.0 - 2.0 ** (-5.0 - jnp.arange(H, dtype=jnp.float32)))
    idx = jnp.arange(Q, dtype=jnp.float32)
    dist = idx[:, None] - idx[None, :]
    intra = jnp.exp(jnp.where(dist[..., None] >= 0, dist[..., None] * log_gamma, -jnp.inf))
    scores = jnp.einsum('bclhd,bcshd->bchls', q, k) * jnp.transpose(intra, (2, 0, 1))
    y_intra = jnp.einsum('bchls,bcshv->bclhv', scores, v)
    k_dec = jnp.exp((Q - 1 - idx)[:, None] * log_gamma)
    states = jnp.einsum('bcshd,sh,bcshv->bchdv', k, k_dec, v)
    chunk_decay = jnp.exp(Q * log_gamma)

    def step(r, s_c):
        return r * chunk_decay[:, None, None] + s_c, r

    r0 = jnp.zeros((Bsz, H, RET_QK_DIM, RET_V_DIM), jnp.float32)
    _, r_prev = lax.scan(step, r0, jnp.moveaxis(states, 1, 0))
    r_prev = jnp.moveaxis(r_prev, 0, 1)
    q_dec = jnp.exp((idx + 1)[:, None] * log_gamma)
    y_inter = jnp.einsum('bclhd,lh,bchdv->bclhv', q, q_dec, r_prev)
    y = (y_intra + y_inter).reshape(Bsz, L, H, RET_V_DIM)
    y = rms_norm(y, norm_w.reshape(H, RET_V_DIM)).reshape(Bsz, L, RET_D)
    return (jax.nn.silu(g.astype(jnp.float32)) * y).astype(g.dtype)


def dsa_mixer(proj, positions, idx_k_norm_w):
    Bsz, L, _ = proj.shape
    q, k, v, qi, ki, wi = split_cols(proj, IN1_WIDTHS)
    rot = ATT_HEAD_DIM // ROPE_FRACTION
    rot_i = IDX_DIM // ROPE_FRACTION
    q = rope(q.reshape(Bsz, L, ATT_HEADS, ATT_HEAD_DIM), positions, rot, ROPE_THETA)
    k = rope(k[:, :, None, :], positions, rot, ROPE_THETA)[:, :, 0]
    qi = rope(qi.reshape(Bsz, L, IDX_HEADS, IDX_DIM), positions, rot_i, ROPE_THETA)
    ki = rope(rms_norm(ki, idx_k_norm_w)[:, :, None, :], positions, rot_i, ROPE_THETA)[:, :, 0]
    wi = wi * (IDX_HEADS ** -0.5) * (IDX_DIM ** -0.5)
    kv = jnp.concatenate([k, v], axis=-1)
    topk = min(TOPK_MAX, L // 4)
    nb = L // Q_BLOCK
    key_pos = jnp.arange(L)

    def to_blocks(a):
        return jnp.swapaxes(a.reshape(Bsz, nb, Q_BLOCK, *a.shape[2:]), 0, 1)

    def block(args):
        qb, qib, wib, start = args
        q_pos = start + jnp.arange(Q_BLOCK)
        s = jax.nn.relu(jnp.einsum('bqhd,bsd->bqhs', qib, ki).astype(jnp.float32))
        score = jnp.einsum('bqhs,bqh->bqs', s, wib.astype(jnp.float32))
        visible = key_pos[None, :] <= q_pos[:, None]
        score = jnp.where(visible[None], score, -jnp.inf)
        _, sel = lax.top_k(score, topk)
        kv_sel = jax.vmap(lambda kvb, ib: kvb[ib])(kv, sel)
        k_sel, v_sel = kv_sel[..., :ATT_HEAD_DIM], kv_sel[..., ATT_HEAD_DIM:]
        logits = jnp.einsum('bqhd,bqkd->bqhk', qb, k_sel).astype(jnp.float32) * (ATT_HEAD_DIM ** -0.5)
        valid = sel <= q_pos[None, :, None]
        logits = jnp.where(valid[:, :, None, :], logits, -jnp.inf)
        p = jax.nn.softmax(logits, axis=-1).astype(v_sel.dtype)
        return jnp.einsum('bqhk,bqkd->bqhd', p, v_sel)

    starts = jnp.arange(nb) * Q_BLOCK
    out = lax.map(block, (to_blocks(q), to_blocks(qi), to_blocks(wi), starts))
    return jnp.swapaxes(out, 0, 1).reshape(Bsz, L, ATT_HEADS * ATT_HEAD_DIM)


def modulated_sublayer(x, mods, j, pre_w, post_w, fn, res_weight):
    shift, scale, gate = (mods[..., (3 * j + m) * D_MODEL:(3 * j + m + 1) * D_MODEL] for m in range(3))
    h = rms_norm(x, pre_w) * (1 + scale) + shift
    y = rms_norm(fn(h), post_w)
    return x + res_weight * gate * y


def setup_inputs(seed: int = 0) -> dict:
    key = jax.random.key(seed)
    ks = jax.random.split(key, 24)
    f32 = jnp.float32

    def nrm(k, shape, fan_in, gain=1.0):
        return jax.random.normal(k, shape, f32) * (gain * fan_in ** -0.5)

    def gain(k, shape):
        return 1.0 + 0.05 * jax.random.normal(k, shape, f32)

    x = jax.random.normal(ks[0], (BATCH, SEQ, D_MODEL), f32)
    c = jax.random.normal(ks[1], (BATCH, D_MODEL), f32)
    offset = jax.random.randint(ks[2], (BATCH, 1), 0, 4096, dtype=jnp.int32)
    positions = (jnp.arange(SEQ, dtype=jnp.int32)[None, :] + offset).astype(jnp.int32)
    mod_w = nrm(ks[3], (DEPTH, D_MODEL, 9 * D_MODEL), D_MODEL, 0.5)
    mod_b = 0.01 * jax.random.normal(ks[4], (DEPTH, 9 * D_MODEL), f32)
    norm_w = gain(ks[5], (DEPTH, 6, D_MODEL))
    ffn_w_gate = nrm(ks[6], (DEPTH, 2, D_MODEL, D_FF), D_MODEL)
    ffn_w_up = nrm(ks[7], (DEPTH, 2, D_MODEL, D_FF), D_MODEL)
    ffn_w_down = nrm(ks[8], (DEPTH, 2, D_FF, D_MODEL), D_FF)
    hy_w_in = nrm(ks[9], (N_EVEN, D_MODEL, IN0), D_MODEL)
    hy_conv_w = nrm(ks[10], (N_EVEN, SSD_CONV, SSD_XBC), SSD_CONV)
    hy_conv_b = 0.05 * jax.random.normal(ks[11], (N_EVEN, SSD_XBC), f32)
    ssd_A_log = jnp.log(jax.random.uniform(ks[12], (N_EVEN, SSD_HEADS), f32, 1.0, 16.0))
    dt0 = jnp.exp(jax.random.uniform(ks[13], (N_EVEN, SSD_HEADS), f32, np.log(1e-3), np.log(1e-1)))
    ssd_dt_bias = dt0 + jnp.log(-jnp.expm1(-dt0))
    ssd_D = 1.0 + 0.1 * jax.random.normal(ks[14], (N_EVEN, SSD_HEADS), f32)
    ssd_norm_w = gain(ks[15], (N_EVEN, SSD_D))
    ret_norm_w = gain(ks[16], (N_EVEN, RET_D))
    hy_w_out = nrm(ks[17], (N_EVEN, SSD_D + RET_D, D_MODEL), SSD_D + RET_D)
    dsa_w_in = nrm(ks[18], (N_ODD, D_MODEL, IN1), D_MODEL)
    idx_k_norm_w = gain(ks[19], (N_ODD, IDX_DIM))
    dsa_w_out = nrm(ks[20], (N_ODD, ATT_HEADS * ATT_HEAD_DIM, D_MODEL), ATT_HEADS * ATT_HEAD_DIM)
    return {"x": x, "c": c, "positions": positions, "mod_w": mod_w, "mod_b": mod_b, "norm_w": norm_w,
            "ffn_w_gate": ffn_w_gate, "ffn_w_up": ffn_w_up, "ffn_w_down": ffn_w_down,
            "hy_w_in": hy_w_in, "hy_conv_w": hy_conv_w, "hy_conv_b": hy_conv_b, "ssd_A_log": ssd_A_log,
            "ssd_dt_bias": ssd_dt_bias, "ssd_D": ssd_D, "ssd_norm_w": ssd_norm_w, "ret_norm_w": ret_norm_w,
            "hy_w_out": hy_w_out, "dsa_w_in": dsa_w_in, "idx_k_norm_w": idx_k_norm_w, "dsa_w_out": dsa_w_out}


def reference(x, c, positions, mod_w, mod_b, norm_w, ffn_w_gate, ffn_w_up, ffn_w_down,
              hy_w_in, hy_conv_w, hy_conv_b, ssd_A_log, ssd_dt_bias, ssd_D, ssd_norm_w, ret_norm_w,
              hy_w_out, dsa_w_in, idx_k_norm_w, dsa_w_out):
    cond = jax.nn.silu(c)
    for i in range(DEPTH):
        mods = (cond @ mod_w[i] + mod_b[i])[:, None, :]

        def ffn(h, f, i=i):
            return swiglu(h, ffn_w_gate[i, f], ffn_w_up[i, f], ffn_w_down[i, f])

        if i % 2 == 0:
            e = i // 2

            def mixer(h, e=e):
                proj = h @ hy_w_in[e]
                z, xbc, dt_raw, rq, rk, rv, rg = split_cols(proj, IN0_WIDTHS)
                ya = ssd_mixer(z, xbc, dt_raw, hy_conv_w[e], hy_conv_b[e], ssd_A_log[e],
                               ssd_dt_bias[e], ssd_D[e], ssd_norm_w[e])
                yb = retention_mixer(rq, rk, rv, rg, positions, ret_norm_w[e])
                return jnp.concatenate([ya.astype(h.dtype), yb.astype(h.dtype)], axis=-1) @ hy_w_out[e]
        else:
            o = i // 2

            def mixer(h, o=o):
                return dsa_mixer(h @ dsa_w_in[o], positions, idx_k_norm_w[o]) @ dsa_w_out[o]

        x = modulated_sublayer(x, mods, 0, norm_w[i, 0], norm_w[i, 1], lambda h: ffn(h, 0), 0.5)
        x = modulated_sublayer(x, mods, 1, norm_w[i, 2], norm_w[i, 3], mixer, 1.0)
        x = modulated_sublayer(x, mods, 2, norm_w[i, 4], norm_w[i, 5], lambda h: ffn(h, 1), 0.5)
    return x
```

```cpp
#include <hip/hip_runtime.h>
#include <cstdio>
#include <cstdint>
namespace pg8 {
#define PG8_LAS __attribute__((address_space(3)))
typedef unsigned short bf16_t;
typedef short bf16x8 __attribute__((ext_vector_type(8)));
typedef float f32x4 __attribute__((ext_vector_type(4)));
typedef unsigned u32x4 __attribute__((ext_vector_type(4)));
constexpr int BM = 256, BK = 64, HALF = 128, HTB = HALF * BK * 2  , STAGE_BYTES = 8 * HTB, NXCD = 8, WGM = 8;

__host__ __device__ __forceinline__ int lds_byte(int r, int c) { const int st = (r >> 4) * 2 + (c >> 5), rr = r & 15, cc = c & 31, ob = rr * 64 + cc * 2; return st * 1024 + (ob ^ (((ob >> 9) & 1) << 5)); }
__host__ __device__ __forceinline__ void stage_rc(int b, int& R, int& C) { const int st = b / 1024, sb = b % 1024, swz = sb ^ (((sb >> 9) & 1) << 5); R = (st >> 1) * 16 + swz / 64; C = (st & 1) * 32 + (swz % 64) / 2; }
__host__ __device__ __forceinline__ int perm32(int rho) { const int n = rho >> 4, i = rho & 15; return 8 * (i >> 2) + 4 * n + (i & 3); }

struct Unit { int pm, pn; };
struct Gemm { const bf16_t* A; const bf16_t* Bt; int M, N, K; };

struct StaticOrder {
    int nM, nN, nwg, G, c;
    __host__ __device__ void init(int M, int N, int G_, int c_) { nM = M / BM; nN = N / BM; nwg = nM * nN; G = G_; c = c_; }
    __host__ __device__ bool next(int i, Unit& u) const {
        const long L = (long)i * G + c; if (L >= nwg) return false;
        int wgid = (int)L; { const int q = nwg / NXCD, r = nwg % NXCD, xcd = wgid % NXCD, off = wgid / NXCD; wgid = (xcd < r ? xcd * (q + 1) : r * (q + 1) + (xcd - r) * q) + off; }
        const int nig = WGM * nN, gid = wgid / nig, fm = gid * WGM, gsz = (nM - fm) < WGM ? (nM - fm) : WGM;
        u.pm = fm + ((wgid % nig) % gsz); u.pn = (wgid % nig) / gsz; return true;
    }
    __device__ __forceinline__ void a_ready(const Unit&) const {}
    __device__ __forceinline__ void done(const Unit&) const {}
};

__device__ __forceinline__ unsigned cvt_pk_bf16(float lo, float hi) { unsigned r; asm volatile("v_cvt_pk_bf16_f32 %0, %1, %2" : "=v"(r) : "v"(lo), "v"(hi)); return r; }
typedef float f32x2 __attribute__((ext_vector_type(2)));
__device__ __forceinline__ float silu_f(float v) { return v * __builtin_amdgcn_rcpf(1.0f + __expf(-v)); }

struct EpiGateUp {
    static constexpr bool PERM = true, AFTER_DRAIN = false;
    bf16_t* O; int ldc;
    __device__ __forceinline__ void operator()(const f32x4 (&acc)[2][2][4][2], const Unit& u, int wr, int wc, int fr, int fq) const {
        const int row0 = u.pm * BM + wr * 64 + fr, col0 = u.pn * HALF + wc * 32 + 8 * fq;
#pragma unroll
        for (int ai = 0; ai < 2; ++ai)
#pragma unroll
            for (int m = 0; m < 4; ++m) { bf16_t* rowp = O + (size_t)(row0 + ai * HALF + m * 16) * ldc + col0;
                const f32x4 g0 = acc[ai][0][m][0], g1 = acc[ai][0][m][1], u0 = acc[ai][1][m][0], u1 = acc[ai][1][m][1];
                f32x4 v0, v1;
#pragma unroll
                for (int j = 0; j < 4; ++j) { v0[j] = silu_f(g0[j]) * u0[j]; v1[j] = silu_f(g1[j]) * u1[j]; }
                u32x4 w; w.x = cvt_pk_bf16(v0[0], v0[1]); w.y = cvt_pk_bf16(v0[2], v0[3]); w.z = cvt_pk_bf16(v1[0], v1[1]); w.w = cvt_pk_bf16(v1[2], v1[3]);
                *(u32x4*)rowp = w; }
    }
};
struct EpiYSsq {
    static constexpr bool PERM = false, AFTER_DRAIN = false;
    float* C; int ldc; float* ssq;
    __device__ __forceinline__ void operator()(const f32x4 (&acc)[2][2][4][2], const Unit& u, int wr, int wc, int fr, int fq) const {
        const int row0 = u.pm * BM + wr * 64 + fr, col0 = u.pn * BM + wc * 32 + 4 * fq;
#pragma unroll
        for (int ai = 0; ai < 2; ++ai)
#pragma unroll
            for (int m = 0; m < 4; ++m) { const int row = row0 + ai * HALF + m * 16; float* rowp = C + (size_t)row * ldc + col0; float s = 0.f;
#pragma unroll
                for (int bj = 0; bj < 2; ++bj)
#pragma unroll
                    for (int n = 0; n < 2; ++n) { const f32x4 v = acc[ai][bj][m][n]; *(f32x4*)(rowp + bj * HALF + n * 16) = v; s += (v[0] * v[0] + v[1] * v[1]) + (v[2] * v[2] + v[3] * v[3]); }
                s += __shfl_xor(s, 16); s += __shfl_xor(s, 32);
                if (fq == 0) ssq[(size_t)row * 32 + u.pn * 4 + wc] = s; }
    }
};
struct EpiProj {
    static constexpr bool PERM = true, AFTER_DRAIN = false;
    bf16_t* O; int ldo; int nbf; float* Fo; int ldf;
    __device__ __forceinline__ void operator()(const f32x4 (&acc)[2][2][4][2], const Unit& u, int wr, int wc, int fr, int fq) const {
        const int row0 = u.pm * BM + wr * 64 + fr;
        if (u.pn < nbf) {
            const int col0 = u.pn * BM + wc * 32 + 8 * fq;
#pragma unroll
            for (int ai = 0; ai < 2; ++ai)
#pragma unroll
                for (int m = 0; m < 4; ++m) { bf16_t* rowp = O + (size_t)(row0 + ai * HALF + m * 16) * ldo + col0;
#pragma unroll
                    for (int bj = 0; bj < 2; ++bj) { const f32x4 v0 = acc[ai][bj][m][0], v1 = acc[ai][bj][m][1];
                        u32x4 w; w.x = cvt_pk_bf16(v0[0], v0[1]); w.y = cvt_pk_bf16(v0[2], v0[3]); w.z = cvt_pk_bf16(v1[0], v1[1]); w.w = cvt_pk_bf16(v1[2], v1[3]);
                        *(u32x4*)(rowp + bj * HALF) = w; } }
        } else {
            const int col0 = (u.pn - nbf) * BM + wc * 32 + 8 * fq;
#pragma unroll
            for (int ai = 0; ai < 2; ++ai)
#pragma unroll
                for (int m = 0; m < 4; ++m) { float* rowp = Fo + (size_t)(row0 + ai * HALF + m * 16) * ldf + col0;
#pragma unroll
                    for (int bj = 0; bj < 2; ++bj) { *(f32x4*)(rowp + bj * HALF) = acc[ai][bj][m][0]; *(f32x4*)(rowp + bj * HALF + 4) = acc[ai][bj][m][1]; } }
        }
    }
};
template <class Epi, class Sched, bool ALIGN_EPI = false, bool SP2 = false>
__device__ __forceinline__ void gemm_phase(PG8_LAS unsigned char* lds, const Gemm g, const Sched& S, const Epi& E) {
    int tid_ = threadIdx.x; asm volatile("" : "+v"(tid_));
    const int tid = tid_, wid = __builtin_amdgcn_readfirstlane(tid >> 6), lane = tid & 63, wr = wid >> 2, wc = wid & 3, fr = lane & 15, fq = lane >> 4;
    const int K = g.K, nt = K / BK;
    unsigned voffA[2], voffB[2];
#pragma unroll
    for (int i = 0; i < 2; ++i) { int R, C; stage_rc(tid * 16 + i * 8192, R, C); const int Rb = Epi::PERM ? ((R & ~31) + perm32(R & 31)) : R;
        voffA[i] = (unsigned)(R * K + C) * 2u; voffB[i] = (unsigned)(Rb * K + C) * 2u; }
    const size_t kstep = (size_t)(BK * 2);
    const size_t hstep = (size_t)HALF * K * 2;
    const size_t tstep = 2 * hstep;
    const unsigned ldsw = (unsigned)wid * 1024u;
    const int aoff = lds_byte(wr * 64 + fr, fq * 8), boff = lds_byte(wc * 32 + fr, fq * 8);
#define PG8_SA(b, h) (((b) * 2 + (h)) * HTB)
#define PG8_SB(b, h) ((4 + (b) * 2 + (h)) * HTB)
#define PG8_STAGE(bufoff, gbase, voff) do { _Pragma("unroll") for (int _i = 0; _i < 2; ++_i) \
        __builtin_amdgcn_global_load_lds((const unsigned*)((const char*)(gbase) + (voff)[_i]), (PG8_LAS unsigned*)(lds + (bufoff) + ldsw + _i * 8192), 16, 0, 0); } while (0)
#define PG8_LDA(dst, b, h) do { _Pragma("unroll") for (int m = 0; m < 4; ++m) _Pragma("unroll") for (int k = 0; k < 2; ++k) dst[m][k] = *(const PG8_LAS bf16x8*)(lds + PG8_SA(b, h) + aoff + m * 2048 + k * 1024); } while (0)
#define PG8_LDB(dst, b, h) do { _Pragma("unroll") for (int n = 0; n < 2; ++n) _Pragma("unroll") for (int k = 0; k < 2; ++k) dst[n][k] = *(const PG8_LAS bf16x8*)(lds + PG8_SB(b, h) + boff + n * 2048 + k * 1024); } while (0)
#define PG8_MMA(ai, bj, At, Bt) do { __builtin_amdgcn_s_setprio(1); _Pragma("unroll") for (int m = 0; m < 4; ++m) _Pragma("unroll") for (int n = 0; n < 2; ++n) _Pragma("unroll") for (int k = 0; k < 2; ++k) \
        acc[ai][bj][m][n] = __builtin_amdgcn_mfma_f32_16x16x32_bf16(Bt[n][k], At[m][k], acc[ai][bj][m][n], 0, 0, 0); __builtin_amdgcn_s_setprio(0); } while (0)
#define PG8_WAIT_V(n) asm volatile("s_waitcnt vmcnt(" #n ")" ::: "memory")
#define PG8_WAIT_L(n) asm volatile("s_waitcnt lgkmcnt(" #n ")" ::: "memory")
#define PG8_BAR __builtin_amdgcn_s_barrier()
#define PG8_SCHED __builtin_amdgcn_sched_barrier(0)
    Unit cur, nxt; int ui = 0;
    if (!S.next(0, cur)) return;
    f32x4 acc[2][2][4][2];
#pragma unroll
    for (int a = 0; a < 2; ++a)
#pragma unroll
        for (int b = 0; b < 2; ++b)
#pragma unroll
            for (int m = 0; m < 4; ++m)
#pragma unroll
                for (int n = 0; n < 2; ++n) acc[a][b][m][n] = (f32x4){0.f, 0.f, 0.f, 0.f};
    bf16x8 At[4][2], B0[2][2], B1[2][2];
    const char* cA = (const char*)g.A + (size_t)cur.pm * tstep; const char* cB = (const char*)g.Bt + (size_t)cur.pn * tstep;
    S.a_ready(cur);
    if constexpr (SP2) {
        PG8_STAGE(PG8_SB(0, 0), cB, voffB); PG8_STAGE(PG8_SB(0, 1), cB + hstep, voffB); PG8_STAGE(PG8_SA(0, 0), cA, voffA); PG8_STAGE(PG8_SA(0, 1), cA + hstep, voffA);
        if (wr == 1) PG8_BAR;
        PG8_WAIT_V(2); PG8_BAR;
        PG8_STAGE(PG8_SB(1, 0), cB + kstep, voffB); PG8_STAGE(PG8_SA(1, 0), cA + kstep, voffA); PG8_STAGE(PG8_SB(1, 1), cB + hstep + kstep, voffB);
        PG8_WAIT_V(6); PG8_BAR;
    } else {
        PG8_STAGE(PG8_SB(0, 0), cB, voffB); PG8_STAGE(PG8_SA(0, 0), cA, voffA); PG8_STAGE(PG8_SB(0, 1), cB + hstep, voffB); PG8_STAGE(PG8_SA(0, 1), cA + hstep, voffA);
        if (wr == 1) PG8_BAR;
        PG8_WAIT_V(4); PG8_BAR;
        PG8_STAGE(PG8_SB(1, 0), cB + kstep, voffB); PG8_STAGE(PG8_SA(1, 0), cA + kstep, voffA); PG8_STAGE(PG8_SB(1, 1), cB + hstep + kstep, voffB);
        PG8_WAIT_V(6); PG8_BAR;
    }
    for (;;) {
        const bool has_next = S.next(ui + 1, nxt);
        const char* nA = has_next ? (const char*)g.A + (size_t)nxt.pm * tstep : cA; const char* nB = has_next ? (const char*)g.Bt + (size_t)nxt.pn * tstep : cB;
        for (int t = 0; t < nt; t += 2) {
            const bool last = (t == nt - 2);
            const char* a1 = cA + (size_t)(t + 1) * kstep;
            const char* a2 = last ? nA : cA + (size_t)(t + 2) * kstep; const char* b2 = last ? nB : cB + (size_t)(t + 2) * kstep;
            const char* a3 = a2 + kstep; const char* b3 = b2 + kstep;
            if (last && has_next) S.a_ready(nxt);
            if constexpr (SP2) {
            PG8_LDB(B0, 0, 0); PG8_LDB(B1, 0, 1); PG8_SCHED; PG8_LDA(At, 0, 0); PG8_STAGE(PG8_SA(1, 1), a1 + hstep, voffA);
            PG8_WAIT_V(8); PG8_WAIT_L(0); PG8_BAR; PG8_MMA(0, 0, At, B0); PG8_MMA(0, 1, At, B1); PG8_BAR; PG8_SCHED;
            PG8_LDA(At, 0, 1); PG8_STAGE(PG8_SB(0, 0), b2, voffB); PG8_STAGE(PG8_SB(0, 1), b2 + hstep, voffB); PG8_STAGE(PG8_SA(0, 0), a2, voffA);
            PG8_WAIT_V(8); PG8_WAIT_L(0); PG8_BAR; PG8_MMA(1, 0, At, B0); PG8_MMA(1, 1, At, B1); PG8_BAR; PG8_SCHED;
            PG8_LDB(B0, 1, 0); PG8_LDB(B1, 1, 1); PG8_SCHED; PG8_LDA(At, 1, 0); PG8_STAGE(PG8_SA(0, 1), a2 + hstep, voffA);
            PG8_WAIT_V(8); PG8_WAIT_L(0); PG8_BAR; PG8_MMA(0, 0, At, B0); PG8_MMA(0, 1, At, B1); PG8_BAR; PG8_SCHED;
            PG8_LDA(At, 1, 1); PG8_STAGE(PG8_SB(1, 0), b3, voffB); PG8_STAGE(PG8_SB(1, 1), b3 + hstep, voffB); PG8_STAGE(PG8_SA(1, 0), a3, voffA);
            PG8_WAIT_V(8); PG8_WAIT_L(0); PG8_BAR; PG8_MMA(1, 0, At, B0); PG8_MMA(1, 1, At, B1); PG8_BAR; PG8_SCHED;
            } else {
            PG8_LDB(B0, 0, 0); PG8_SCHED; PG8_LDA(At, 0, 0); PG8_STAGE(PG8_SA(1, 1), a1 + hstep, voffA);
            PG8_WAIT_L(8); PG8_BAR; PG8_WAIT_L(0); PG8_MMA(0, 0, At, B0); PG8_BAR; PG8_SCHED;
            PG8_LDB(B1, 0, 1); PG8_STAGE(PG8_SB(0, 0), b2, voffB);
            PG8_BAR; PG8_WAIT_L(0); PG8_MMA(0, 1, At, B1); PG8_BAR;
            PG8_LDA(At, 0, 1); PG8_STAGE(PG8_SA(0, 0), a2, voffA);
            PG8_BAR; PG8_WAIT_L(0); PG8_MMA(1, 0, At, B0); PG8_BAR; PG8_SCHED;
            PG8_STAGE(PG8_SB(0, 1), b2 + hstep, voffB);
            PG8_WAIT_V(6); PG8_BAR; PG8_MMA(1, 1, At, B1); PG8_BAR;
            PG8_LDB(B0, 1, 0); PG8_SCHED; PG8_LDA(At, 1, 0); PG8_STAGE(PG8_SA(0, 1), a2 + hstep, voffA);
            PG8_WAIT_L(8); PG8_BAR; PG8_WAIT_L(0); PG8_MMA(0, 0, At, B0); PG8_BAR; PG8_SCHED;
            PG8_LDB(B1, 1, 1); PG8_STAGE(PG8_SB(1, 0), b3, voffB);
            PG8_BAR; PG8_WAIT_L(0); PG8_MMA(0, 1, At, B1); PG8_BAR;
            PG8_LDA(At, 1, 1); PG8_STAGE(PG8_SA(1, 0), a3, voffA);
            PG8_BAR; PG8_WAIT_L(0); PG8_MMA(1, 0, At, B0); PG8_BAR; PG8_SCHED;
            PG8_STAGE(PG8_SB(1, 1), b3 + hstep, voffB);
            PG8_WAIT_V(6); PG8_BAR; PG8_MMA(1, 1, At, B1); PG8_BAR;
            }
        }
        if constexpr (ALIGN_EPI) { if (wr == 0) PG8_BAR; }
        if constexpr (!Epi::AFTER_DRAIN) { E(acc, cur, wr, wc, fr, fq); S.done(cur); }
        if (!has_next) break;
#pragma unroll
        for (int a = 0; a < 2; ++a)
#pragma unroll
            for (int b = 0; b < 2; ++b)
#pragma unroll
                for (int m = 0; m < 4; ++m)
#pragma unroll
                    for (int n = 0; n < 2; ++n) acc[a][b][m][n] = (f32x4){0.f, 0.f, 0.f, 0.f};
        cur = nxt; cA = nA; cB = nB; ++ui;
        if constexpr (ALIGN_EPI) { if (wr == 1) PG8_BAR; }
    }
    PG8_WAIT_V(0);
    if constexpr (!ALIGN_EPI) { if (wr == 0) PG8_BAR; }
    PG8_BAR;
    if constexpr (Epi::AFTER_DRAIN) { E.fused(acc, cur, wr, wc, fr, fq, lds, wid, lane); S.done(cur); }
#undef PG8_SA
#undef PG8_SB
#undef PG8_STAGE
#undef PG8_LDA
#undef PG8_LDB
#undef PG8_MMA
#undef PG8_WAIT_V
#undef PG8_WAIT_L
#undef PG8_BAR
#undef PG8_SCHED
}
}
#define GAS __attribute__((address_space(1)))
#define LAS __attribute__((address_space(3)))
typedef unsigned short bf16;
typedef unsigned v4u __attribute__((ext_vector_type(4)));
typedef float f32x4 __attribute__((ext_vector_type(4)));
typedef short bf16x8 __attribute__((ext_vector_type(8)));
typedef GAS unsigned gu32;
typedef GAS unsigned long long gu64;
#define RLX_AGENT __ATOMIC_RELAXED, __HIP_MEMORY_SCOPE_AGENT
#define LDS_WAIT() asm volatile("s_waitcnt lgkmcnt(0)" ::: "memory")
#define VM_WAIT() asm volatile("s_waitcnt vmcnt(0)" ::: "memory")
__device__ __forceinline__ unsigned long long rt() { return __builtin_amdgcn_s_memrealtime(); }
__device__ __forceinline__ unsigned f2bf(float f) { unsigned u = __builtin_bit_cast(unsigned, f); return (u + 0x7fffu + ((u >> 16) & 1u)) >> 16; }
__device__ __forceinline__ unsigned pk2(float lo, float hi) { return f2bf(lo) | (f2bf(hi) << 16); }

#define XB_TMO      128
#define XB_XCNT(j)  (256  + 64 * (j))
#define XB_XSUB(j)  (1280 + 64 * (j))
#define XB_XGEN(j)  (2304 + 64 * (j))
#define XB_TOP      3328
#define XB_TOPGEN   3392
#define XCD_BAR_WORDS 3456
#define XB_SPIN_CAP (1u << 18)

__device__ __forceinline__ unsigned xb_ld(unsigned* p)              { return __hip_atomic_load(p, __ATOMIC_RELAXED, __HIP_MEMORY_SCOPE_AGENT); }
__device__ __forceinline__ unsigned xb_add(unsigned* p, unsigned v) { return __hip_atomic_fetch_add(p, v, __ATOMIC_RELAXED, __HIP_MEMORY_SCOPE_AGENT); }
__device__ __forceinline__ unsigned xb_xcc_id() { return (unsigned)__builtin_amdgcn_s_getreg((3 << 11) | 20) & 0xFu; }
#define XB_SPIN(cond, bar) do { unsigned _sp = 0; while (cond) { __builtin_amdgcn_s_sleep(1); \
    if ((++_sp & 255u) == 0u) { if (xb_ld(&(bar)[XB_TMO])) break; if (_sp > XB_SPIN_CAP) { atomicAdd(&(bar)[XB_TMO], 1u); break; } } } } while (0)

struct XcdBarrier {
    unsigned* bar; unsigned x;
    volatile LAS unsigned* st;
};

__device__ __forceinline__ XcdBarrier xcd_barrier_post(unsigned* bar, volatile LAS unsigned* st) {
    XcdBarrier b; b.bar = bar; b.x = xb_xcc_id(); b.st = st;
    if (threadIdx.x == 0) (void)xb_add(&bar[XB_XCNT(b.x)], 1u);
    return b;
}
__device__ __forceinline__ void xcd_barrier_complete(unsigned* bar, unsigned x, unsigned& nloc, unsigned& nx) {
    const unsigned G = gridDim.x * gridDim.y * gridDim.z;
    unsigned sum, cnt, mine, sp = 0u;
    for (;;) {
        sum = 0u; cnt = 0u; mine = 0u;
#pragma unroll
        for (unsigned j = 0; j < 16; ++j) { const unsigned c = xb_ld(&bar[XB_XCNT(j)]); sum += c; cnt += (c > 0u) ? 1u : 0u; mine = (j == x) ? c : mine; }
        if (sum == G) break;
        __builtin_amdgcn_s_sleep(1);
        if ((++sp & 255u) == 0u) { if (xb_ld(&bar[XB_TMO])) break; if (sp > XB_SPIN_CAP) { atomicAdd(&bar[XB_TMO], 1u); break; } }
    }
    nloc = mine > 0u ? mine : 1u; nx = cnt > 0u ? cnt : 1u;
}

__device__ __forceinline__ void xcd_barrier(const XcdBarrier& b) {
    asm volatile("s_waitcnt vmcnt(0)" ::: "memory");
    __syncthreads();
    if (threadIdx.x == 0) {
        unsigned* bar = b.bar;
        __builtin_amdgcn_s_waitcnt(0);
        unsigned nloc = b.st[0], nx = b.st[1];
        if (nloc == 0u) { xcd_barrier_complete(bar, b.x, nloc, nx); b.st[0] = nloc; b.st[1] = nx; }
        const unsigned old = xb_add(&bar[XB_XSUB(b.x)], 1u);
        const unsigned gen = old / nloc;
        if (old + 1u == (gen + 1u) * nloc) {
            __builtin_amdgcn_fence(__ATOMIC_RELEASE, "agent");
            asm volatile("s_waitcnt vmcnt(0)" ::: "memory");
            const unsigned og = xb_add(&bar[XB_TOP], 1u);
            const unsigned tg = og / nx;
            if (og + 1u == (tg + 1u) * nx) xb_add(&bar[XB_TOPGEN], 1u);
            else XB_SPIN(xb_ld(&bar[XB_TOPGEN]) == tg, bar);
            __builtin_amdgcn_fence(__ATOMIC_ACQUIRE, "agent");
            xb_add(&bar[XB_XGEN(b.x)], 1u);
            asm volatile("s_waitcnt vmcnt(0)" ::: "memory");
        } else {
            XB_SPIN(xb_ld(&bar[XB_XGEN(b.x)]) == gen, bar);
            __builtin_amdgcn_fence(__ATOMIC_ACQUIRE, "agent");
            asm volatile("s_waitcnt vmcnt(0)" ::: "memory");
        }
    }
    __syncthreads();
}


#ifndef MK_LAUNCH_PER_PHASE
#define MK_LAUNCH_PER_PHASE 1
#endif
constexpr int NWAVES = 8;
#ifndef PHASE_MASK
#define PHASE_MASK 0xFFFFFFFFu
#endif
#define PON(i) ((PHASE_MASK >> (i)) & 1u)

constexpr int NB = 4, SEQ = 2048, D = 2048, M = NB * SEQ, FF = 5632;
constexpr int IN0 = 14368, IN0P = 14592, IN1 = 3408, IN1P = 3584;
constexpr int MODW = 9 * D;
constexpr float EPS = 1e-6f;
constexpr int NPH = 26;

constexpr size_t MiB = 1u << 20;
constexpr size_t WS_CTL = 0, CTL_ZERO_BYTES = 1 * MiB;
constexpr size_t WS_MODS = 1 * MiB;
constexpr size_t WS_RTC = 2 * MiB, WS_RTS = 6 * MiB;
constexpr size_t WS_RTQ = 10 * MiB;
constexpr size_t WS_RTI = 11 * MiB;
constexpr size_t WS_SSQ = 12 * MiB;
constexpr size_t WS_DTB = 13 * MiB;
constexpr size_t WS_WGU = 24 * MiB;
constexpr size_t WS_WD = 200 * MiB;
constexpr size_t WS_WIN0 = 288 * MiB;
constexpr size_t WS_WOUT0 = 345 * MiB;
constexpr size_t WS_WIN1 = 361 * MiB;
constexpr size_t WS_WOUT1 = 375 * MiB;
constexpr size_t WS_H = 384 * MiB;
constexpr size_t WS_Y = 416 * MiB;
constexpr size_t WS_MIX = 480 * MiB;
constexpr size_t WS_BIG = 544 * MiB;
constexpr size_t WS_X0 = 772 * MiB;
constexpr size_t WS_QR = 900 * MiB, WS_KR = 932 * MiB;
constexpr size_t WS_YR = 964 * MiB;
constexpr size_t WS_IDX = 772 * MiB;
constexpr size_t WS_QA = 812 * MiB;
constexpr size_t WS_KA = 844 * MiB, WS_VA = 848 * MiB;
constexpr size_t WS_QI = 852 * MiB;
constexpr size_t WS_KI = 884 * MiB;
constexpr size_t WS_WI = 886 * MiB;
constexpr size_t WS_SEL = 888 * MiB;
constexpr size_t WS_NSEL = 896 * MiB;
constexpr size_t WS_END = 1028 * MiB;
constexpr size_t WGU_ELEMS = (size_t)2 * FF * D, WD_ELEMS = (size_t)D * FF;
constexpr int CW_BAR = 4096;

constexpr int RING_BYTES = 131072;
constexpr int LDSCTL_OFF = RING_BYTES, MISC_OFF = LDSCTL_OFF + 320;
constexpr int LDS_BYTES = 147456;

__device__ __forceinline__ float bf2f(unsigned short b) { return __uint_as_float(((unsigned)b) << 16); }
__device__ __forceinline__ float bflo(unsigned w) { return __uint_as_float(w << 16); }
__device__ __forceinline__ float bfhi(unsigned w) { return __uint_as_float(w & 0xffff0000u); }
__device__ __forceinline__ float silu(float v) { return v / (1.0f + __expf(-v)); }
__device__ __forceinline__ float wave_sum(float v) {
#pragma unroll
    for (int o = 1; o < 64; o <<= 1) v += __shfl_xor(v, o);
    return v;
}

struct Frame {
    LAS unsigned char* lds;
    int vcu, G;
    const float *x, *c, *mod_w, *mod_b, *norm_w, *w_gate, *w_up, *w_down, *hy_w_in, *conv_w, *conv_b, *A_log, *dt_bias, *ssd_D, *ssd_norm_w, *ret_norm_w, *hy_w_out, *dsa_w_in, *idx_k_norm_w, *dsa_w_out;
    const int* positions;
    float* out;
    unsigned char* ws;
};
#define WSP(T, off) ((T*)(F.ws + (off)))

__device__ __forceinline__ void tr_item(const float* W, int ldn, int K, int k0, int sc, int ncl, bf16* WT, int dr, LAS float* scr, int lane) {
    int cc = sc + (lane & 31); cc = cc < ncl ? cc : ncl - 1;
#pragma unroll 8
    for (int i = 0; i < 32; ++i) { const int kk = 2 * i + (lane >> 5); scr[kk * 33 + (lane & 31)] = W[(size_t)(k0 + kk) * ldn + cc]; }
    LDS_WAIT(); asm volatile("" ::: "memory");
    const int c = lane & 7;
#pragma unroll
    for (int j = 0; j < 4; ++j) { const int n = (lane >> 3) + 8 * j; const LAS float* s = scr + (8 * c) * 33 + n;
        v4u o; o.x = pk2(s[0 * 33], s[1 * 33]); o.y = pk2(s[2 * 33], s[3 * 33]); o.z = pk2(s[4 * 33], s[5 * 33]); o.w = pk2(s[6 * 33], s[7 * 33]);
        *(GAS v4u*)(WT + (size_t)(dr + n) * K + k0 + 8 * c) = o; }
    LDS_WAIT(); asm volatile("" ::: "memory");
}
__device__ __forceinline__ int in0_dst_col(int sc) {
    if (sc < 6144) return sc;
    if (sc < 6176) return 14336 + (sc - 6144);
    return sc - 32;
}
__device__ __forceinline__ void p0_prologue(Frame& F) {
    int tid_ = threadIdx.x; asm volatile("" : "+v"(tid_)); const int TID = tid_, LANE = TID & 63, WAVE = __builtin_amdgcn_readfirstlane(TID >> 6); (void)LANE; (void)WAVE;

    {
        LAS float* cond = (LAS float*)F.lds;
        LAS float* red = (LAS float*)(F.lds + 32768);
        for (int i = TID; i < NB * D; i += NWAVES * 64) cond[i] = silu(F.c[i]);
        __syncthreads();
        float* MODS = WSP(float, WS_MODS);
        for (int u = F.vcu; u < 256; u += F.G) {
            const int col0 = 144 * u, layer = col0 / MODW, j0 = col0 % MODW;
            const int cq = TID % 36, ks = TID / 36;
            if (ks < 14) {
                f32x4 a0 = {0.f, 0.f, 0.f, 0.f}, a1 = a0, a2 = a0, a3 = a0;
                const int kb = ks * 147, ke = (kb + 147 < D) ? kb + 147 : D;
                const float* wp = F.mod_w + (size_t)layer * D * MODW + j0 + 4 * cq;
#pragma unroll 4
                for (int k = kb; k < ke; ++k) { const f32x4 w = *(const f32x4*)(wp + (size_t)k * MODW);
                    a0 += cond[k] * w; a1 += cond[D + k] * w; a2 += cond[2 * D + k] * w; a3 += cond[3 * D + k] * w; }
                LAS float* r = red + (ks * 36 + cq) * 16;
                *(LAS f32x4*)(r) = a0; *(LAS f32x4*)(r + 4) = a1; *(LAS f32x4*)(r + 8) = a2; *(LAS f32x4*)(r + 12) = a3;
            }
            __syncthreads();
            for (int o = TID; o < 576; o += NWAVES * 64) { const int cq2 = o / 16, r = o % 16, b = r / 4, e = r % 4; float s = 0.f;
#pragma unroll
                for (int k2 = 0; k2 < 14; ++k2) s += red[(k2 * 36 + cq2) * 16 + r];
                const int j = j0 + 4 * cq2 + e;
                MODS[(size_t)(layer * 4 + b) * MODW + j] = s + F.mod_b[layer * MODW + j]; }
            __syncthreads();
        }
    }
    {
        const int gt = F.vcu * NWAVES * 64 + TID, NT = F.G * NWAVES * 64;
        const double INV2PI = 0.15915494309189535;
        float* rc = WSP(float, WS_RTC); float* rs = WSP(float, WS_RTS);
        for (int idx = gt; idx < M * 128; idx += NT) { const int row = idx >> 7, i = idx & 127;
            const double inv = exp2(-(double)i * (13.287712379549449 / 128.0));
            const double rev = (double)F.positions[row] * inv * INV2PI; const float fr = (float)(rev - rint(rev));
            rc[idx] = __builtin_amdgcn_cosf(fr); rs[idx] = __builtin_amdgcn_sinf(fr); }
        float* qc = WSP(float, WS_RTQ); float* qs = qc + M * 16;
        for (int idx = gt; idx < M * 16; idx += NT) { const int row = idx >> 4, i = idx & 15;
            const double inv = exp2(-(double)i * (18.931568569324174 / 16.0));
            const double rev = (double)F.positions[row] * inv * INV2PI; const float fr = (float)(rev - rint(rev));
            qc[idx] = __builtin_amdgcn_cosf(fr); qs[idx] = __builtin_amdgcn_sinf(fr); }
        float* ic = WSP(float, WS_RTI); float* is = ic + M * 8;
        for (int idx = gt; idx < M * 8; idx += NT) { const int row = idx >> 3, i = idx & 7;
            const double inv = exp2(-(double)i * (18.931568569324174 / 8.0));
            const double rev = (double)F.positions[row] * inv * INV2PI; const float fr = (float)(rev - rint(rev));
            ic[idx] = __builtin_amdgcn_cosf(fr); is[idx] = __builtin_amdgcn_sinf(fr); }
    }
    {
        LAS float* scr = (LAS float*)(F.lds + WAVE * 8448);
        const int gw = F.vcu * NWAVES + WAVE, NGW = F.G * NWAVES;
        constexpr int I_G = 32 * 176, I_D = 88 * 64, I_FFN = 2 * I_G + I_D;
        constexpr int I_IN0 = 32 * 449, I_OUT0 = 64 * 64, I_IN1 = 32 * 107, I_OUT1 = 32 * 64;
        constexpr int NITEMS = 4 * I_FFN + I_IN0 + I_OUT0 + I_IN1 + I_OUT1;
        bf16* Wgu = WSP(bf16, WS_WGU); bf16* Wd = WSP(bf16, WS_WD);
        for (int it = gw; it < NITEMS; it += NGW) {
            int r = it;
            if (r < 4 * I_FFN) { const int s = r / I_FFN; r -= s * I_FFN;
                if (r < 2 * I_G) { const int up = r / I_G; r -= up * I_G; const int kb = r / 176, nb = r % 176, sc = 32 * nb;
                    const float* W = (up ? F.w_up : F.w_gate) + (size_t)s * D * FF;
                    tr_item(W, FF, D, 64 * kb, sc, FF, Wgu + (size_t)s * WGU_ELEMS, 256 * (sc / 128) + 128 * up + (sc % 128), scr, LANE); }
                else { r -= 2 * I_G; const int kb = r / 64, nb = r % 64;
                    tr_item(F.w_down + (size_t)s * FF * D, D, FF, 64 * kb, 32 * nb, D, Wd + (size_t)s * WD_ELEMS, 32 * nb, scr, LANE); }
                continue; }
            r -= 4 * I_FFN;
            if (r < I_IN0) { const int kb = r / 449, nb = r % 449, sc = 32 * nb; tr_item(F.hy_w_in, IN0, D, 64 * kb, sc, IN0, WSP(bf16, WS_WIN0), in0_dst_col(sc), scr, LANE); continue; }
            r -= I_IN0;
            if (r < I_OUT0) { const int kb = r / 64, nb = r % 64; tr_item(F.hy_w_out, D, 2 * D, 64 * kb, 32 * nb, D, WSP(bf16, WS_WOUT0), 32 * nb, scr, LANE); continue; }
            r -= I_OUT0;
            if (r < I_IN1) { const int kb = r / 107, nb = r % 107; tr_item(F.dsa_w_in, IN1, D, 64 * kb, 32 * nb, IN1, WSP(bf16, WS_WIN1), 32 * nb, scr, LANE); continue; }
            r -= I_IN1;
            { const int kb = r / 64, nb = r % 64; tr_item(F.dsa_w_out, D, D, 64 * kb, 32 * nb, D, WSP(bf16, WS_WOUT1), 32 * nb, scr, LANE); }
        }
    }
}

__device__ __forceinline__ void thin_phase(Frame& F, int prevq, int nextq) {
    int tid_ = threadIdx.x; asm volatile("" : "+v"(tid_)); const int TID = tid_, LANE = TID & 63, WAVE = __builtin_amdgcn_readfirstlane(TID >> 6); (void)LANE; (void)WAVE;

    const int gw = F.vcu * NWAVES + WAVE, NGW = F.G * NWAVES;
    const float* xin = (prevq <= 0) ? F.x : F.out;
    const float* Y = WSP(float, WS_Y); const float* SSQ = WSP(float, WS_SSQ); const float* MODS = WSP(float, WS_MODS); bf16* H = WSP(bf16, WS_H);
    for (int row = gw; row < M; row += NGW) {
        const int b = row >> 11;
        f32x4 xv[8];
        const f32x4* xr = (const f32x4*)(xin + (size_t)row * D) + LANE;
#pragma unroll
        for (int j = 0; j < 8; ++j) xv[j] = xr[64 * j];
        if (prevq >= 0) {
            const int pl = prevq / 3, pj = prevq % 3; const float rw = (pj == 1) ? 1.0f : 0.5f;
            float s = (LANE < 32) ? SSQ[(size_t)row * 32 + LANE] : 0.f; s = wave_sum(s);
            const float sc = rw * rsqrtf(s * (1.0f / D) + EPS);
            const f32x4* yr = (const f32x4*)(Y + (size_t)row * D) + LANE;
            const f32x4* pw = (const f32x4*)(F.norm_w + (size_t)(pl * 6 + 2 * pj + 1) * D) + LANE;
            const f32x4* gt = (const f32x4*)(MODS + (size_t)(pl * 4 + b) * MODW + (3 * pj + 2) * D) + LANE;
            f32x4* xo = (f32x4*)(F.out + (size_t)row * D) + LANE;
#pragma unroll
            for (int j = 0; j < 8; ++j) { xv[j] = xv[j] + sc * (gt[64 * j] * yr[64 * j] * pw[64 * j]); xo[64 * j] = xv[j]; }
        }
        if (nextq >= 0) {
            const int nl = nextq / 3, nj = nextq % 3;
            float s = 0.f;
#pragma unroll
            for (int j = 0; j < 8; ++j) s += (xv[j].x * xv[j].x + xv[j].y * xv[j].y) + (xv[j].z * xv[j].z + xv[j].w * xv[j].w);
            const float rstd = rsqrtf(wave_sum(s) * (1.0f / D) + EPS);
            const f32x4* pw = (const f32x4*)(F.norm_w + (size_t)(nl * 6 + 2 * nj) * D) + LANE;
            const f32x4* sh = (const f32x4*)(MODS + (size_t)(nl * 4 + b) * MODW + (3 * nj) * D) + LANE;
            const f32x4* scp = (const f32x4*)(MODS + (size_t)(nl * 4 + b) * MODW + (3 * nj + 1) * D) + LANE;
            unsigned long long* o8 = (unsigned long long*)(H + (size_t)row * D) + LANE;
#pragma unroll
            for (int j = 0; j < 8; ++j) { const f32x4 h = (xv[j] * rstd) * pw[64 * j] * (scp[64 * j] + 1.0f) + sh[64 * j];
                o8[64 * j] = (unsigned long long)pk2(h.x, h.y) | ((unsigned long long)pk2(h.z, h.w) << 32); }
        }
    }
}

__device__ __forceinline__ void m0_prep(Frame& F) {
    int tid_ = threadIdx.x; asm volatile("" : "+v"(tid_)); const int TID = tid_, LANE = TID & 63, WAVE = __builtin_amdgcn_readfirstlane(TID >> 6); (void)LANE; (void)WAVE;

    const int gt = F.vcu * NWAVES * 64 + TID, NT = F.G * NWAVES * 64;
    const bf16* PB = WSP(bf16, WS_BIG); float* X2 = WSP(float, WS_X0);
    for (int idx = gt; idx < M * 512; idx += NT) {
        const int row = idx >> 9, c8 = (idx & 511) * 8, t = row & (SEQ - 1);
        float a[8];
#pragma unroll
        for (int e = 0; e < 8; ++e) a[e] = F.conv_b[c8 + e];
#pragma unroll
        for (int j = 0; j < 4; ++j) { const int tt = t - 3 + j; if (tt < 0) continue;
            const v4u u = *(const v4u*)(PB + (size_t)(row - 3 + j) * IN0P + 2048 + c8);
            const float* w = F.conv_w + (size_t)j * 4096 + c8;
            a[0] += w[0] * bflo(u.x); a[1] += w[1] * bfhi(u.x); a[2] += w[2] * bflo(u.y); a[3] += w[3] * bfhi(u.y);
            a[4] += w[4] * bflo(u.z); a[5] += w[5] * bfhi(u.z); a[6] += w[6] * bflo(u.w); a[7] += w[7] * bfhi(u.w); }
        float* o = X2 + (size_t)row * 4096 + c8;
        *(f32x4*)o = (f32x4){silu(a[0]), silu(a[1]), silu(a[2]), silu(a[3])}; *(f32x4*)(o + 4) = (f32x4){silu(a[4]), silu(a[5]), silu(a[6]), silu(a[7])};
    }
    const float* rc = WSP(float, WS_RTC); const float* rs = WSP(float, WS_RTS);
    bf16* QR = WSP(bf16, WS_QR); bf16* KR = WSP(bf16, WS_KR);
    for (int idx = gt; idx < M * 128 * 2; idx += NT) {
        const int isk = idx >= M * 128, id2 = isk ? idx - M * 128 : idx;
        const int row = id2 >> 7, r = id2 & 127, h = r >> 4, i0 = (r & 15) * 8;
        const bf16* src = PB + (size_t)row * IN0P + (isk ? 8192 : 6144) + h * 256 + i0;
        const v4u u1 = *(const v4u*)src, u2 = *(const v4u*)(src + 128);
        const float x1[8] = {bflo(u1.x), bfhi(u1.x), bflo(u1.y), bfhi(u1.y), bflo(u1.z), bfhi(u1.z), bflo(u1.w), bfhi(u1.w)};
        const float x2[8] = {bflo(u2.x), bfhi(u2.x), bflo(u2.y), bfhi(u2.y), bflo(u2.z), bfhi(u2.z), bflo(u2.w), bfhi(u2.w)};
        const float sc = isk ? 0.0625f : 1.0f;
        float o1[8], o2[8];
#pragma unroll
        for (int e = 0; e < 8; ++e) { const float cs = rc[(size_t)row * 128 + i0 + e], sn = rs[(size_t)row * 128 + i0 + e];
            o1[e] = (x1[e] * cs - x2[e] * sn) * sc; o2[e] = (x1[e] * sn + x2[e] * cs) * sc; }
        bf16* dst = (isk ? KR : QR) + (size_t)row * 2048 + h * 256 + i0;
        v4u w1, w2; w1.x = pk2(o1[0], o1[1]); w1.y = pk2(o1[2], o1[3]); w1.z = pk2(o1[4], o1[5]); w1.w = pk2(o1[6], o1[7]);
        w2.x = pk2(o2[0], o2[1]); w2.y = pk2(o2[2], o2[3]); w2.z = pk2(o2[4], o2[5]); w2.w = pk2(o2[6], o2[7]);
        *(v4u*)dst = w1; *(v4u*)(dst + 128) = w2;
    }
}
__device__ __forceinline__ void m0_scan(Frame& F) {
    int tid_ = threadIdx.x; asm volatile("" : "+v"(tid_)); const int TID = tid_, LANE = TID & 63, WAVE = __builtin_amdgcn_readfirstlane(TID >> 6); (void)LANE; (void)WAVE;

    const float* X2 = WSP(float, WS_X0); const float* DTB = WSP(float, WS_DTB);
    for (int u = F.vcu; u < 32; u += F.G) {
        constexpr int TT = 32;
        LAS float* Bs = (LAS float*)F.lds; LAS float* Cs = Bs + TT * 128; LAS float* Xs = Cs + TT * 128; LAS float* dec = Xs + TT * 256; LAS float* dtv = dec + TT * 4;
        const int b = u >> 3, g = u & 7, hd = g * 4 + (WAVE & 3);
        float hst[128];
#pragma unroll
        for (int n = 0; n < 128; ++n) hst[n] = 0.f;
        const float Dh = F.ssd_D[hd];
        float* YS = WSP(float, WS_Y);
        for (int t0 = 0; t0 < SEQ; t0 += TT) {
            __syncthreads();
            const size_t row0 = (size_t)b * SEQ + t0;
            for (int i = TID; i < TT * 32; i += NWAVES * 64) { const int tt = i >> 5, c4 = (i & 31) * 4; const float* src = X2 + (row0 + tt) * 4096;
                *(LAS f32x4*)(Bs + tt * 128 + c4) = *(const f32x4*)(src + 2048 + g * 128 + c4); *(LAS f32x4*)(Cs + tt * 128 + c4) = *(const f32x4*)(src + 3072 + g * 128 + c4); }
            for (int i = TID; i < TT * 64; i += NWAVES * 64) { const int tt = i >> 6, c4 = (i & 63) * 4; *(LAS f32x4*)(Xs + tt * 256 + c4) = *(const f32x4*)(X2 + (row0 + tt) * 4096 + g * 256 + c4); }
            if (TID < TT * 4) { const int tt = TID >> 2, h2 = g * 4 + (TID & 3); const float v = DTB[(row0 + tt) * 256 + h2] + F.dt_bias[h2];
                const float dt = v > 20.f ? v : log1pf(__expf(v)); dtv[TID] = dt; dec[TID] = __expf(-dt * __expf(F.A_log[h2])); }
            __syncthreads();
            if (WAVE < 4) {
                for (int tt = 0; tt < TT; ++tt) {
                    const float a = dec[tt * 4 + WAVE], xv = Xs[tt * 256 + WAVE * 64 + LANE], uu = dtv[tt * 4 + WAVE] * xv; float y = 0.f;
#pragma unroll
                    for (int n4 = 0; n4 < 32; ++n4) { const f32x4 Bv = *(const LAS f32x4*)(Bs + tt * 128 + 4 * n4), Cv = *(const LAS f32x4*)(Cs + tt * 128 + 4 * n4);
#pragma unroll
                        for (int e = 0; e < 4; ++e) { hst[4 * n4 + e] = hst[4 * n4 + e] * a + uu * Bv[e]; y += hst[4 * n4 + e] * Cv[e]; } }
                    YS[(row0 + tt) * 2048 + hd * 64 + LANE] = y + Dh * xv;
                }
            }
        }
        __syncthreads();
    }
    for (int u = (F.vcu >= 32 ? F.vcu - 32 : F.vcu + F.G - 32); u < 32; u += F.G) {
        constexpr int TT = 16;
        LAS float* qs = (LAS float*)F.lds; LAS float* ks = qs + TT * 256; LAS float* vs = ks + TT * 256; LAS float* yp = vs + TT * 256;
        const int b = u >> 3, h = u & 7, dv = TID & 255, half = TID >> 8;
        const float gamma = 1.0f - exp2f(-5.0f - (float)h);
        float S[128];
#pragma unroll
        for (int n = 0; n < 128; ++n) S[n] = 0.f;
        const bf16* QR = WSP(bf16, WS_QR); const bf16* KR = WSP(bf16, WS_KR); const bf16* PB = WSP(bf16, WS_BIG); float* YR = WSP(float, WS_YR);
        for (int t0 = 0; t0 < SEQ; t0 += TT) {
            __syncthreads();
            const size_t row0 = (size_t)b * SEQ + t0;
            for (int i = TID; i < TT * 256; i += NWAVES * 64) { const int tt = i >> 8, d = i & 255;
                qs[i] = bf2f(QR[(row0 + tt) * 2048 + h * 256 + d]); ks[i] = bf2f(KR[(row0 + tt) * 2048 + h * 256 + d]); vs[i] = bf2f(PB[(row0 + tt) * IN0P + 10240 + h * 256 + d]); }
            __syncthreads();
            for (int tt = 0; tt < TT; ++tt) { const float vv = vs[tt * 256 + dv]; float y = 0.f;
#pragma unroll
                for (int j4 = 0; j4 < 32; ++j4) { const f32x4 qv = *(const LAS f32x4*)(qs + tt * 256 + half * 128 + 4 * j4), kv = *(const LAS f32x4*)(ks + tt * 256 + half * 128 + 4 * j4);
#pragma unroll
                    for (int e = 0; e < 4; ++e) { S[4 * j4 + e] = S[4 * j4 + e] * gamma + kv[e] * vv; y += qv[e] * S[4 * j4 + e]; } }
                yp[(tt * 2 + half) * 256 + dv] = y; }
            __syncthreads();
            for (int i = TID; i < TT * 256; i += NWAVES * 64) { const int tt = i >> 8, d = i & 255; YR[(row0 + tt) * 2048 + h * 256 + d] = yp[(tt * 2) * 256 + d] + yp[(tt * 2 + 1) * 256 + d]; }
        }
        __syncthreads();
    }
}
__device__ __forceinline__ void m0_post(Frame& F) {
    int tid_ = threadIdx.x; asm volatile("" : "+v"(tid_)); const int TID = tid_, LANE = TID & 63, WAVE = __builtin_amdgcn_readfirstlane(TID >> 6); (void)LANE; (void)WAVE;

    const int gw = F.vcu * NWAVES + WAVE, NGW = F.G * NWAVES;
    const float* YS = WSP(float, WS_Y); const float* YR = WSP(float, WS_YR); const bf16* PB = WSP(bf16, WS_BIG); bf16* MIX = WSP(bf16, WS_MIX);
    for (int row = gw; row < M; row += NGW) {
        f32x4 v[8]; float s = 0.f;
#pragma unroll
        for (int j = 0; j < 8; ++j) { const int c = 4 * LANE + 256 * j; const f32x4 y = *(const f32x4*)(YS + (size_t)row * 2048 + c);
            const unsigned long long zz = *(const unsigned long long*)(PB + (size_t)row * IN0P + c); const unsigned z0 = (unsigned)zz, z1 = (unsigned)(zz >> 32);
            v[j] = (f32x4){y.x * silu(bflo(z0)), y.y * silu(bfhi(z0)), y.z * silu(bflo(z1)), y.w * silu(bfhi(z1))};
            s += (v[j].x * v[j].x + v[j].y * v[j].y) + (v[j].z * v[j].z + v[j].w * v[j].w); }
        const float rstd = rsqrtf(wave_sum(s) * (1.0f / 2048.0f) + EPS);
#pragma unroll
        for (int j = 0; j < 8; ++j) { const int c = 4 * LANE + 256 * j; const f32x4 w = *(const f32x4*)(F.ssd_norm_w + c); const f32x4 o = v[j] * rstd * w;
            *(unsigned long long*)(MIX + (size_t)row * 4096 + c) = (unsigned long long)pk2(o.x, o.y) | ((unsigned long long)pk2(o.z, o.w) << 32); }
#pragma unroll
        for (int j = 0; j < 8; ++j) { const int c = 4 * LANE + 256 * j; const f32x4 y = *(const f32x4*)(YR + (size_t)row * 2048 + c);
            const float hs = wave_sum((y.x * y.x + y.y * y.y) + (y.z * y.z + y.w * y.w)); const float rs = rsqrtf(hs * (1.0f / 256.0f) + EPS);
            const unsigned long long gg = *(const unsigned long long*)(PB + (size_t)row * IN0P + 12288 + c); const unsigned g0 = (unsigned)gg, g1 = (unsigned)(gg >> 32);
            const f32x4 w = *(const f32x4*)(F.ret_norm_w + c);
            const f32x4 o = (f32x4){silu(bflo(g0)), silu(bfhi(g0)), silu(bflo(g1)), silu(bfhi(g1))} * (y * rs * w);
            *(unsigned long long*)(MIX + (size_t)row * 4096 + 2048 + c) = (unsigned long long)pk2(o.x, o.y) | ((unsigned long long)pk2(o.z, o.w) << 32); }
    }
}

__device__ __forceinline__ void m1_prep(Frame& F) {
    int tid_ = threadIdx.x; asm volatile("" : "+v"(tid_)); const int TID = tid_, LANE = TID & 63, WAVE = __builtin_amdgcn_readfirstlane(TID >> 6); (void)LANE; (void)WAVE;

    const int gt = F.vcu * NWAVES * 64 + TID, NT = F.G * NWAVES * 64;
    const bf16* PB = WSP(bf16, WS_BIG); const float* IDX = WSP(float, WS_IDX);
    const float* qc = WSP(float, WS_RTQ); const float* qs = qc + M * 16; const float* ic = WSP(float, WS_RTI); const float* is = ic + M * 8;
    bf16* QA = WSP(bf16, WS_QA); float* KA = WSP(float, WS_KA); float* VA = WSP(float, WS_VA); float* QI = WSP(float, WS_QI); float* KI = WSP(float, WS_KI); float* WI = WSP(float, WS_WI);
    for (int idx = gt; idx < M * 16; idx += NT) {
        const int row = idx >> 4, h = idx & 15; const bf16* src = PB + (size_t)row * 2304 + h * 128; bf16* dst = QA + (size_t)row * 2048 + h * 128;
        for (int i = 0; i < 16; ++i) { const float x1 = bf2f(src[i]), x2 = bf2f(src[16 + i]), cs = qc[row * 16 + i], sn = qs[row * 16 + i];
            dst[i] = (bf16)f2bf(x1 * cs - x2 * sn); dst[16 + i] = (bf16)f2bf(x1 * sn + x2 * cs); }
        for (int i = 32; i < 128; i += 8) *(v4u*)(dst + i) = *(const v4u*)(src + i);
        const float* si = IDX + (size_t)row * 1280 + h * 64; float* di = QI + (size_t)row * 1024 + h * 64;
        for (int i = 0; i < 8; ++i) { const float x1 = si[i], x2 = si[8 + i], cs = ic[row * 8 + i], sn = is[row * 8 + i]; di[i] = x1 * cs - x2 * sn; di[8 + i] = x1 * sn + x2 * cs; }
        for (int i = 16; i < 64; ++i) di[i] = si[i];
        WI[(size_t)row * 16 + h] = IDX[(size_t)row * 1280 + 1088 + h] * 0.03125f;
    }
    for (int row = gt; row < M; row += NT) {
        const bf16* src = PB + (size_t)row * 2304 + 2048; float* kd = KA + (size_t)row * 128; float* vd = VA + (size_t)row * 128;
        for (int i = 0; i < 16; ++i) { const float x1 = bf2f(src[i]), x2 = bf2f(src[16 + i]), cs = qc[row * 16 + i], sn = qs[row * 16 + i]; kd[i] = x1 * cs - x2 * sn; kd[16 + i] = x1 * sn + x2 * cs; }
        for (int i = 32; i < 128; ++i) kd[i] = bf2f(src[i]);
        for (int i = 0; i < 128; ++i) vd[i] = bf2f(src[128 + i]);
        const float* si = IDX + (size_t)row * 1280 + 1024; float* di = KI + (size_t)row * 64;
        float ss = 0.f; for (int i = 0; i < 64; ++i) ss += si[i] * si[i];
        const float rstd = rsqrtf(ss * (1.0f / 64.0f) + EPS);
        for (int i = 0; i < 8; ++i) { const float x1 = si[i] * rstd * F.idx_k_norm_w[i], x2 = si[8 + i] * rstd * F.idx_k_norm_w[8 + i], cs = ic[row * 8 + i], sn = is[row * 8 + i];
            di[i] = x1 * cs - x2 * sn; di[8 + i] = x1 * sn + x2 * cs; }
        for (int i = 16; i < 64; ++i) di[i] = si[i] * rstd * F.idx_k_norm_w[i];
    }
}
__device__ __forceinline__ unsigned block_count(int TID, int LANE, LAS unsigned* cnt, unsigned mine) {
    unsigned w = mine;
#pragma unroll
    for (int o = 1; o < 64; o <<= 1) w += __shfl_xor(w, o);
    __syncthreads();
    if (TID == 0) cnt[0] = 0u;
    __syncthreads();
    if (LANE == 0) atomicAdd((unsigned*)cnt, w);
    __syncthreads();
    return cnt[0];
}
__device__ __forceinline__ void m1_index(Frame& F) {
    int tid_ = threadIdx.x; asm volatile("" : "+v"(tid_)); const int TID = tid_, LANE = TID & 63, WAVE = __builtin_amdgcn_readfirstlane(TID >> 6); (void)LANE; (void)WAVE;

    LAS float* qis = (LAS float*)F.lds; LAS float* wis = qis + 1024; LAS unsigned* sc = (LAS unsigned*)(wis + 16); LAS unsigned* cnt = sc + 2048;
    const float* QI = WSP(float, WS_QI); const float* KI = WSP(float, WS_KI); const float* WI = WSP(float, WS_WI); int* SEL = WSP(int, WS_SEL); int* NSEL = WSP(int, WS_NSEL);
    for (int qrow = F.vcu; qrow < M; qrow += F.G) {
        const int b = qrow >> 11, qp = qrow & (SEQ - 1), nvis = qp + 1;
        if (nvis <= 256) { for (int i = TID; i < nvis; i += NWAVES * 64) SEL[(size_t)qrow * 256 + i] = i; if (TID == 0) NSEL[qrow] = nvis; continue; }
        __syncthreads();
        for (int i = TID; i < 1024; i += NWAVES * 64) qis[i] = QI[(size_t)qrow * 1024 + i];
        if (TID < 16) wis[TID] = WI[(size_t)qrow * 16 + TID];
        __syncthreads();
        for (int key = TID; key < nvis; key += NWAVES * 64) {
            const f32x4* kp = (const f32x4*)(KI + ((size_t)b * SEQ + key) * 64); f32x4 kv[16];
#pragma unroll
            for (int i = 0; i < 16; ++i) kv[i] = kp[i];
            float s = 0.f;
            for (int h = 0; h < 16; ++h) { float d = 0.f;
#pragma unroll
                for (int i = 0; i < 16; ++i) { const f32x4 q = *(const LAS f32x4*)(qis + h * 64 + 4 * i); d += (q.x * kv[i].x + q.y * kv[i].y) + (q.z * kv[i].z + q.w * kv[i].w); }
                s += fmaxf(d, 0.f) * wis[h]; }
            s += 0.0f;
            const unsigned uu = __float_as_uint(s); sc[key] = (uu & 0x80000000u) ? ~uu : (uu | 0x80000000u);
        }
        __syncthreads();
        unsigned prefix = 0u;
        for (int bit = 31; bit >= 0; --bit) { const unsigned cand = prefix | (1u << bit); unsigned mine = 0u;
            for (int key = TID; key < nvis; key += NWAVES * 64) mine += (sc[key] >= cand) ? 1u : 0u;
            if (block_count(TID, LANE, cnt, mine) >= 256u) prefix = cand; }
        unsigned mine = 0u;
        for (int key = TID; key < nvis; key += NWAVES * 64) mine += (sc[key] > prefix) ? 1u : 0u;
        const unsigned ngt = block_count(TID, LANE, cnt, mine);
        __syncthreads();
        if (TID == 0) cnt[1] = 0u;
        __syncthreads();
        for (int key = TID; key < nvis; key += NWAVES * 64) if (sc[key] > prefix) { const unsigned p = atomicAdd((unsigned*)(cnt + 1), 1u); SEL[(size_t)qrow * 256 + p] = key; }
        if (WAVE == 0) { int need = 256 - (int)ngt, pos = (int)ngt;
            for (int base = 0; base < nvis && need > 0; base += 64) { const int key = base + LANE; const bool eq = key < nvis && sc[key] == prefix;
                const unsigned long long mk = __ballot(eq); const int rank = __popcll(mk & ((1ull << LANE) - 1ull));
                if (eq && rank < need) SEL[(size_t)qrow * 256 + pos + rank] = key;
                const int c = __popcll(mk); pos += c; need -= c; }
            if (LANE == 0) NSEL[qrow] = 256; }
    }
}
__device__ __forceinline__ void m1_attn(Frame& F) {
    int tid_ = threadIdx.x; asm volatile("" : "+v"(tid_)); const int TID = tid_, LANE = TID & 63, WAVE = __builtin_amdgcn_readfirstlane(TID >> 6); (void)LANE; (void)WAVE;

    LAS float* qsm = (LAS float*)F.lds; LAS float* pr = qsm + 2048; LAS int* sel = (LAS int*)(pr + 16 * 256);
    const bf16* QA = WSP(bf16, WS_QA); const float* KA = WSP(float, WS_KA); const float* VA = WSP(float, WS_VA); const int* SEL = WSP(int, WS_SEL); const int* NSEL = WSP(int, WS_NSEL); bf16* MIX = WSP(bf16, WS_MIX);
    for (int qrow = F.vcu; qrow < M; qrow += F.G) {
        const int b = qrow >> 11, nsel = NSEL[qrow];
        __syncthreads();
        for (int i = TID; i < 2048; i += NWAVES * 64) qsm[i] = bf2f(QA[(size_t)qrow * 2048 + i]);
        if (TID < 256) sel[TID] = (TID < nsel) ? SEL[(size_t)qrow * 256 + TID] : 0;
        __syncthreads();
        const int h = TID >> 5, j = TID & 31;
        float mx = -3.0e38f;
        for (int kk = j; kk < nsel; kk += 32) { const f32x4* kp = (const f32x4*)(KA + ((size_t)b * SEQ + sel[kk]) * 128); float d = 0.f;
#pragma unroll 8
            for (int i = 0; i < 32; ++i) { const f32x4 kv = kp[i]; const f32x4 q = *(const LAS f32x4*)(qsm + h * 128 + 4 * i); d += (q.x * kv.x + q.y * kv.y) + (q.z * kv.z + q.w * kv.w); }
            d *= 0.08838834764831845f; pr[h * 256 + kk] = d; mx = fmaxf(mx, d); }
#pragma unroll
        for (int o = 1; o < 32; o <<= 1) mx = fmaxf(mx, __shfl_xor(mx, o));
        float sum = 0.f;
        for (int kk = j; kk < nsel; kk += 32) { const float e = __expf(pr[h * 256 + kk] - mx); pr[h * 256 + kk] = e; sum += e; }
#pragma unroll
        for (int o = 1; o < 32; o <<= 1) sum += __shfl_xor(sum, o);
        __syncthreads();
        f32x4 acc = {0.f, 0.f, 0.f, 0.f};
        for (int kk = 0; kk < nsel; ++kk) { const float p = pr[h * 256 + kk]; const f32x4 vv = *(const f32x4*)(VA + ((size_t)b * SEQ + sel[kk]) * 128 + 4 * j); acc += p * vv; }
        const float inv = 1.0f / sum; acc = acc * inv;
        *(unsigned long long*)(MIX + (size_t)qrow * 2048 + h * 128 + 4 * j) = (unsigned long long)pk2(acc.x, acc.y) | ((unsigned long long)pk2(acc.z, acc.w) << 32);
    }
}

struct Args { const void* in[21]; float* out; unsigned char* ws; int ph_lo, ph_hi; };
__global__ void __launch_bounds__(NWAVES * 64, 2) mk_fwd(Args args) {
    extern __shared__ __attribute__((aligned(16))) unsigned char lds_raw[];
    Frame F;
    F.lds = (LAS unsigned char*)lds_raw;
    F.G = gridDim.x; { const int bx = blockIdx.x; F.vcu = (F.G % 8 == 0) ? (bx % 8) * (F.G / 8) + bx / 8 : bx; }
    F.x = (const float*)args.in[0]; F.c = (const float*)args.in[1]; F.positions = (const int*)args.in[2]; F.mod_w = (const float*)args.in[3]; F.mod_b = (const float*)args.in[4];
    F.norm_w = (const float*)args.in[5]; F.w_gate = (const float*)args.in[6]; F.w_up = (const float*)args.in[7]; F.w_down = (const float*)args.in[8]; F.hy_w_in = (const float*)args.in[9];
    F.conv_w = (const float*)args.in[10]; F.conv_b = (const float*)args.in[11]; F.A_log = (const float*)args.in[12]; F.dt_bias = (const float*)args.in[13]; F.ssd_D = (const float*)args.in[14];
    F.ssd_norm_w = (const float*)args.in[15]; F.ret_norm_w = (const float*)args.in[16]; F.hy_w_out = (const float*)args.in[17]; F.dsa_w_in = (const float*)args.in[18];
    F.idx_k_norm_w = (const float*)args.in[19]; F.dsa_w_out = (const float*)args.in[20];
    F.out = args.out; F.ws = args.ws;
    const int TID = threadIdx.x;
    volatile LAS unsigned* MISC = (volatile LAS unsigned*)(F.lds + MISC_OFF);
    for (int u = TID; u < (LDS_BYTES - LDSCTL_OFF) / 4; u += NWAVES * 64) ((LAS unsigned*)(F.lds + LDSCTL_OFF))[u] = 0u;
    __syncthreads();
    const int lo = args.ph_lo, hi = args.ph_hi;
    XcdBarrier bar; bar.bar = (unsigned*)(F.ws + WS_CTL) + CW_BAR; bar.x = 0; bar.st = nullptr;
    if (hi - lo > 1) bar = xcd_barrier_post((unsigned*)(F.ws + WS_CTL) + CW_BAR, MISC + 8);
#define RUN(k) (lo <= (k) && (k) < hi)
#define SEAM(k) do { if (RUN(k) && RUN((k) + 1)) xcd_barrier(bar); } while (0)
    bf16* H = WSP(bf16, WS_H); bf16* ACT = WSP(bf16, WS_BIG); bf16* PB = WSP(bf16, WS_BIG); bf16* MIX = WSP(bf16, WS_MIX); float* Y = WSP(float, WS_Y); float* SSQ = WSP(float, WS_SSQ);

    if (PON(0) && RUN(0)) p0_prologue(F);
    SEAM(0);
    if (PON(1) && RUN(1)) thin_phase(F, -1, 0);
    SEAM(1);
    int ph = 2, q = 0;
    for (int s = 0; s < 4; ++s) {
        if (PON(2) && RUN(ph)) { pg8::Gemm g{H, WSP(bf16, WS_WGU) + (size_t)s * WGU_ELEMS, M, 2 * FF, D}; pg8::StaticOrder S; S.init(M, 2 * FF, F.G, (int)blockIdx.x);
            pg8::EpiGateUp E{ACT, FF}; pg8::gemm_phase<pg8::EpiGateUp, pg8::StaticOrder, true, true>(F.lds, g, S, E); }
        SEAM(ph); ++ph;
        if (PON(3) && RUN(ph)) { pg8::Gemm g{ACT, WSP(bf16, WS_WD) + (size_t)s * WD_ELEMS, M, D, FF}; pg8::StaticOrder S; S.init(M, D, F.G, (int)blockIdx.x);
            pg8::EpiYSsq E{Y, D, SSQ}; pg8::gemm_phase<pg8::EpiYSsq, pg8::StaticOrder, true, true>(F.lds, g, S, E); }
        SEAM(ph); ++ph;
        if (PON(1) && RUN(ph)) thin_phase(F, q, q < 5 ? q + 1 : -1);
        SEAM(ph); ++ph; ++q;
        if (s == 0) {
            if (PON(4) && RUN(ph)) { pg8::Gemm g{H, WSP(bf16, WS_WIN0), M, IN0P, D}; pg8::StaticOrder S; S.init(M, IN0P, F.G, (int)blockIdx.x);
                pg8::EpiProj E{PB, IN0P, 56, WSP(float, WS_DTB), 256}; pg8::gemm_phase<pg8::EpiProj, pg8::StaticOrder, true, true>(F.lds, g, S, E); }
            SEAM(ph); ++ph;
            if (PON(5) && RUN(ph)) m0_prep(F);
            SEAM(ph); ++ph;
            if (PON(6) && RUN(ph)) m0_scan(F);
            SEAM(ph); ++ph;
            if (PON(7) && RUN(ph)) m0_post(F);
            SEAM(ph); ++ph;
            if (PON(8) && RUN(ph)) { pg8::Gemm g{MIX, WSP(bf16, WS_WOUT0), M, D, 2 * D}; pg8::StaticOrder S; S.init(M, D, F.G, (int)blockIdx.x);
                pg8::EpiYSsq E{Y, D, SSQ}; pg8::gemm_phase<pg8::EpiYSsq, pg8::StaticOrder, true, true>(F.lds, g, S, E); }
            SEAM(ph); ++ph;
            if (PON(1) && RUN(ph)) thin_phase(F, q, q + 1);
            SEAM(ph); ++ph; ++q;
        }
        if (s == 2) {
            if (PON(9) && RUN(ph)) { pg8::Gemm g{H, WSP(bf16, WS_WIN1), M, IN1P, D}; pg8::StaticOrder S; S.init(M, IN1P, F.G, (int)blockIdx.x);
                pg8::EpiProj E{PB, 2304, 9, WSP(float, WS_IDX), 1280}; pg8::gemm_phase<pg8::EpiProj, pg8::StaticOrder, true, true>(F.lds, g, S, E); }
            SEAM(ph); ++ph;
            if (PON(10) && RUN(ph)) m1_prep(F);
            SEAM(ph); ++ph;
            if (PON(11) && RUN(ph)) m1_index(F);
            SEAM(ph); ++ph;
            if (PON(12) && RUN(ph)) m1_attn(F);
            SEAM(ph); ++ph;
            if (PON(13) && RUN(ph)) { pg8::Gemm g{MIX, WSP(bf16, WS_WOUT1), M, D, D}; pg8::StaticOrder S; S.init(M, D, F.G, (int)blockIdx.x);
                pg8::EpiYSsq E{Y, D, SSQ}; pg8::gemm_phase<pg8::EpiYSsq, pg8::StaticOrder, true, true>(F.lds, g, S, E); }
            SEAM(ph); ++ph;
            if (PON(1) && RUN(ph)) thin_phase(F, q, q + 1);
            SEAM(ph); ++ph; ++q;
        }
    }
#undef RUN
#undef SEAM
}

extern "C" void kernel_launch(void* const* d_in, const int* in_sizes, int n_in, void* d_out, int out_size, void* d_ws, size_t ws_size, hipStream_t stream) {
    static int grid = 0;
    if (grid == 0) {
        if (n_in != 21 || out_size != M * D || ws_size < WS_END) { fprintf(stderr, "kernel_launch: unexpected shapes (n_in %d, out %d, ws %zu < %zu)\n", n_in, out_size, ws_size, (size_t)WS_END); grid = -1; return; }
        int dev = 0, cus = 0, per_cu = 0;
        if (hipGetDevice(&dev) != hipSuccess || hipDeviceGetAttribute(&cus, hipDeviceAttributeMultiprocessorCount, dev) != hipSuccess) { grid = -1; return; }
        if (hipFuncSetAttribute((const void*)mk_fwd, hipFuncAttributeMaxDynamicSharedMemorySize, LDS_BYTES) != hipSuccess) { fprintf(stderr, "kernel_launch: hipFuncSetAttribute failed\n"); grid = -1; return; }
        if (hipOccupancyMaxActiveBlocksPerMultiprocessor(&per_cu, (const void*)mk_fwd, NWAVES * 64, LDS_BYTES) != hipSuccess || per_cu < 1) { fprintf(stderr, "kernel_launch: occupancy query says %d\n", per_cu); }
        (void)hipGetLastError();
        grid = cus;
    }
    if (grid < 0) return;
    (void)hipMemsetAsync((char*)d_ws + WS_CTL, 0, CTL_ZERO_BYTES, stream);
    Args a{};
    for (int i = 0; i < 21; ++i) a.in[i] = d_in[i];
    a.out = (float*)d_out; a.ws = (unsigned char*)d_ws;
#if MK_LAUNCH_PER_PHASE
    for (int p = 0; p < NPH; ++p) { a.ph_lo = p; a.ph_hi = p + 1; hipLaunchKernelGGL(mk_fwd, dim3(grid), dim3(NWAVES * 64), LDS_BYTES, stream, a); }
#else
    a.ph_lo = 0; a.ph_hi = NPH; hipLaunchKernelGGL(mk_fwd, dim3(grid), dim3(NWAVES * 64), LDS_BYTES, stream, a);
#endif
}
```

```cpp
#include <hip/hip_runtime.h>
#include <cstdio>
#include <cstdint>
namespace pg8 {
#define PG8_LAS __attribute__((address_space(3)))
typedef unsigned short bf16_t;
typedef short bf16x8 __attribute__((ext_vector_type(8)));
typedef float f32x4 __attribute__((ext_vector_type(4)));
typedef unsigned u32x4 __attribute__((ext_vector_type(4)));
constexpr int BM = 256, BK = 64, HALF = 128, HTB = HALF * BK * 2  , STAGE_BYTES = 8 * HTB, NXCD = 8, WGM = 8;

__host__ __device__ __forceinline__ int lds_byte(int r, int c) { const int st = (r >> 4) * 2 + (c >> 5), rr = r & 15, cc = c & 31, ob = rr * 64 + cc * 2; return st * 1024 + (ob ^ (((ob >> 9) & 1) << 5)); }
__host__ __device__ __forceinline__ void stage_rc(int b, int& R, int& C) { const int st = b / 1024, sb = b % 1024, swz = sb ^ (((sb >> 9) & 1) << 5); R = (st >> 1) * 16 + swz / 64; C = (st & 1) * 32 + (swz % 64) / 2; }
__host__ __device__ __forceinline__ int perm32(int rho) { const int n = rho >> 4, i = rho & 15; return 8 * (i >> 2) + 4 * n + (i & 3); }

struct Unit { int pm, pn; };
struct Gemm { const bf16_t* A; const bf16_t* Bt; int M, N, K; };

struct StaticOrder {
    int nM, nN, nwg, G, c;
    __host__ __device__ void init(int M, int N, int G_, int c_) { nM = M / BM; nN = N / BM; nwg = nM * nN; G = G_; c = c_; }
    __host__ __device__ bool next(int i, Unit& u) const {
        const long L = (long)i * G + c; if (L >= nwg) return false;
        int wgid = (int)L; { const int q = nwg / NXCD, r = nwg % NXCD, xcd = wgid % NXCD, off = wgid / NXCD; wgid = (xcd < r ? xcd * (q + 1) : r * (q + 1) + (xcd - r) * q) + off; }
        const int nig = WGM * nN, gid = wgid / nig, fm = gid * WGM, gsz = (nM - fm) < WGM ? (nM - fm) : WGM;
        u.pm = fm + ((wgid % nig) % gsz); u.pn = (wgid % nig) / gsz; return true;
    }
    __device__ __forceinline__ void a_ready(const Unit&) const {}
    __device__ __forceinline__ void done(const Unit&) const {}
};

__device__ __forceinline__ unsigned cvt_pk_bf16(float lo, float hi) { unsigned r; asm volatile("v_cvt_pk_bf16_f32 %0, %1, %2" : "=v"(r) : "v"(lo), "v"(hi)); return r; }
typedef float f32x2 __attribute__((ext_vector_type(2)));
__device__ __forceinline__ float silu_f(float v) { return v * __builtin_amdgcn_rcpf(1.0f + __expf(-v)); }

struct EpiGateUp {
    static constexpr bool PERM = true, AFTER_DRAIN = false;
    bf16_t* O; int ldc;
    __device__ __forceinline__ void operator()(const f32x4 (&acc)[2][2][4][2], const Unit& u, int wr, int wc, int fr, int fq) const {
        const int row0 = u.pm * BM + wr * 64 + fr, col0 = u.pn * HALF + wc * 32 + 8 * fq;
#pragma unroll
        for (int ai = 0; ai < 2; ++ai)
#pragma unroll
            for (int m = 0; m < 4; ++m) { bf16_t* rowp = O + (size_t)(row0 + ai * HALF + m * 16) * ldc + col0;
                const f32x4 g0 = acc[ai][0][m][0], g1 = acc[ai][0][m][1], u0 = acc[ai][1][m][0], u1 = acc[ai][1][m][1];
                f32x4 v0, v1;
#pragma unroll
                for (int j = 0; j < 4; ++j) { v0[j] = silu_f(g0[j]) * u0[j]; v1[j] = silu_f(g1[j]) * u1[j]; }
                u32x4 w; w.x = cvt_pk_bf16(v0[0], v0[1]); w.y = cvt_pk_bf16(v0[2], v0[3]); w.z = cvt_pk_bf16(v1[0], v1[1]); w.w = cvt_pk_bf16(v1[2], v1[3]);
                *(u32x4*)rowp = w; }
    }
};
struct EpiYSsq {
    static constexpr bool PERM = false, AFTER_DRAIN = false;
    float* C; int ldc; float* ssq;
    __device__ __forceinline__ void operator()(const f32x4 (&acc)[2][2][4][2], const Unit& u, int wr, int wc, int fr, int fq) const {
        const int row0 = u.pm * BM + wr * 64 + fr, col0 = u.pn * BM + wc * 32 + 4 * fq;
#pragma unroll
        for (int ai = 0; ai < 2; ++ai)
#pragma unroll
            for (int m = 0; m < 4; ++m) { const int row = row0 + ai * HALF + m * 16; float* rowp = C + (size_t)row * ldc + col0; float s = 0.f;
#pragma unroll
                for (int bj = 0; bj < 2; ++bj)
#pragma unroll
                    for (int n = 0; n < 2; ++n) { const f32x4 v = acc[ai][bj][m][n]; *(f32x4*)(rowp + bj * HALF + n * 16) = v; s += (v[0] * v[0] + v[1] * v[1]) + (v[2] * v[2] + v[3] * v[3]); }
                s += __shfl_xor(s, 16); s += __shfl_xor(s, 32);
                if (fq == 0) ssq[(size_t)row * 32 + u.pn * 4 + wc] = s; }
    }
};
struct EpiProj {
    static constexpr bool PERM = true, AFTER_DRAIN = false;
    bf16_t* O; int ldo; int nbf; float* Fo; int ldf;
    __device__ __forceinline__ void operator()(const f32x4 (&acc)[2][2][4][2], const Unit& u, int wr, int wc, int fr, int fq) const {
        const int row0 = u.pm * BM + wr * 64 + fr;
        if (u.pn < nbf) {
            const int col0 = u.pn * BM + wc * 32 + 8 * fq;
#pragma unroll
            for (int ai = 0; ai < 2; ++ai)
#pragma unroll
                for (int m = 0; m < 4; ++m) { bf16_t* rowp = O + (size_t)(row0 + ai * HALF + m * 16) * ldo + col0;
#pragma unroll
                    for (int bj = 0; bj < 2; ++bj) { const f32x4 v0 = acc[ai][bj][m][0], v1 = acc[ai][bj][m][1];
                        u32x4 w; w.x = cvt_pk_bf16(v0[0], v0[1]); w.y = cvt_pk_bf16(v0[2], v0[3]); w.z = cvt_pk_bf16(v1[0], v1[1]); w.w = cvt_pk_bf16(v1[2], v1[3]);
                        *(u32x4*)(rowp + bj * HALF) = w; } }
        } else {
            const int col0 = (u.pn - nbf) * BM + wc * 32 + 8 * fq;
#pragma unroll
            for (int ai = 0; ai < 2; ++ai)
#pragma unroll
                for (int m = 0; m < 4; ++m) { float* rowp = Fo + (size_t)(row0 + ai * HALF + m * 16) * ldf + col0;
#pragma unroll
                    for (int bj = 0; bj < 2; ++bj) { *(f32x4*)(rowp + bj * HALF) = acc[ai][bj][m][0]; *(f32x4*)(rowp + bj * HALF + 4) = acc[ai][bj][m][1]; } }
        }
    }
};
template <class Epi, class Sched, bool ALIGN_EPI = false, bool SP2 = false>
__device__ __forceinline__ void gemm_phase(PG8_LAS unsigned char* lds, const Gemm g, const Sched& S, const Epi& E) {
    int tid_ = threadIdx.x; asm volatile("" : "+v"(tid_));
    const int tid = tid_, wid = __builtin_amdgcn_readfirstlane(tid >> 6), lane = tid & 63, wr = wid >> 2, wc = wid & 3, fr = lane & 15, fq = lane >> 4;
    const int K = g.K, nt = K / BK;
    unsigned voffA[2], voffB[2];
#pragma unroll
    for (int i = 0; i < 2; ++i) { int R, C; stage_rc(tid * 16 + i * 8192, R, C); const int Rb = Epi::PERM ? ((R & ~31) + perm32(R & 31)) : R;
        voffA[i] = (unsigned)(R * K + C) * 2u; voffB[i] = (unsigned)(Rb * K + C) * 2u; }
    const size_t kstep = (size_t)(BK * 2);
    const size_t hstep = (size_t)HALF * K * 2;
    const size_t tstep = 2 * hstep;
    const unsigned ldsw = (unsigned)wid * 1024u;
    const int aoff = lds_byte(wr * 64 + fr, fq * 8), boff = lds_byte(wc * 32 + fr, fq * 8);
#define PG8_SA(b, h) (((b) * 2 + (h)) * HTB)
#define PG8_SB(b, h) ((4 + (b) * 2 + (h)) * HTB)
#define PG8_STAGE(bufoff, gbase, voff) do { _Pragma("unroll") for (int _i = 0; _i < 2; ++_i) \
        __builtin_amdgcn_global_load_lds((const unsigned*)((const char*)(gbase) + (voff)[_i]), (PG8_LAS unsigned*)(lds + (bufoff) + ldsw + _i * 8192), 16, 0, 0); } while (0)
#define PG8_LDA(dst, b, h) do { _Pragma("unroll") for (int m = 0; m < 4; ++m) _Pragma("unroll") for (int k = 0; k < 2; ++k) dst[m][k] = *(const PG8_LAS bf16x8*)(lds + PG8_SA(b, h) + aoff + m * 2048 + k * 1024); } while (0)
#define PG8_LDB(dst, b, h) do { _Pragma("unroll") for (int n = 0; n < 2; ++n) _Pragma("unroll") for (int k = 0; k < 2; ++k) dst[n][k] = *(const PG8_LAS bf16x8*)(lds + PG8_SB(b, h) + boff + n * 2048 + k * 1024); } while (0)
#define PG8_MMA(ai, bj, At, Bt) do { __builtin_amdgcn_s_setprio(1); _Pragma("unroll") for (int m = 0; m < 4; ++m) _Pragma("unroll") for (int n = 0; n < 2; ++n) _Pragma("unroll") for (int k = 0; k < 2; ++k) \
        acc[ai][bj][m][n] = __builtin_amdgcn_mfma_f32_16x16x32_bf16(Bt[n][k], At[m][k], acc[ai][bj][m][n], 0, 0, 0); __builtin_amdgcn_s_setprio(0); } while (0)
#define PG8_WAIT_V(n) asm volatile("s_waitcnt vmcnt(" #n ")" ::: "memory")
#define PG8_WAIT_L(n) asm volatile("s_waitcnt lgkmcnt(" #n ")" ::: "memory")
#define PG8_BAR __builtin_amdgcn_s_barrier()
#define PG8_SCHED __builtin_amdgcn_sched_barrier(0)
    Unit cur, nxt; int ui = 0;
    if (!S.next(0, cur)) return;
    f32x4 acc[2][2][4][2];
#pragma unroll
    for (int a = 0; a < 2; ++a)
#pragma unroll
        for (int b = 0; b < 2; ++b)
#pragma unroll
            for (int m = 0; m < 4; ++m)
#pragma unroll
                for (int n = 0; n < 2; ++n) acc[a][b][m][n] = (f32x4){0.f, 0.f, 0.f, 0.f};
    bf16x8 At[4][2], B0[2][2], B1[2][2];
    const char* cA = (const char*)g.A + (size_t)cur.pm * tstep; const char* cB = (const char*)g.Bt + (size_t)cur.pn * tstep;
    S.a_ready(cur);
    if constexpr (SP2) {
        PG8_STAGE(PG8_SB(0, 0), cB, voffB); PG8_STAGE(PG8_SB(0, 1), cB + hstep, voffB); PG8_STAGE(PG8_SA(0, 0), cA, voffA); PG8_STAGE(PG8_SA(0, 1), cA + hstep, voffA);
        if (wr == 1) PG8_BAR;
        PG8_WAIT_V(2); PG8_BAR;
        PG8_STAGE(PG8_SB(1, 0), cB + kstep, voffB); PG8_STAGE(PG8_SA(1, 0), cA + kstep, voffA); PG8_STAGE(PG8_SB(1, 1), cB + hstep + kstep, voffB);
        PG8_WAIT_V(6); PG8_BAR;
    } else {
        PG8_STAGE(PG8_SB(0, 0), cB, voffB); PG8_STAGE(PG8_SA(0, 0), cA, voffA); PG8_STAGE(PG8_SB(0, 1), cB + hstep, voffB); PG8_STAGE(PG8_SA(0, 1), cA + hstep, voffA);
        if (wr == 1) PG8_BAR;
        PG8_WAIT_V(4); PG8_BAR;
        PG8_STAGE(PG8_SB(1, 0), cB + kstep, voffB); PG8_STAGE(PG8_SA(1, 0), cA + kstep, voffA); PG8_STAGE(PG8_SB(1, 1), cB + hstep + kstep, voffB);
        PG8_WAIT_V(6); PG8_BAR;
    }
    for (;;) {
        const bool has_next = S.next(ui + 1, nxt);
        const char* nA = has_next ? (const char*)g.A + (size_t)nxt.pm * tstep : cA; const char* nB = has_next ? (const char*)g.Bt + (size_t)nxt.pn * tstep : cB;
        for (int t = 0; t < nt; t += 2) {
            const bool last = (t == nt - 2);
            const char* a1 = cA + (size_t)(t + 1) * kstep;
            const char* a2 = last ? nA : cA + (size_t)(t + 2) * kstep; const char* b2 = last ? nB : cB + (size_t)(t + 2) * kstep;
            const char* a3 = a2 + kstep; const char* b3 = b2 + kstep;
            if (last && has_next) S.a_ready(nxt);
            if constexpr (SP2) {
            PG8_LDB(B0, 0, 0); PG8_LDB(B1, 0, 1); PG8_SCHED; PG8_LDA(At, 0, 0); PG8_STAGE(PG8_SA(1, 1), a1 + hstep, voffA);
            PG8_WAIT_V(8); PG8_WAIT_L(0); PG8_BAR; PG8_MMA(0, 0, At, B0); PG8_MMA(0, 1, At, B1); PG8_BAR; PG8_SCHED;
            PG8_LDA(At, 0, 1); PG8_STAGE(PG8_SB(0, 0), b2, voffB); PG8_STAGE(PG8_SB(0, 1), b2 + hstep, voffB); PG8_STAGE(PG8_SA(0, 0), a2, voffA);
            PG8_WAIT_V(8); PG8_WAIT_L(0); PG8_BAR; PG8_MMA(1, 0, At, B0); PG8_MMA(1, 1, At, B1); PG8_BAR; PG8_SCHED;
            PG8_LDB(B0, 1, 0); PG8_LDB(B1, 1, 1); PG8_SCHED; PG8_LDA(At, 1, 0); PG8_STAGE(PG8_SA(0, 1), a2 + hstep, voffA);
            PG8_WAIT_V(8); PG8_WAIT_L(0); PG8_BAR; PG8_MMA(0, 0, At, B0); PG8_MMA(0, 1, At, B1); PG8_BAR; PG8_SCHED;
            PG8_LDA(At, 1, 1); PG8_STAGE(PG8_SB(1, 0), b3, voffB); PG8_STAGE(PG8_SB(1, 1), b3 + hstep, voffB); PG8_STAGE(PG8_SA(1, 0), a3, voffA);
            PG8_WAIT_V(8); PG8_WAIT_L(0); PG8_BAR; PG8_MMA(1, 0, At, B0); PG8_MMA(1, 1, At, B1); PG8_BAR; PG8_SCHED;
            } else {
            PG8_LDB(B0, 0, 0); PG8_SCHED; PG8_LDA(At, 0, 0); PG8_STAGE(PG8_SA(1, 1), a1 + hstep, voffA);
            PG8_WAIT_L(8); PG8_BAR; PG8_WAIT_L(0); PG8_MMA(0, 0, At, B0); PG8_BAR; PG8_SCHED;
            PG8_LDB(B1, 0, 1); PG8_STAGE(PG8_SB(0, 0), b2, voffB);
            PG8_BAR; PG8_WAIT_L(0); PG8_MMA(0, 1, At, B1); PG8_BAR;
            PG8_LDA(At, 0, 1); PG8_STAGE(PG8_SA(0, 0), a2, voffA);
            PG8_BAR; PG8_WAIT_L(0); PG8_MMA(1, 0, At, B0); PG8_BAR; PG8_SCHED;
            PG8_STAGE(PG8_SB(0, 1), b2 + hstep, voffB);
            PG8_WAIT_V(6); PG8_BAR; PG8_MMA(1, 1, At, B1); PG8_BAR;
            PG8_LDB(B0, 1, 0); PG8_SCHED; PG8_LDA(At, 1, 0); PG8_STAGE(PG8_SA(0, 1), a2 + hstep, voffA);
            PG8_WAIT_L(8); PG8_BAR; PG8_WAIT_L(0); PG8_MMA(0, 0, At, B0); PG8_BAR; PG8_SCHED;
            PG8_LDB(B1, 1, 1); PG8_STAGE(PG8_SB(1, 0), b3, voffB);
            PG8_BAR; PG8_WAIT_L(0); PG8_MMA(0, 1, At, B1); PG8_BAR;
            PG8_LDA(At, 1, 1); PG8_STAGE(PG8_SA(1, 0), a3, voffA);
            PG8_BAR; PG8_WAIT_L(0); PG8_MMA(1, 0, At, B0); PG8_BAR; PG8_SCHED;
            PG8_STAGE(PG8_SB(1, 1), b3 + hstep, voffB);
            PG8_WAIT_V(6); PG8_BAR; PG8_MMA(1, 1, At, B1); PG8_BAR;
            }
        }
        if constexpr (ALIGN_EPI) { if (wr == 0) PG8_BAR; }
        if constexpr (!Epi::AFTER_DRAIN) { E(acc, cur, wr, wc, fr, fq); S.done(cur); }
        if (!has_next) break;
#pragma unroll
        for (int a = 0; a < 2; ++a)
#pragma unroll
            for (int b = 0; b < 2; ++b)
#pragma unroll
                for (int m = 0; m < 4; ++m)
#pragma unroll
                    for (int n = 0; n < 2; ++n) acc[a][b][m][n] = (f32x4){0.f, 0.f, 0.f, 0.f};
        cur = nxt; cA = nA; cB = nB; ++ui;
        if constexpr (ALIGN_EPI) { if (wr == 1) PG8_BAR; }
    }
    PG8_WAIT_V(0);
    if constexpr (!ALIGN_EPI) { if (wr == 0) PG8_BAR; }
    PG8_BAR;
    if constexpr (Epi::AFTER_DRAIN) { E.fused(acc, cur, wr, wc, fr, fq, lds, wid, lane); S.done(cur); }
#undef PG8_SA
#undef PG8_SB
#undef PG8_STAGE
#undef PG8_LDA
#undef PG8_LDB
#undef PG8_MMA
#undef PG8_WAIT_V
#undef PG8_WAIT_L
#undef PG8_BAR
#undef PG8_SCHED
}
}
#define GAS __attribute__((address_space(1)))
#define LAS __attribute__((address_space(3)))
typedef unsigned short bf16;
typedef unsigned v4u __attribute__((ext_vector_type(4)));
typedef float f32x4 __attribute__((ext_vector_type(4)));
typedef short bf16x8 __attribute__((ext_vector_type(8)));
typedef GAS unsigned gu32;
typedef GAS unsigned long long gu64;
#define RLX_AGENT __ATOMIC_RELAXED, __HIP_MEMORY_SCOPE_AGENT
#define LDS_WAIT() asm volatile("s_waitcnt lgkmcnt(0)" ::: "memory")
#define VM_WAIT() asm volatile("s_waitcnt vmcnt(0)" ::: "memory")
__device__ __forceinline__ unsigned long long rt() { return __builtin_amdgcn_s_memrealtime(); }
__device__ __forceinline__ unsigned f2bf(float f) { unsigned u = __builtin_bit_cast(unsigned, f); return (u + 0x7fffu + ((u >> 16) & 1u)) >> 16; }
__device__ __forceinline__ unsigned pk2(float lo, float hi) { return f2bf(lo) | (f2bf(hi) << 16); }

#define XB_TMO      128
#define XB_XCNT(j)  (256  + 64 * (j))
#define XB_XSUB(j)  (1280 + 64 * (j))
#define XB_XGEN(j)  (2304 + 64 * (j))
#define XB_TOP      3328
#define XB_TOPGEN   3392
#define XCD_BAR_WORDS 3456
#define XB_SPIN_CAP (1u << 18)

__device__ __forceinline__ unsigned xb_ld(unsigned* p)              { return __hip_atomic_load(p, __ATOMIC_RELAXED, __HIP_MEMORY_SCOPE_AGENT); }
__device__ __forceinline__ unsigned xb_add(unsigned* p, unsigned v) { return __hip_atomic_fetch_add(p, v, __ATOMIC_RELAXED, __HIP_MEMORY_SCOPE_AGENT); }
__device__ __forceinline__ unsigned xb_xcc_id() { return (unsigned)__builtin_amdgcn_s_getreg((3 << 11) | 20) & 0xFu; }
#define XB_SPIN(cond, bar) do { unsigned _sp = 0; while (cond) { __builtin_amdgcn_s_sleep(1); \
    if ((++_sp & 255u) == 0u) { if (xb_ld(&(bar)[XB_TMO])) break; if (_sp > XB_SPIN_CAP) { atomicAdd(&(bar)[XB_TMO], 1u); break; } } } } while (0)

struct XcdBarrier {
    unsigned* bar; unsigned x;
    volatile LAS unsigned* st;
};

__device__ __forceinline__ XcdBarrier xcd_barrier_post(unsigned* bar, volatile LAS unsigned* st) {
    XcdBarrier b; b.bar = bar; b.x = xb_xcc_id(); b.st = st;
    if (threadIdx.x == 0) (void)xb_add(&bar[XB_XCNT(b.x)], 1u);
    return b;
}
__device__ __forceinline__ void xcd_barrier_complete(unsigned* bar, unsigned x, unsigned& nloc, unsigned& nx) {
    const unsigned G = gridDim.x * gridDim.y * gridDim.z;
    unsigned sum, cnt, mine, sp = 0u;
    for (;;) {
        sum = 0u; cnt = 0u; mine = 0u;
#pragma unroll
        for (unsigned j = 0; j < 16; ++j) { const unsigned c = xb_ld(&bar[XB_XCNT(j)]); sum += c; cnt += (c > 0u) ? 1u : 0u; mine = (j == x) ? c : mine; }
        if (sum == G) break;
        __builtin_amdgcn_s_sleep(1);
        if ((++sp & 255u) == 0u) { if (xb_ld(&bar[XB_TMO])) break; if (sp > XB_SPIN_CAP) { atomicAdd(&bar[XB_TMO], 1u); break; } }
    }
    nloc = mine > 0u ? mine : 1u; nx = cnt > 0u ? cnt : 1u;
}

__device__ __forceinline__ void xcd_barrier(const XcdBarrier& b) {
    asm volatile("s_waitcnt vmcnt(0)" ::: "memory");
    __syncthreads();
    if (threadIdx.x == 0) {
        unsigned* bar = b.bar;
        __builtin_amdgcn_s_waitcnt(0);
        unsigned nloc = b.st[0], nx = b.st[1];
        if (nloc == 0u) { xcd_barrier_complete(bar, b.x, nloc, nx); b.st[0] = nloc; b.st[1] = nx; }
        const unsigned old = xb_add(&bar[XB_XSUB(b.x)], 1u);
        const unsigned gen = old / nloc;
        if (old + 1u == (gen + 1u) * nloc) {
            __builtin_amdgcn_fence(__ATOMIC_RELEASE, "agent");
            asm volatile("s_waitcnt vmcnt(0)" ::: "memory");
            const unsigned og = xb_add(&bar[XB_TOP], 1u);
            const unsigned tg = og / nx;
            if (og + 1u == (tg + 1u) * nx) xb_add(&bar[XB_TOPGEN], 1u);
            else XB_SPIN(xb_ld(&bar[XB_TOPGEN]) == tg, bar);
            __builtin_amdgcn_fence(__ATOMIC_ACQUIRE, "agent");
            xb_add(&bar[XB_XGEN(b.x)], 1u);
            asm volatile("s_waitcnt vmcnt(0)" ::: "memory");
        } else {
            XB_SPIN(xb_ld(&bar[XB_XGEN(b.x)]) == gen, bar);
            __builtin_amdgcn_fence(__ATOMIC_ACQUIRE, "agent");
            asm volatile("s_waitcnt vmcnt(0)" ::: "memory");
        }
    }
    __syncthreads();
}


#ifndef MK_LAUNCH_PER_PHASE
#define MK_LAUNCH_PER_PHASE 0
#endif
constexpr int NWAVES = 8;
#ifndef PHASE_MASK
#define PHASE_MASK 0xFFFFFFFFu
#endif
#define PON(i) ((PHASE_MASK >> (i)) & 1u)
#ifndef PROBE_REP_MASK
#define PROBE_REP_MASK 0u
#endif

constexpr int NB = 4, SEQ = 2048, D = 2048, M = NB * SEQ, FF = 5632;
constexpr int IN0 = 14368, IN0P = 14592, IN1 = 3408, IN1P = 3584;
constexpr int MODW = 9 * D;
constexpr float EPS = 1e-6f;
constexpr int NPH = 28;

constexpr size_t MiB = 1u << 20;
constexpr size_t WS_CTL = 0, CTL_ZERO_BYTES = 1 * MiB;
constexpr size_t WS_MODS = 1 * MiB;
constexpr size_t WS_RTC = 2 * MiB, WS_RTS = 6 * MiB;
constexpr size_t WS_RTQ = 10 * MiB;
constexpr size_t WS_RTI = 11 * MiB;
constexpr size_t WS_SSQ = 12 * MiB;
constexpr size_t WS_DTB = 13 * MiB;
constexpr size_t WS_WGU = 24 * MiB;
constexpr size_t WS_WD = 200 * MiB;
constexpr size_t WS_WIN0 = 288 * MiB;
constexpr size_t WS_WOUT0 = 345 * MiB;
constexpr size_t WS_WIN1 = 361 * MiB;
constexpr size_t WS_WOUT1 = 375 * MiB;
constexpr size_t WS_H = 384 * MiB;
constexpr size_t WS_Y = 416 * MiB;
constexpr size_t WS_MIX = 480 * MiB;
constexpr size_t WS_BIG = 544 * MiB;
constexpr size_t WS_CD = 21 * MiB;
constexpr size_t WS_XC = 772 * MiB;
constexpr size_t WS_QR = 836 * MiB, WS_KR = 868 * MiB;
constexpr size_t WS_RST = 900 * MiB;
constexpr size_t WS_RPT = 1028 * MiB;
constexpr size_t WS_SST = WS_Y;
constexpr size_t WS_HP = WS_H;
constexpr size_t WS_IDX = 772 * MiB;
constexpr size_t WS_QA = 812 * MiB;
constexpr size_t WS_KAB = 844 * MiB, WS_VAB = 846 * MiB;
constexpr size_t WS_QIH = 848 * MiB, WS_QIL = 864 * MiB;
constexpr size_t WS_KIH = 880 * MiB, WS_KIL = 881 * MiB;
constexpr size_t WS_WI = 882 * MiB;
constexpr size_t WS_SEL = 884 * MiB;
constexpr size_t WS_NSEL = 892 * MiB;
constexpr size_t WS_END = 1092 * MiB;
constexpr size_t WGU_ELEMS = (size_t)2 * FF * D, WD_ELEMS = (size_t)D * FF;
constexpr int CW_BAR = 4096;

constexpr int RING_BYTES = 131072;
constexpr int LDSCTL_OFF = 146432, MISC_OFF = LDSCTL_OFF + 320;
constexpr int LDS_BYTES = 147456;

__device__ __forceinline__ float bf2f(unsigned short b) { return __uint_as_float(((unsigned)b) << 16); }
__device__ __forceinline__ float bflo(unsigned w) { return __uint_as_float(w << 16); }
__device__ __forceinline__ float bfhi(unsigned w) { return __uint_as_float(w & 0xffff0000u); }
__device__ __forceinline__ float silu(float v) { return v / (1.0f + __expf(-v)); }
__device__ __forceinline__ float wave_sum(float v) {
#pragma unroll
    for (int o = 1; o < 64; o <<= 1) v += __shfl_xor(v, o);
    return v;
}

struct Frame {
    LAS unsigned char* lds;
    int vcu, G;
    const float *x, *c, *mod_w, *mod_b, *norm_w, *w_gate, *w_up, *w_down, *hy_w_in, *conv_w, *conv_b, *A_log, *dt_bias, *ssd_D, *ssd_norm_w, *ret_norm_w, *hy_w_out, *dsa_w_in, *idx_k_norm_w, *dsa_w_out;
    const int* positions;
    float* out;
    unsigned char* ws;
};
#define WSP(T, off) ((T*)(F.ws + (off)))

__device__ __forceinline__ void tr_item(const float* W, int ldn, int K, int k0, int sc, int ncl, bf16* WT, int dr, LAS float* scr, int lane) {
    int cc = sc + (lane & 31); cc = cc < ncl ? cc : ncl - 1;
#pragma unroll 8
    for (int i = 0; i < 32; ++i) { const int kk = 2 * i + (lane >> 5); scr[kk * 33 + (lane & 31)] = W[(size_t)(k0 + kk) * ldn + cc]; }
    LDS_WAIT(); asm volatile("" ::: "memory");
    const int c = lane & 7;
#pragma unroll
    for (int j = 0; j < 4; ++j) { const int n = (lane >> 3) + 8 * j; const LAS float* s = scr + (8 * c) * 33 + n;
        v4u o; o.x = pk2(s[0 * 33], s[1 * 33]); o.y = pk2(s[2 * 33], s[3 * 33]); o.z = pk2(s[4 * 33], s[5 * 33]); o.w = pk2(s[6 * 33], s[7 * 33]);
        *(GAS v4u*)(WT + (size_t)(dr + n) * K + k0 + 8 * c) = o; }
    LDS_WAIT(); asm volatile("" ::: "memory");
}
__device__ __forceinline__ int in0_dst_col(int sc) {
    if (sc < 6144) return sc;
    if (sc < 6176) return 14336 + (sc - 6144);
    return sc - 32;
}
__device__ __forceinline__ void p0_prologue(Frame& F) {
    int tid_ = threadIdx.x; asm volatile("" : "+v"(tid_)); const int TID = tid_, LANE = TID & 63, WAVE = __builtin_amdgcn_readfirstlane(TID >> 6); (void)LANE; (void)WAVE;

    {
        LAS float* cond = (LAS float*)F.lds;
        LAS float* red = (LAS float*)(F.lds + 32768);
        for (int i = TID; i < NB * D; i += NWAVES * 64) cond[i] = silu(F.c[i]);
        __syncthreads();
        float* MODS = WSP(float, WS_MODS);
        for (int u = F.vcu; u < 256; u += F.G) {
            const int col0 = 144 * u, layer = col0 / MODW, j0 = col0 % MODW;
            const int cq = TID % 36, ks = TID / 36;
            if (ks < 14) {
                f32x4 a0 = {0.f, 0.f, 0.f, 0.f}, a1 = a0, a2 = a0, a3 = a0;
                const int kb = ks * 147, ke = (kb + 147 < D) ? kb + 147 : D;
                const float* wp = F.mod_w + (size_t)layer * D * MODW + j0 + 4 * cq;
#pragma unroll 4
                for (int k = kb; k < ke; ++k) { const f32x4 w = *(const f32x4*)(wp + (size_t)k * MODW);
                    a0 += cond[k] * w; a1 += cond[D + k] * w; a2 += cond[2 * D + k] * w; a3 += cond[3 * D + k] * w; }
                LAS float* r = red + (ks * 36 + cq) * 16;
                *(LAS f32x4*)(r) = a0; *(LAS f32x4*)(r + 4) = a1; *(LAS f32x4*)(r + 8) = a2; *(LAS f32x4*)(r + 12) = a3;
            }
            __syncthreads();
            for (int o = TID; o < 576; o += NWAVES * 64) { const int cq2 = o / 16, r = o % 16, b = r / 4, e = r % 4; float s = 0.f;
#pragma unroll
                for (int k2 = 0; k2 < 14; ++k2) s += red[(k2 * 36 + cq2) * 16 + r];
                const int j = j0 + 4 * cq2 + e;
                MODS[(size_t)(layer * 4 + b) * MODW + j] = s + F.mod_b[layer * MODW + j]; }
            __syncthreads();
        }
    }
    {
        const int gt = F.vcu * NWAVES * 64 + TID, NT = F.G * NWAVES * 64;
        const double INV2PI = 0.15915494309189535;
        float* rc = WSP(float, WS_RTC); float* rs = WSP(float, WS_RTS);
        for (int idx = gt; idx < M * 128; idx += NT) { const int row = idx >> 7, i = idx & 127;
            const double inv = exp2(-(double)i * (13.287712379549449 / 128.0));
            const double rev = (double)F.positions[row] * inv * INV2PI; const float fr = (float)(rev - rint(rev));
            rc[idx] = __builtin_amdgcn_cosf(fr); rs[idx] = __builtin_amdgcn_sinf(fr); }
        float* qc = WSP(float, WS_RTQ); float* qs = qc + M * 16;
        for (int idx = gt; idx < M * 16; idx += NT) { const int row = idx >> 4, i = idx & 15;
            const double inv = exp2(-(double)i * (18.931568569324174 / 16.0));
            const double rev = (double)F.positions[row] * inv * INV2PI; const float fr = (float)(rev - rint(rev));
            qc[idx] = __builtin_amdgcn_cosf(fr); qs[idx] = __builtin_amdgcn_sinf(fr); }
        float* ic = WSP(float, WS_RTI); float* is = ic + M * 8;
        for (int idx = gt; idx < M * 8; idx += NT) { const int row = idx >> 3, i = idx & 7;
            const double inv = exp2(-(double)i * (18.931568569324174 / 8.0));
            const double rev = (double)F.positions[row] * inv * INV2PI; const float fr = (float)(rev - rint(rev));
            ic[idx] = __builtin_amdgcn_cosf(fr); is[idx] = __builtin_amdgcn_sinf(fr); }
    }
    {
        LAS float* scr = (LAS float*)(F.lds + WAVE * 8448);
        const int gw = F.vcu * NWAVES + WAVE, NGW = F.G * NWAVES;
        constexpr int I_G = 32 * 176, I_D = 88 * 64, I_FFN = 2 * I_G + I_D;
        constexpr int I_IN0 = 32 * 449, I_OUT0 = 64 * 64, I_IN1 = 32 * 107, I_OUT1 = 32 * 64;
        constexpr int NITEMS = 4 * I_FFN + I_IN0 + I_OUT0 + I_IN1 + I_OUT1;
        bf16* Wgu = WSP(bf16, WS_WGU); bf16* Wd = WSP(bf16, WS_WD);
        for (int it = gw; it < NITEMS; it += NGW) {
            int r = it;
            if (r < 4 * I_FFN) { const int s = r / I_FFN; r -= s * I_FFN;
                if (r < 2 * I_G) { const int up = r / I_G; r -= up * I_G; const int kb = r / 176, nb = r % 176, sc = 32 * nb;
                    const float* W = (up ? F.w_up : F.w_gate) + (size_t)s * D * FF;
                    tr_item(W, FF, D, 64 * kb, sc, FF, Wgu + (size_t)s * WGU_ELEMS, 256 * (sc / 128) + 128 * up + (sc % 128), scr, LANE); }
                else { r -= 2 * I_G; const int kb = r / 64, nb = r % 64;
                    tr_item(F.w_down + (size_t)s * FF * D, D, FF, 64 * kb, 32 * nb, D, Wd + (size_t)s * WD_ELEMS, 32 * nb, scr, LANE); }
                continue; }
            r -= 4 * I_FFN;
            if (r < I_IN0) { const int kb = r / 449, nb = r % 449, sc = 32 * nb; tr_item(F.hy_w_in, IN0, D, 64 * kb, sc, IN0, WSP(bf16, WS_WIN0), in0_dst_col(sc), scr, LANE); continue; }
            r -= I_IN0;
            if (r < I_OUT0) { const int kb = r / 64, nb = r % 64; tr_item(F.hy_w_out, D, 2 * D, 64 * kb, 32 * nb, D, WSP(bf16, WS_WOUT0), 32 * nb, scr, LANE); continue; }
            r -= I_OUT0;
            if (r < I_IN1) { const int kb = r / 107, nb = r % 107; tr_item(F.dsa_w_in, IN1, D, 64 * kb, 32 * nb, IN1, WSP(bf16, WS_WIN1), 32 * nb, scr, LANE); continue; }
            r -= I_IN1;
            { const int kb = r / 64, nb = r % 64; tr_item(F.dsa_w_out, D, D, 64 * kb, 32 * nb, D, WSP(bf16, WS_WOUT1), 32 * nb, scr, LANE); }
        }
    }
}

__device__ __forceinline__ void thin_phase(Frame& F, int prevq, int nextq) {
    int tid_ = threadIdx.x; asm volatile("" : "+v"(tid_)); const int TID = tid_, LANE = TID & 63, WAVE = __builtin_amdgcn_readfirstlane(TID >> 6); (void)LANE; (void)WAVE;

    const int gw = F.vcu * NWAVES + WAVE, NGW = F.G * NWAVES;
    const float* xin = (prevq <= 0) ? F.x : F.out;
    const float* Y = WSP(float, WS_Y); const float* SSQ = WSP(float, WS_SSQ); const float* MODS = WSP(float, WS_MODS); bf16* H = WSP(bf16, WS_H);
    for (int row = gw; row < M; row += NGW) {
        const int b = row >> 11;
        f32x4 xv[8];
        const f32x4* xr = (const f32x4*)(xin + (size_t)row * D) + LANE;
#pragma unroll
        for (int j = 0; j < 8; ++j) xv[j] = xr[64 * j];
        if (prevq >= 0) {
            const int pl = prevq / 3, pj = prevq % 3; const float rw = (pj == 1) ? 1.0f : 0.5f;
            float s = (LANE < 32) ? SSQ[(size_t)row * 32 + LANE] : 0.f; s = wave_sum(s);
            const float sc = rw * rsqrtf(s * (1.0f / D) + EPS);
            const f32x4* yr = (const f32x4*)(Y + (size_t)row * D) + LANE;
            const f32x4* pw = (const f32x4*)(F.norm_w + (size_t)(pl * 6 + 2 * pj + 1) * D) + LANE;
            const f32x4* gt = (const f32x4*)(MODS + (size_t)(pl * 4 + b) * MODW + (3 * pj + 2) * D) + LANE;
            f32x4* xo = (f32x4*)(F.out + (size_t)row * D) + LANE;
#pragma unroll
            for (int j = 0; j < 8; ++j) { xv[j] = xv[j] + sc * (gt[64 * j] * yr[64 * j] * pw[64 * j]); xo[64 * j] = xv[j]; }
        }
        if (nextq >= 0) {
            const int nl = nextq / 3, nj = nextq % 3;
            float s = 0.f;
#pragma unroll
            for (int j = 0; j < 8; ++j) s += (xv[j].x * xv[j].x + xv[j].y * xv[j].y) + (xv[j].z * xv[j].z + xv[j].w * xv[j].w);
            const float rstd = rsqrtf(wave_sum(s) * (1.0f / D) + EPS);
            const f32x4* pw = (const f32x4*)(F.norm_w + (size_t)(nl * 6 + 2 * nj) * D) + LANE;
            const f32x4* sh = (const f32x4*)(MODS + (size_t)(nl * 4 + b) * MODW + (3 * nj) * D) + LANE;
            const f32x4* scp = (const f32x4*)(MODS + (size_t)(nl * 4 + b) * MODW + (3 * nj + 1) * D) + LANE;
            unsigned long long* o8 = (unsigned long long*)(H + (size_t)row * D) + LANE;
#pragma unroll
            for (int j = 0; j < 8; ++j) { const f32x4 h = (xv[j] * rstd) * pw[64 * j] * (scp[64 * j] + 1.0f) + sh[64 * j];
                o8[64 * j] = (unsigned long long)pk2(h.x, h.y) | ((unsigned long long)pk2(h.z, h.w) << 32); }
        }
    }
}

typedef float f32x16 __attribute__((ext_vector_type(16)));
typedef float f32x2v __attribute__((ext_vector_type(2)));
typedef __bf16 bf16x2v __attribute__((ext_vector_type(2)));
__device__ __forceinline__ unsigned pkbf(float lo, float hi) { return __builtin_bit_cast(unsigned, __builtin_convertvector((f32x2v){lo, hi}, bf16x2v)); }
#define MFMA32(a, b, c) __builtin_amdgcn_mfma_f32_32x32x16_bf16((a), (b), (c), 0, 0, 0)
template <int S> __device__ __forceinline__ bf16x8 pack8(const f32x16& x) {
    v4u p; p.x = pkbf(x[8 * S + 0], x[8 * S + 1]); p.y = pkbf(x[8 * S + 2], x[8 * S + 3]); p.z = pkbf(x[8 * S + 4], x[8 * S + 5]); p.w = pkbf(x[8 * S + 6], x[8 * S + 7]);
    return __builtin_bit_cast(bf16x8, p);
}
__device__ __forceinline__ f32x16 zero16() { f32x16 z;
#pragma unroll
    for (int i = 0; i < 16; ++i) z[i] = 0.f;
    return z; }
struct IdFrag { bf16x8 f0, f1; };
__device__ __forceinline__ IdFrag make_id(int r, int hh) { IdFrag I;
#pragma unroll
    for (int j = 0; j < 8; ++j) { I.f0[j] = (r == 8 * hh + j) ? (short)0x3F80 : (short)0; I.f1[j] = (r == 16 + 8 * hh + j) ? (short)0x3F80 : (short)0; }
    return I; }
__device__ __forceinline__ bf16x8 lfrag(const LAS unsigned char* img, int stride, int row, int col) { return *(const LAS bf16x8*)(img + row * stride + col * 2); }
__device__ __forceinline__ f32x16 to_acc_lds(const LAS unsigned char* img, int stride, int row0, int col0, int r, int hh, const IdFrag& I) {
    f32x16 x = MFMA32(lfrag(img, stride, row0 + r, col0 + 8 * hh), I.f0, zero16());
    return MFMA32(lfrag(img, stride, row0 + r, col0 + 16 + 8 * hh), I.f1, x);
}
__device__ __forceinline__ f32x16 to_acc_glb(const bf16* base, size_t ld, int r, int hh, const IdFrag& I) {
    f32x16 x = MFMA32(*(const bf16x8*)(base + (size_t)r * ld + 8 * hh), I.f0, zero16());
    return MFMA32(*(const bf16x8*)(base + (size_t)r * ld + 16 + 8 * hh), I.f1, x);
}
__device__ __forceinline__ int crow(int i, int hh) { return (i & 3) + 8 * (i >> 2) + 4 * hh; }

constexpr int XS_STRIDE = 528, BC_STRIDE = 272;
constexpr int L0_XS = 0, L0_BM = 128 * XS_STRIDE, L0_CM = L0_BM + 128 * BC_STRIDE, L0_TAB = L0_CM + 128 * BC_STRIDE;
constexpr int L0_K = 0, L0_V = 128 * XS_STRIDE, L0_RS = 2 * 128 * XS_STRIDE;
static_assert(L0_TAB + 3 * 2048 <= LDSCTL_OFF && L0_RS + 1024 <= LDSCTL_OFF, "LDS map (layer-0 mixer)");

__device__ __forceinline__ void m0_prep(Frame& F) {
    int tid_ = threadIdx.x; asm volatile("" : "+v"(tid_)); const int TID = tid_;
    const int gt = F.vcu * NWAVES * 64 + TID, NT = F.G * NWAVES * 64;
    const bf16* PB = WSP(bf16, WS_BIG); bf16* XC = WSP(bf16, WS_XC);
    for (int idx = gt; idx < M * 512; idx += NT) {
        const int row = idx >> 9, c8 = (idx & 511) * 8, t = row & (SEQ - 1);
        float a[8];
#pragma unroll
        for (int e = 0; e < 8; ++e) a[e] = F.conv_b[c8 + e];
#pragma unroll
        for (int j = 0; j < 4; ++j) { const int tt = t - 3 + j; if (tt < 0) continue;
            const v4u u = *(const v4u*)(PB + (size_t)(row - 3 + j) * IN0P + 2048 + c8);
            const float* w = F.conv_w + (size_t)j * 4096 + c8;
            a[0] += w[0] * bflo(u.x); a[1] += w[1] * bfhi(u.x); a[2] += w[2] * bflo(u.y); a[3] += w[3] * bfhi(u.y);
            a[4] += w[4] * bflo(u.z); a[5] += w[5] * bfhi(u.z); a[6] += w[6] * bflo(u.w); a[7] += w[7] * bfhi(u.w); }
        v4u o; o.x = pkbf(silu(a[0]), silu(a[1])); o.y = pkbf(silu(a[2]), silu(a[3])); o.z = pkbf(silu(a[4]), silu(a[5])); o.w = pkbf(silu(a[6]), silu(a[7]));
        *(v4u*)(XC + (size_t)row * 4096 + c8) = o;
    }
    const float* rc = WSP(float, WS_RTC); const float* rs = WSP(float, WS_RTS);
    bf16* QR = WSP(bf16, WS_QR); bf16* KR = WSP(bf16, WS_KR);
    for (int idx = gt; idx < M * 128 * 2; idx += NT) {
        const int isk = idx >= M * 128, id2 = isk ? idx - M * 128 : idx;
        const int row = id2 >> 7, r = id2 & 127, h = r >> 4, i0 = (r & 15) * 8;
        const bf16* src = PB + (size_t)row * IN0P + (isk ? 8192 : 6144) + h * 256 + i0;
        const v4u u1 = *(const v4u*)src, u2 = *(const v4u*)(src + 128);
        const float x1[8] = {bflo(u1.x), bfhi(u1.x), bflo(u1.y), bfhi(u1.y), bflo(u1.z), bfhi(u1.z), bflo(u1.w), bfhi(u1.w)};
        const float x2[8] = {bflo(u2.x), bfhi(u2.x), bflo(u2.y), bfhi(u2.y), bflo(u2.z), bfhi(u2.z), bflo(u2.w), bfhi(u2.w)};
        const float sc = isk ? 0.0625f : 1.0f;
        float o1[8], o2[8];
#pragma unroll
        for (int e = 0; e < 8; ++e) { const float cs = rc[(size_t)row * 128 + i0 + e], sn = rs[(size_t)row * 128 + i0 + e];
            o1[e] = (x1[e] * cs - x2[e] * sn) * sc; o2[e] = (x1[e] * sn + x2[e] * cs) * sc; }
        bf16* dst = (isk ? KR : QR) + (size_t)row * 2048 + h * 256 + i0;
        v4u w1, w2; w1.x = pkbf(o1[0], o1[1]); w1.y = pkbf(o1[2], o1[3]); w1.z = pkbf(o1[4], o1[5]); w1.w = pkbf(o1[6], o1[7]);
        w2.x = pkbf(o2[0], o2[1]); w2.y = pkbf(o2[2], o2[3]); w2.z = pkbf(o2[4], o2[5]); w2.w = pkbf(o2[6], o2[7]);
        *(v4u*)dst = w1; *(v4u*)(dst + 128) = w2;
    }
}
__device__ __forceinline__ void ssd_tables(Frame& F, int TID, int LANE, int WAVE, LAS float* tab, size_t R0, int g, float* cd) {
    LAS float* cuml = tab; LAS float* dtl = tab + 512; LAS float* wl = tab + 1024;
    { const int row = TID >> 2, hd = TID & 3, h2 = g * 4 + hd; const float v = WSP(float, WS_DTB)[(R0 + row) * 256 + h2] + F.dt_bias[h2];
      const float dt = v > 20.f ? v : log1pf(__expf(v)); dtl[hd * 128 + row] = dt; wl[hd * 128 + row] = -dt * __expf(F.A_log[h2]); }
    __syncthreads();
    if (WAVE < 4) { const float a0 = wl[WAVE * 128 + 2 * LANE], a1 = wl[WAVE * 128 + 2 * LANE + 1]; float p = a0 + a1;
#pragma unroll
        for (int o = 1; o < 64; o <<= 1) { const float t = __shfl_up(p, o); if (LANE >= o) p += t; }
        const float tot = __shfl(p, 63), c0 = p - a1;
        cuml[WAVE * 128 + 2 * LANE] = c0; cuml[WAVE * 128 + 2 * LANE + 1] = p;
        wl[WAVE * 128 + 2 * LANE] = dtl[WAVE * 128 + 2 * LANE] * __expf(tot - c0); wl[WAVE * 128 + 2 * LANE + 1] = dtl[WAVE * 128 + 2 * LANE + 1] * __expf(tot - p);
        if (cd != nullptr && LANE == 0) cd[WAVE] = __expf(tot); }
    __syncthreads();
}
__device__ __forceinline__ void m0_states(Frame& F) {
    int tid_ = threadIdx.x; asm volatile("" : "+v"(tid_)); const int TID = tid_, LANE = TID & 63, WAVE = __builtin_amdgcn_readfirstlane(TID >> 6);
    const int r = LANE & 31, hh = LANE >> 5; const IdFrag I = make_id(r, hh);
    const bf16* XC = WSP(bf16, WS_XC);
    for (int u = F.vcu; u < 1024; u += F.G) {
        __syncthreads();
        if (u < 512) {
            const int bc = u >> 3, g = u & 7; const size_t R0 = (size_t)bc * 128;
            for (int i = TID; i < 4096; i += NWAVES * 64) { const int row = i >> 5, ch = i & 31; *(LAS v4u*)(F.lds + L0_XS + row * XS_STRIDE + ch * 16) = *(const v4u*)(XC + (R0 + row) * 4096 + g * 256 + ch * 8); }
            for (int i = TID; i < 2048; i += NWAVES * 64) { const int row = i >> 4, ch = i & 15; *(LAS v4u*)(F.lds + L0_BM + row * BC_STRIDE + ch * 16) = *(const v4u*)(XC + (R0 + row) * 4096 + 2048 + g * 128 + ch * 8); }
            LAS float* tab = (LAS float*)(F.lds + L0_TAB);
            ssd_tables(F, TID, LANE, WAVE, tab, R0, g, WSP(float, WS_CD) + bc * 32 + g * 4);
            const LAS float* wl = tab + 1024;
            const int head = WAVE >> 1, pt = WAVE & 1;
            f32x16 acc[4];
#pragma unroll
            for (int t = 0; t < 4; ++t) acc[t] = zero16();
#pragma unroll 1
            for (int sb = 0; sb < 4; ++sb) {
                f32x16 X = to_acc_lds(F.lds + L0_XS, XS_STRIDE, sb * 32, head * 64 + pt * 32, r, hh, I);
#pragma unroll
                for (int g4 = 0; g4 < 4; ++g4) { const f32x4 wv = *(const LAS f32x4*)(wl + head * 128 + sb * 32 + 8 * g4 + 4 * hh);
#pragma unroll
                    for (int e = 0; e < 4; ++e) X[4 * g4 + e] *= wv[e]; }
                const bf16x8 A0 = pack8<0>(X), A1 = pack8<1>(X);
#pragma unroll
                for (int nt = 0; nt < 4; ++nt) { const f32x16 XB = to_acc_lds(F.lds + L0_BM, BC_STRIDE, sb * 32, nt * 32, r, hh, I);
                    acc[nt] = MFMA32(A0, pack8<0>(XB), acc[nt]); acc[nt] = MFMA32(A1, pack8<1>(XB), acc[nt]); }
            }
            float* dst = WSP(float, WS_SST) + ((size_t)(bc * 32 + g * 4 + head) * 64 + pt * 32) * 128;
#pragma unroll
            for (int nt = 0; nt < 4; ++nt)
#pragma unroll
                for (int i = 0; i < 16; ++i) dst[(size_t)crow(i, hh) * 128 + nt * 32 + r] = acc[nt][i];
        } else {
            const int u2 = u - 512, bc = u2 >> 3, h = u2 & 7; const size_t R0 = (size_t)bc * 128;
            const bf16* KR = WSP(bf16, WS_KR); const bf16* PB = WSP(bf16, WS_BIG);
            for (int i = TID; i < 4096; i += NWAVES * 64) { const int row = i >> 5, ch = i & 31;
                *(LAS v4u*)(F.lds + L0_K + row * XS_STRIDE + ch * 16) = *(const v4u*)(KR + (R0 + row) * 2048 + h * 256 + ch * 8);
                *(LAS v4u*)(F.lds + L0_V + row * XS_STRIDE + ch * 16) = *(const v4u*)(PB + (R0 + row) * IN0P + 10240 + h * 256 + ch * 8); }
            __syncthreads();
            const float lg = log2f(1.0f - exp2f(-5.0f - (float)h));
            float* dstb = WSP(float, WS_RST) + ((size_t)(bc * 8 + h) * 256 + WAVE * 32) * 256;
#pragma unroll 1
            for (int half = 0; half < 2; ++half) {
                f32x16 acc[4];
#pragma unroll
                for (int t = 0; t < 4; ++t) acc[t] = zero16();
#pragma unroll 1
                for (int sb = 0; sb < 4; ++sb) {
                    const f32x16 XV = to_acc_lds(F.lds + L0_V, XS_STRIDE, sb * 32, WAVE * 32, r, hh, I);
                    const bf16x8 A0 = pack8<0>(XV), A1 = pack8<1>(XV);
#pragma unroll
                    for (int t = 0; t < 4; ++t) { f32x16 XK = to_acc_lds(F.lds + L0_K, XS_STRIDE, sb * 32, (half * 4 + t) * 32, r, hh, I);
#pragma unroll
                        for (int i = 0; i < 16; ++i) XK[i] *= exp2f((float)(127 - (sb * 32 + crow(i, hh))) * lg);
                        acc[t] = MFMA32(A0, pack8<0>(XK), acc[t]); acc[t] = MFMA32(A1, pack8<1>(XK), acc[t]); }
                }
#pragma unroll
                for (int t = 0; t < 4; ++t)
#pragma unroll
                    for (int i = 0; i < 16; ++i) dstb[(size_t)crow(i, hh) * 256 + (half * 4 + t) * 32 + r] = acc[t][i];
            }
        }
    }
}
__device__ __forceinline__ void m0_chunkscan(Frame& F) {
    int tid_ = threadIdx.x; asm volatile("" : "+v"(tid_)); const int TID = tid_;
    const int gt = F.vcu * NWAVES * 64 + TID, NT = F.G * NWAVES * 64;
    const float* SST = WSP(float, WS_SST); const float* CD = WSP(float, WS_CD); bf16* HP = WSP(bf16, WS_HP);
    for (int idx = gt; idx < NB * 32 * 64 * 32; idx += NT) {
        const int b = idx >> 16, rem = idx & 65535, h = rem >> 11;
        f32x4 st = {0.f, 0.f, 0.f, 0.f};
        for (int c = 0; c < 16; ++c) { const size_t off = ((size_t)((b * 16 + c) * 32) * 2048 + rem) * 4;
            *(unsigned long long*)(HP + off) = (unsigned long long)pkbf(st.x, st.y) | ((unsigned long long)pkbf(st.z, st.w) << 32);
            const float a = CD[(b * 16 + c) * 32 + h]; st = st * a + *(const f32x4*)(SST + off); }
    }
    const float* RST = WSP(float, WS_RST); bf16* RPT = WSP(bf16, WS_RPT);
    for (int idx = gt; idx < NB * 8 * 256 * 64; idx += NT) {
        const int b = idx >> 17, rem = idx & 131071, h = rem >> 14;
        const float gc = exp2f(128.0f * log2f(1.0f - exp2f(-5.0f - (float)h)));
        f32x4 st = {0.f, 0.f, 0.f, 0.f};
        for (int c = 0; c < 16; ++c) { const size_t off = ((size_t)((b * 16 + c) * 8) * 16384 + rem) * 4;
            *(unsigned long long*)(RPT + off) = (unsigned long long)pkbf(st.x, st.y) | ((unsigned long long)pkbf(st.z, st.w) << 32);
            st = st * gc + *(const f32x4*)(RST + off); }
    }
}
__device__ __forceinline__ void m0_out_ssd(Frame& F) {
    int tid_ = threadIdx.x; asm volatile("" : "+v"(tid_)); const int TID = tid_, LANE = TID & 63, WAVE = __builtin_amdgcn_readfirstlane(TID >> 6);
    const int r = LANE & 31, hh = LANE >> 5; const IdFrag I = make_id(r, hh);
    const bf16* XC = WSP(bf16, WS_XC); const bf16* PB = WSP(bf16, WS_BIG); bf16* MIX = WSP(bf16, WS_MIX);
    for (int u = F.vcu; u < 512; u += F.G) {
        __syncthreads();
        {
            const int bc = u >> 3, g = u & 7; const size_t R0 = (size_t)bc * 128;
            for (int i = TID; i < 4096; i += NWAVES * 64) { const int row = i >> 5, ch = i & 31; *(LAS v4u*)(F.lds + L0_XS + row * XS_STRIDE + ch * 16) = *(const v4u*)(XC + (R0 + row) * 4096 + g * 256 + ch * 8); }
            for (int i = TID; i < 2048; i += NWAVES * 64) { const int row = i >> 4, ch = i & 15;
                *(LAS v4u*)(F.lds + L0_BM + row * BC_STRIDE + ch * 16) = *(const v4u*)(XC + (R0 + row) * 4096 + 2048 + g * 128 + ch * 8);
                *(LAS v4u*)(F.lds + L0_CM + row * BC_STRIDE + ch * 16) = *(const v4u*)(XC + (R0 + row) * 4096 + 3072 + g * 128 + ch * 8); }
            LAS float* tab = (LAS float*)(F.lds + L0_TAB);
            ssd_tables(F, TID, LANE, WAVE, tab, R0, g, nullptr);
            const int head = WAVE >> 1, pt = WAVE & 1, hd = g * 4 + head;
            const LAS float* cuml = tab + head * 128; const LAS float* dtl = tab + 512 + head * 128;
            const float Dh = F.ssd_D[hd];
            bf16x8 hpf[8];
            { const bf16* hp = WSP(bf16, WS_HP) + ((size_t)(bc * 32 + hd) * 64 + pt * 32 + r) * 128 + 8 * hh;
#pragma unroll
              for (int ks = 0; ks < 8; ++ks) hpf[ks] = *(const bf16x8*)(hp + 16 * ks); }
#pragma unroll 1
            for (int lt = 0; lt < 4; ++lt) {
                f32x16 y = zero16();
#pragma unroll
                for (int ks = 0; ks < 8; ++ks) y = MFMA32(lfrag(F.lds + L0_CM, BC_STRIDE, lt * 32 + r, 16 * ks + 8 * hh), hpf[ks], y);
#pragma unroll
                for (int i = 0; i < 16; ++i) y[i] *= __expf(cuml[lt * 32 + crow(i, hh)]);
                const float cl = cuml[lt * 32 + r];
                f32x16 XS = zero16();
#pragma unroll 1
                for (int st = 0; st <= lt; ++st) {
                    f32x16 cbt = zero16();
#pragma unroll
                    for (int ks = 0; ks < 8; ++ks) cbt = MFMA32(lfrag(F.lds + L0_BM, BC_STRIDE, st * 32 + r, 16 * ks + 8 * hh), lfrag(F.lds + L0_CM, BC_STRIDE, lt * 32 + r, 16 * ks + 8 * hh), cbt);
#pragma unroll
                    for (int g4 = 0; g4 < 4; ++g4) { const f32x4 cs = *(const LAS f32x4*)(cuml + st * 32 + 8 * g4 + 4 * hh), ds = *(const LAS f32x4*)(dtl + st * 32 + 8 * g4 + 4 * hh);
#pragma unroll
                        for (int e = 0; e < 4; ++e) { const int s = st * 32 + 8 * g4 + 4 * hh + e; const float v = cbt[4 * g4 + e] * __expf(cl - cs[e]) * ds[e]; cbt[4 * g4 + e] = (s <= lt * 32 + r) ? v : 0.f; } }
                    XS = to_acc_lds(F.lds + L0_XS, XS_STRIDE, st * 32, head * 64 + pt * 32, r, hh, I);
                    y = MFMA32(pack8<0>(cbt), pack8<0>(XS), y); y = MFMA32(pack8<1>(cbt), pack8<1>(XS), y);
                }
                const f32x16 Z = to_acc_glb(PB + (R0 + lt * 32) * IN0P + hd * 64 + pt * 32, IN0P, r, hh, I);
                bf16* dst = MIX + (R0 + lt * 32) * 4096 + hd * 64 + pt * 32 + r;
#pragma unroll
                for (int i = 0; i < 16; ++i) { const float v = (y[i] + Dh * XS[i]) * silu(Z[i]); dst[(size_t)crow(i, hh) * 4096] = (bf16)(pkbf(v, v) & 0xffffu); }
            }
        }
    }
    __syncthreads();
}
__device__ __forceinline__ void m0_out_ret(Frame& F) {
    int tid_ = threadIdx.x; asm volatile("" : "+v"(tid_)); const int TID = tid_, LANE = TID & 63, WAVE = __builtin_amdgcn_readfirstlane(TID >> 6);
    const int r = LANE & 31, hh = LANE >> 5; const IdFrag I = make_id(r, hh);
    const bf16* XC = WSP(bf16, WS_XC); const bf16* PB = WSP(bf16, WS_BIG); bf16* MIX = WSP(bf16, WS_MIX);
    for (int u = 512 + F.vcu; u < 1024; u += F.G) {
        __syncthreads();
        {
            const int u2 = u - 512, bc = u2 >> 3, h = u2 & 7; const size_t R0 = (size_t)bc * 128;
            const bf16* KR = WSP(bf16, WS_KR); const bf16* QR = WSP(bf16, WS_QR);
            for (int i = TID; i < 4096; i += NWAVES * 64) { const int row = i >> 5, ch = i & 31;
                *(LAS v4u*)(F.lds + L0_K + row * XS_STRIDE + ch * 16) = *(const v4u*)(KR + (R0 + row) * 2048 + h * 256 + ch * 8);
                *(LAS v4u*)(F.lds + L0_V + row * XS_STRIDE + ch * 16) = *(const v4u*)(PB + (R0 + row) * IN0P + 10240 + h * 256 + ch * 8); }
            __syncthreads();
            const float lg = log2f(1.0f - exp2f(-5.0f - (float)h));
            const int lt = WAVE >> 1, dh = WAVE & 1;
            const bf16* qp = QR + (R0 + lt * 32 + r) * 2048 + h * 256 + 8 * hh;
            f32x16 y[4];
#pragma unroll
            for (int t = 0; t < 4; ++t) y[t] = zero16();
            const bf16* rpt = WSP(bf16, WS_RPT) + ((size_t)(bc * 8 + h) * 256 + dh * 128 + r) * 256 + 8 * hh;
#pragma unroll 1
            for (int ks = 0; ks < 16; ++ks) { const bf16x8 qf = *(const bf16x8*)(qp + 16 * ks);
#pragma unroll
                for (int t = 0; t < 4; ++t) y[t] = MFMA32(qf, *(const bf16x8*)(rpt + (size_t)t * 32 * 256 + 16 * ks), y[t]); }
#pragma unroll
            for (int i = 0; i < 16; ++i) { const float sc = exp2f((float)(lt * 32 + crow(i, hh) + 1) * lg);
#pragma unroll
                for (int t = 0; t < 4; ++t) y[t][i] *= sc; }
#pragma unroll 1
            for (int st = 0; st <= lt; ++st) {
                f32x16 sct = zero16();
#pragma unroll 2
                for (int ks = 0; ks < 16; ++ks) sct = MFMA32(lfrag(F.lds + L0_K, XS_STRIDE, st * 32 + r, 16 * ks + 8 * hh), *(const bf16x8*)(qp + 16 * ks), sct);
#pragma unroll
                for (int i = 0; i < 16; ++i) { const int d = lt * 32 + r - (st * 32 + crow(i, hh)); sct[i] = (d >= 0) ? sct[i] * exp2f((float)d * lg) : 0.f; }
                const bf16x8 A0 = pack8<0>(sct), A1 = pack8<1>(sct);
#pragma unroll
                for (int t = 0; t < 4; ++t) { const f32x16 XV = to_acc_lds(F.lds + L0_V, XS_STRIDE, st * 32, dh * 128 + t * 32, r, hh, I);
                    y[t] = MFMA32(A0, pack8<0>(XV), y[t]); y[t] = MFMA32(A1, pack8<1>(XV), y[t]); }
            }
            LAS float* rsum = (LAS float*)(F.lds + L0_RS);
#pragma unroll
            for (int i = 0; i < 16; ++i) { float s = (y[0][i] * y[0][i] + y[1][i] * y[1][i]) + (y[2][i] * y[2][i] + y[3][i] * y[3][i]);
#pragma unroll
                for (int o = 1; o < 32; o <<= 1) s += __shfl_xor(s, o);
                if (r == 0) rsum[(lt * 32 + crow(i, hh)) * 2 + dh] = s; }
            __syncthreads();
#pragma unroll
            for (int t = 0; t < 4; ++t) { const int dv0 = dh * 128 + t * 32;
                const f32x16 G = to_acc_glb(PB + (R0 + lt * 32) * IN0P + 12288 + h * 256 + dv0, IN0P, r, hh, I);
                const float w = F.ret_norm_w[h * 256 + dv0 + r];
                bf16* dst = MIX + (R0 + lt * 32) * 4096 + 2048 + h * 256 + dv0 + r;
#pragma unroll
                for (int i = 0; i < 16; ++i) { const int l = lt * 32 + crow(i, hh); const float rstd = rsqrtf((rsum[l * 2] + rsum[l * 2 + 1]) * (1.0f / 256.0f) + EPS);
                    const float v = silu(G[i]) * (y[t][i] * rstd * w); dst[(size_t)crow(i, hh) * 4096] = (bf16)(pkbf(v, v) & 0xffffu); } }
        }
    }
    __syncthreads();
}
__device__ __forceinline__ void m0_post(Frame& F) {
    int tid_ = threadIdx.x; asm volatile("" : "+v"(tid_)); const int TID = tid_, LANE = TID & 63, WAVE = __builtin_amdgcn_readfirstlane(TID >> 6);
    const int gw = F.vcu * NWAVES + WAVE, NGW = F.G * NWAVES;
    bf16* MIX = WSP(bf16, WS_MIX);
    for (int row = gw; row < M; row += NGW) {
        v4u v[4]; float s = 0.f;
#pragma unroll
        for (int j = 0; j < 4; ++j) { v[j] = *(const v4u*)(MIX + (size_t)row * 4096 + 8 * LANE + 512 * j);
            const float a0 = bflo(v[j].x), a1 = bfhi(v[j].x), a2 = bflo(v[j].y), a3 = bfhi(v[j].y), a4 = bflo(v[j].z), a5 = bfhi(v[j].z), a6 = bflo(v[j].w), a7 = bfhi(v[j].w);
            s += ((a0 * a0 + a1 * a1) + (a2 * a2 + a3 * a3)) + ((a4 * a4 + a5 * a5) + (a6 * a6 + a7 * a7)); }
        const float rstd = rsqrtf(wave_sum(s) * (1.0f / 2048.0f) + EPS);
#pragma unroll
        for (int j = 0; j < 4; ++j) { const int c = 8 * LANE + 512 * j; const f32x4 w0 = *(const f32x4*)(F.ssd_norm_w + c), w1 = *(const f32x4*)(F.ssd_norm_w + c + 4);
            v4u o; o.x = pkbf(bflo(v[j].x) * rstd * w0.x, bfhi(v[j].x) * rstd * w0.y); o.y = pkbf(bflo(v[j].y) * rstd * w0.z, bfhi(v[j].y) * rstd * w0.w);
            o.z = pkbf(bflo(v[j].z) * rstd * w1.x, bfhi(v[j].z) * rstd * w1.y); o.w = pkbf(bflo(v[j].w) * rstd * w1.z, bfhi(v[j].w) * rstd * w1.w);
            *(v4u*)(MIX + (size_t)row * 4096 + c) = o; }
    }
}
__device__ __forceinline__ void split_store8(bf16* hi, bf16* lo, const float (&v)[8]) {
    v4u h, l; unsigned hw[4], lw[4];
#pragma unroll
    for (int e = 0; e < 4; ++e) { hw[e] = pkbf(v[2 * e], v[2 * e + 1]); lw[e] = pkbf(v[2 * e] - bflo(hw[e]), v[2 * e + 1] - bfhi(hw[e])); }
    h.x = hw[0]; h.y = hw[1]; h.z = hw[2]; h.w = hw[3]; l.x = lw[0]; l.y = lw[1]; l.z = lw[2]; l.w = lw[3];
    *(v4u*)hi = h; *(v4u*)lo = l;
}
__device__ __forceinline__ void m1_prep(Frame& F) {
    int tid_ = threadIdx.x; asm volatile("" : "+v"(tid_)); const int TID = tid_;
    const int gt = F.vcu * NWAVES * 64 + TID, NT = F.G * NWAVES * 64;
    const bf16* PB = WSP(bf16, WS_BIG); const float* IDX = WSP(float, WS_IDX);
    const float* qc = WSP(float, WS_RTQ); const float* qs = qc + M * 16; const float* ic = WSP(float, WS_RTI); const float* is = ic + M * 8;
    bf16* QA = WSP(bf16, WS_QA); bf16* KAb = WSP(bf16, WS_KAB); bf16* VAb = WSP(bf16, WS_VAB);
    for (int idx = gt; idx < M * 288; idx += NT) {
        const int row = idx / 288, ch = idx % 288, hd = ch >> 4, c = ch & 15;
        const bf16* src = PB + (size_t)row * 2304 + ch * 8;
        bf16* dst = hd < 16 ? QA + (size_t)row * 2048 + ch * 8 : (hd == 16 ? KAb + (size_t)row * 128 + c * 8 : VAb + (size_t)row * 128 + c * 8);
        if (hd == 17 || c >= 4) { *(v4u*)dst = *(const v4u*)src; continue; }
        if (c >= 2) continue;
        const v4u u1 = *(const v4u*)src, u2 = *(const v4u*)(src + 16);
        const float x1[8] = {bflo(u1.x), bfhi(u1.x), bflo(u1.y), bfhi(u1.y), bflo(u1.z), bfhi(u1.z), bflo(u1.w), bfhi(u1.w)};
        const float x2[8] = {bflo(u2.x), bfhi(u2.x), bflo(u2.y), bfhi(u2.y), bflo(u2.z), bfhi(u2.z), bflo(u2.w), bfhi(u2.w)};
        float o1[8], o2[8];
#pragma unroll
        for (int e = 0; e < 8; ++e) { const float cs = qc[row * 16 + c * 8 + e], sn = qs[row * 16 + c * 8 + e]; o1[e] = x1[e] * cs - x2[e] * sn; o2[e] = x1[e] * sn + x2[e] * cs; }
        v4u w1, w2; w1.x = pkbf(o1[0], o1[1]); w1.y = pkbf(o1[2], o1[3]); w1.z = pkbf(o1[4], o1[5]); w1.w = pkbf(o1[6], o1[7]);
        w2.x = pkbf(o2[0], o2[1]); w2.y = pkbf(o2[2], o2[3]); w2.z = pkbf(o2[4], o2[5]); w2.w = pkbf(o2[6], o2[7]);
        *(v4u*)dst = w1; *(v4u*)(dst + 16) = w2;
    }
    bf16* QIH = WSP(bf16, WS_QIH); bf16* QIL = WSP(bf16, WS_QIL);
    for (int idx = gt; idx < M * 128; idx += NT) {
        const int row = idx >> 7, ch = idx & 127, c = ch & 7;
        const float* src = IDX + (size_t)row * 1280 + ch * 8;
        if (c == 1) continue;
        float v[8]; { const f32x4 a = *(const f32x4*)src, b = *(const f32x4*)(src + 4); v[0] = a.x; v[1] = a.y; v[2] = a.z; v[3] = a.w; v[4] = b.x; v[5] = b.y; v[6] = b.z; v[7] = b.w; }
        if (c == 0) { float x2[8], o2[8]; { const f32x4 a = *(const f32x4*)(src + 8), b = *(const f32x4*)(src + 12); x2[0] = a.x; x2[1] = a.y; x2[2] = a.z; x2[3] = a.w; x2[4] = b.x; x2[5] = b.y; x2[6] = b.z; x2[7] = b.w; }
#pragma unroll
            for (int e = 0; e < 8; ++e) { const float cs = ic[row * 8 + e], sn = is[row * 8 + e]; const float x1 = v[e]; v[e] = x1 * cs - x2[e] * sn; o2[e] = x1 * sn + x2[e] * cs; }
            split_store8(QIH + (size_t)row * 1024 + ch * 8 + 8, QIL + (size_t)row * 1024 + ch * 8 + 8, o2); }
        split_store8(QIH + (size_t)row * 1024 + ch * 8, QIL + (size_t)row * 1024 + ch * 8, v);
    }
    bf16* KIH = WSP(bf16, WS_KIH); bf16* KIL = WSP(bf16, WS_KIL); float* WI = WSP(float, WS_WI);
    for (int row = gt; row < M; row += NT) {
        const float* si = IDX + (size_t)row * 1280 + 1024;
        float ss = 0.f;
#pragma unroll 4
        for (int i = 0; i < 64; i += 4) { const f32x4 a = *(const f32x4*)(si + i); ss += (a.x * a.x + a.y * a.y) + (a.z * a.z + a.w * a.w); }
        const float rstd = rsqrtf(ss * (1.0f / 64.0f) + EPS);
#pragma unroll 1
        for (int c = 0; c < 8; ++c) { if (c == 1) continue;
            float v[8];
#pragma unroll
            for (int e = 0; e < 8; ++e) v[e] = si[c * 8 + e] * rstd * F.idx_k_norm_w[c * 8 + e];
            if (c == 0) { float o2[8];
#pragma unroll
                for (int e = 0; e < 8; ++e) { const float x2 = si[8 + e] * rstd * F.idx_k_norm_w[8 + e], cs = ic[row * 8 + e], sn = is[row * 8 + e], x1 = v[e]; v[e] = x1 * cs - x2 * sn; o2[e] = x1 * sn + x2 * cs; }
                split_store8(KIH + (size_t)row * 64 + 8, KIL + (size_t)row * 64 + 8, o2); }
            split_store8(KIH + (size_t)row * 64 + c * 8, KIL + (size_t)row * 64 + c * 8, v); }
#pragma unroll
        for (int h4 = 0; h4 < 4; ++h4) { const f32x4 a = *(const f32x4*)(IDX + (size_t)row * 1280 + 1088 + 4 * h4); *(f32x4*)(WI + (size_t)row * 16 + 4 * h4) = a * 0.03125f; }
    }
}
__device__ __forceinline__ void m1_index(Frame& F) {
    int tid_ = threadIdx.x; asm volatile("" : "+v"(tid_)); const int TID = tid_, LANE = TID & 63, WAVE = __builtin_amdgcn_readfirstlane(TID >> 6);
    const int r = LANE & 31, hh = LANE >> 5;
    LAS unsigned* sc = (LAS unsigned*)(F.lds + WAVE * 16384);
    const int gw = F.vcu * NWAVES + WAVE, NGW = F.G * NWAVES;
    const bf16* QIH = WSP(bf16, WS_QIH); const bf16* QIL = WSP(bf16, WS_QIL); const bf16* KIH = WSP(bf16, WS_KIH); const bf16* KIL = WSP(bf16, WS_KIL);
    const float* WI = WSP(float, WS_WI); int* SEL = WSP(int, WS_SEL); int* NSEL = WSP(int, WS_NSEL);
    const unsigned long long ltmask = (1ull << LANE) - 1ull;
    for (int it = 0;; ++it) {
        int pr;
        if (NGW == 2048) { if (it >= 2) break; pr = it == 0 ? gw : 4095 - gw; } else { pr = gw + it * NGW; if (pr >= 4096) break; }
        const int row0 = 2 * pr, b = row0 >> 11, qp0 = row0 & (SEQ - 1);
        if (qp0 + 1 <= 255) {
#pragma unroll 1
            for (int qq = 0; qq < 2; ++qq) { const int nv = qp0 + qq + 1; for (int i = LANE; i < nv; i += 64) SEL[(size_t)(row0 + qq) * 256 + i] = i; if (LANE == 0) NSEL[row0 + qq] = nv; }
            continue; }
        bf16x8 Ah[4], Al[4];
        { const int qq = (r >> 2) & 1, hd = (r & 3) + 4 * (r >> 3); const size_t o = (size_t)(row0 + qq) * 1024 + hd * 64 + 8 * hh;
#pragma unroll
          for (int ks = 0; ks < 4; ++ks) { Ah[ks] = *(const bf16x8*)(QIH + o + 16 * ks); Al[ks] = *(const bf16x8*)(QIL + o + 16 * ks); } }
        float wv[16];
#pragma unroll
        for (int h4 = 0; h4 < 4; ++h4) { const f32x4 a = *(const f32x4*)(WI + (size_t)(row0 + hh) * 16 + 4 * h4); wv[4 * h4] = a.x; wv[4 * h4 + 1] = a.y; wv[4 * h4 + 2] = a.z; wv[4 * h4 + 3] = a.w; }
        const int ntile = (qp0 + 1) / 32 + 1;
#pragma unroll 1
        for (int kt = 0; kt < ntile; ++kt) {
            const size_t ko = ((size_t)b * SEQ + kt * 32 + r) * 64 + 8 * hh;
            f32x16 acc = zero16();
#pragma unroll
            for (int ks = 0; ks < 4; ++ks) { const bf16x8 Bh = *(const bf16x8*)(KIH + ko + 16 * ks), Bl = *(const bf16x8*)(KIL + ko + 16 * ks);
                acc = MFMA32(Ah[ks], Bh, acc); acc = MFMA32(Ah[ks], Bl, acc); acc = MFMA32(Al[ks], Bh, acc); }
            float s = 0.f;
#pragma unroll
            for (int i = 0; i < 16; ++i) s += fmaxf(acc[i], 0.f) * wv[i];
            s += 0.0f;
            const int key = kt * 32 + r; const unsigned uu = __float_as_uint(s); const unsigned ok = (uu & 0x80000000u) ? ~uu : (uu | 0x80000000u);
            sc[hh * 2048 + key] = (key <= qp0 + hh) ? ok : 0u;
        }
        if (ntile & 1) sc[hh * 2048 + ntile * 32 + r] = 0u;
        asm volatile("s_waitcnt lgkmcnt(0)" ::: "memory");
#pragma unroll 1
        for (int qq = 0; qq < 2; ++qq) {
            const int nv = qp0 + qq + 1, nj = (nv + 63) >> 6; const int row = row0 + qq;
            unsigned vals[32];
#pragma unroll
            for (int j = 0; j < 32; ++j) vals[j] = (j < nj) ? sc[qq * 2048 + j * 64 + LANE] : 0u;
            unsigned prefix = 0u; bool exact = false;
#pragma unroll 1
            for (int bit = 31; bit >= 0; --bit) { const unsigned cand = prefix | (1u << bit); int cnt = 0;
#pragma unroll
                for (int j = 0; j < 32; ++j) cnt += __popcll(__ballot(vals[j] >= cand));
                if (cnt >= 256) prefix = cand;
                if (cnt == 256) { exact = true; break; } }
            const unsigned T = exact ? prefix - 1u : prefix;
            int base = 0;
#pragma unroll
            for (int j = 0; j < 32; ++j) { const bool p = vals[j] > T; const unsigned long long mk = __ballot(p);
                if (p) SEL[(size_t)row * 256 + base + __popcll(mk & ltmask)] = j * 64 + LANE; base += __popcll(mk); }
            if (!exact) { int need = 256 - base;
#pragma unroll
                for (int j = 0; j < 32; ++j) { const bool p = vals[j] == T; const unsigned long long mk = __ballot(p); const int rank = __popcll(mk & ltmask);
                    if (p && rank < need) SEL[(size_t)row * 256 + base + rank] = j * 64 + LANE;
                    const int c = __popcll(mk); const int take = c < need ? c : need; base += take; need -= take; } }
            if (LANE == 0) NSEL[row] = 256;
        }
    }
}
__device__ __forceinline__ void m1_attn(Frame& F) {
    int tid_ = threadIdx.x; asm volatile("" : "+v"(tid_)); const int TID = tid_, LANE = TID & 63, WAVE = __builtin_amdgcn_readfirstlane(TID >> 6);
    const int r = LANE & 31, hh = LANE >> 5; const IdFrag I = make_id(r, hh);
    const int gw = F.vcu * NWAVES + WAVE, NGW = F.G * NWAVES;
    const bf16* QA = WSP(bf16, WS_QA); const bf16* KAb = WSP(bf16, WS_KAB); const bf16* VAb = WSP(bf16, WS_VAB); const int* SEL = WSP(int, WS_SEL); const int* NSEL = WSP(int, WS_NSEL); bf16* MIX = WSP(bf16, WS_MIX);
#pragma unroll 1
    for (int q = gw; q < M; q += NGW) {
        const int b = q >> 11, nsel = NSEL[q], ntile = (nsel + 31) >> 5;
        bf16x8 qf[8];
#pragma unroll
        for (int ks = 0; ks < 8; ++ks) qf[ks] = *(const bf16x8*)(QA + (size_t)q * 2048 + (r & 15) * 128 + 16 * ks + 8 * hh);
        float mx = -3.0e38f;
#pragma unroll 1
        for (int kt = 0; kt < ntile; ++kt) {
            const int sid = (kt * 32 + r < nsel) ? SEL[(size_t)q * 256 + kt * 32 + r] : 0;
            const bf16* kp = KAb + ((size_t)b * SEQ + sid) * 128 + 8 * hh;
            f32x16 L = zero16();
#pragma unroll
            for (int ks = 0; ks < 8; ++ks) L = MFMA32(*(const bf16x8*)(kp + 16 * ks), qf[ks], L);
#pragma unroll
            for (int i = 0; i < 16; ++i) mx = fmaxf(mx, (kt * 32 + crow(i, hh) < nsel) ? L[i] * 0.08838834764831845f : -3.0e38f);
        }
        mx = fmaxf(mx, __shfl_xor(mx, 32));
        float sum = 0.f;
        f32x16 o[4];
#pragma unroll
        for (int dt = 0; dt < 4; ++dt) o[dt] = zero16();
#pragma unroll 1
        for (int kt = 0; kt < ntile; ++kt) {
            const int sid = (kt * 32 + r < nsel) ? SEL[(size_t)q * 256 + kt * 32 + r] : 0;
            const bf16* kp = KAb + ((size_t)b * SEQ + sid) * 128 + 8 * hh;
            f32x16 L = zero16();
#pragma unroll
            for (int ks = 0; ks < 8; ++ks) L = MFMA32(*(const bf16x8*)(kp + 16 * ks), qf[ks], L);
#pragma unroll
            for (int i = 0; i < 16; ++i) { const float e = (kt * 32 + crow(i, hh) < nsel) ? __expf(L[i] * 0.08838834764831845f - mx) : 0.f; L[i] = e; sum += e; }
            const bf16x8 P0 = pack8<0>(L), P1 = pack8<1>(L);
            const bf16* vp = VAb + ((size_t)b * SEQ + sid) * 128 + 8 * hh;
#pragma unroll
            for (int dt = 0; dt < 4; ++dt) { f32x16 xv = MFMA32(*(const bf16x8*)(vp + dt * 32), I.f0, zero16()); xv = MFMA32(*(const bf16x8*)(vp + dt * 32 + 16), I.f1, xv);
                o[dt] = MFMA32(P0, pack8<0>(xv), o[dt]); o[dt] = MFMA32(P1, pack8<1>(xv), o[dt]); }
        }
        sum += __shfl_xor(sum, 32);
        const float inv = 1.0f / sum;
#pragma unroll
        for (int i = 0; i < 8; ++i) { const int head = crow(i, hh); const float ih = __shfl(inv, head);
#pragma unroll
            for (int dt = 0; dt < 4; ++dt) { const float v = o[dt][i] * ih; MIX[(size_t)q * 2048 + head * 128 + dt * 32 + r] = (bf16)(pkbf(v, v) & 0xffffu); } }
    }
}
struct Args { const void* in[21]; float* out; unsigned char* ws; int ph_lo, ph_hi; };
__global__ void __launch_bounds__(NWAVES * 64, 2) mk_fwd(Args args) {
    extern __shared__ __attribute__((aligned(16))) unsigned char lds_raw[];
    Frame F;
    F.lds = (LAS unsigned char*)lds_raw;
    F.G = gridDim.x; { const int bx = blockIdx.x; F.vcu = (F.G % 8 == 0) ? (bx % 8) * (F.G / 8) + bx / 8 : bx; }
    F.x = (const float*)args.in[0]; F.c = (const float*)args.in[1]; F.positions = (const int*)args.in[2]; F.mod_w = (const float*)args.in[3]; F.mod_b = (const float*)args.in[4];
    F.norm_w = (const float*)args.in[5]; F.w_gate = (const float*)args.in[6]; F.w_up = (const float*)args.in[7]; F.w_down = (const float*)args.in[8]; F.hy_w_in = (const float*)args.in[9];
    F.conv_w = (const float*)args.in[10]; F.conv_b = (const float*)args.in[11]; F.A_log = (const float*)args.in[12]; F.dt_bias = (const float*)args.in[13]; F.ssd_D = (const float*)args.in[14];
    F.ssd_norm_w = (const float*)args.in[15]; F.ret_norm_w = (const float*)args.in[16]; F.hy_w_out = (const float*)args.in[17]; F.dsa_w_in = (const float*)args.in[18];
    F.idx_k_norm_w = (const float*)args.in[19]; F.dsa_w_out = (const float*)args.in[20];
    F.out = args.out; F.ws = args.ws;
    const int TID = threadIdx.x;
    volatile LAS unsigned* MISC = (volatile LAS unsigned*)(F.lds + MISC_OFF);
    for (int u = TID; u < (LDS_BYTES - LDSCTL_OFF) / 4; u += NWAVES * 64) ((LAS unsigned*)(F.lds + LDSCTL_OFF))[u] = 0u;
    __syncthreads();
    const int lo = args.ph_lo, hi = args.ph_hi;
    XcdBarrier bar; bar.bar = (unsigned*)(F.ws + WS_CTL) + CW_BAR; bar.x = 0; bar.st = nullptr;
    if (hi - lo > 1) bar = xcd_barrier_post((unsigned*)(F.ws + WS_CTL) + CW_BAR, MISC + 8);
#define RUN(k) (lo <= (k) && (k) < hi)
#define REPS(i) (1 + (int)((PROBE_REP_MASK >> (i)) & 1u))
#define SEAM(k) do { if (RUN(k) && RUN((k) + 1)) xcd_barrier(bar); } while (0)
    bf16* H = WSP(bf16, WS_H); bf16* ACT = WSP(bf16, WS_BIG); bf16* PB = WSP(bf16, WS_BIG); bf16* MIX = WSP(bf16, WS_MIX); float* Y = WSP(float, WS_Y); float* SSQ = WSP(float, WS_SSQ);

    if (PON(0) && RUN(0)) for (int rep_ = 0; rep_ < REPS(0); ++rep_) { p0_prologue(F); __syncthreads(); }
    SEAM(0);
    if (PON(1) && RUN(1)) thin_phase(F, -1, 0);
    SEAM(1);
    int ph = 2, q = 0;
    for (int s = 0; s < 4; ++s) {
        if (PON(2) && RUN(ph)) for (int rep_ = 0; rep_ < REPS(2); ++rep_) { pg8::Gemm g{H, WSP(bf16, WS_WGU) + (size_t)s * WGU_ELEMS, M, 2 * FF, D}; pg8::StaticOrder S; S.init(M, 2 * FF, F.G, (int)blockIdx.x);
            pg8::EpiGateUp E{ACT, FF}; pg8::gemm_phase<pg8::EpiGateUp, pg8::StaticOrder, true, true>(F.lds, g, S, E); }
        SEAM(ph); ++ph;
        if (PON(3) && RUN(ph)) for (int rep_ = 0; rep_ < REPS(3); ++rep_) { pg8::Gemm g{ACT, WSP(bf16, WS_WD) + (size_t)s * WD_ELEMS, M, D, FF}; pg8::StaticOrder S; S.init(M, D, F.G, (int)blockIdx.x);
            pg8::EpiYSsq E{Y, D, SSQ}; pg8::gemm_phase<pg8::EpiYSsq, pg8::StaticOrder, true, true>(F.lds, g, S, E); }
        SEAM(ph); ++ph;
        if (PON(1) && RUN(ph)) thin_phase(F, q, q < 5 ? q + 1 : -1);
        SEAM(ph); ++ph; ++q;
        if (s == 0) {
            if (PON(4) && RUN(ph)) for (int rep_ = 0; rep_ < REPS(4); ++rep_) { pg8::Gemm g{H, WSP(bf16, WS_WIN0), M, IN0P, D}; pg8::StaticOrder S; S.init(M, IN0P, F.G, (int)blockIdx.x);
                pg8::EpiProj E{PB, IN0P, 56, WSP(float, WS_DTB), 256}; pg8::gemm_phase<pg8::EpiProj, pg8::StaticOrder, true, true>(F.lds, g, S, E); }
            SEAM(ph); ++ph;
            if (PON(5) && RUN(ph)) for (int rep_ = 0; rep_ < REPS(5); ++rep_) { m0_prep(F); __syncthreads(); }
            SEAM(ph); ++ph;
            if (PON(6) && RUN(ph)) for (int rep_ = 0; rep_ < REPS(6); ++rep_) { m0_states(F); __syncthreads(); }
            SEAM(ph); ++ph;
            if (PON(14) && RUN(ph)) for (int rep_ = 0; rep_ < REPS(14); ++rep_) { m0_chunkscan(F); __syncthreads(); }
            SEAM(ph); ++ph;
            if (PON(15) && RUN(ph)) for (int rep_ = 0; rep_ < REPS(15); ++rep_) { m0_out_ssd(F); m0_out_ret(F); }
            SEAM(ph); ++ph;
            if (PON(7) && RUN(ph)) m0_post(F);
            SEAM(ph); ++ph;
            if (PON(8) && RUN(ph)) for (int rep_ = 0; rep_ < REPS(8); ++rep_) { pg8::Gemm g{MIX, WSP(bf16, WS_WOUT0), M, D, 2 * D}; pg8::StaticOrder S; S.init(M, D, F.G, (int)blockIdx.x);
                pg8::EpiYSsq E{Y, D, SSQ}; pg8::gemm_phase<pg8::EpiYSsq, pg8::StaticOrder, true, true>(F.lds, g, S, E); }
            SEAM(ph); ++ph;
            if (PON(1) && RUN(ph)) thin_phase(F, q, q + 1);
            SEAM(ph); ++ph; ++q;
        }
        if (s == 2) {
            if (PON(9) && RUN(ph)) for (int rep_ = 0; rep_ < REPS(9); ++rep_) { pg8::Gemm g{H, WSP(bf16, WS_WIN1), M, IN1P, D}; pg8::StaticOrder S; S.init(M, IN1P, F.G, (int)blockIdx.x);
                pg8::EpiProj E{PB, 2304, 9, WSP(float, WS_IDX), 1280}; pg8::gemm_phase<pg8::EpiProj, pg8::StaticOrder, true, true>(F.lds, g, S, E); }
            SEAM(ph); ++ph;
            if (PON(10) && RUN(ph)) for (int rep_ = 0; rep_ < REPS(10); ++rep_) { m1_prep(F); __syncthreads(); }
            SEAM(ph); ++ph;
            if (PON(11) && RUN(ph)) for (int rep_ = 0; rep_ < REPS(11); ++rep_) { m1_index(F); __syncthreads(); }
            SEAM(ph); ++ph;
            if (PON(12) && RUN(ph)) for (int rep_ = 0; rep_ < REPS(12); ++rep_) { m1_attn(F); __syncthreads(); }
            SEAM(ph); ++ph;
            if (PON(13) && RUN(ph)) for (int rep_ = 0; rep_ < REPS(13); ++rep_) { pg8::Gemm g{MIX, WSP(bf16, WS_WOUT1), M, D, D}; pg8::StaticOrder S; S.init(M, D, F.G, (int)blockIdx.x);
                pg8::EpiYSsq E{Y, D, SSQ}; pg8::gemm_phase<pg8::EpiYSsq, pg8::StaticOrder, true, true>(F.lds, g, S, E); }
            SEAM(ph); ++ph;
            if (PON(1) && RUN(ph)) thin_phase(F, q, q + 1);
            SEAM(ph); ++ph; ++q;
        }
    }
#undef RUN
#undef SEAM
}

extern "C" void kernel_launch(void* const* d_in, const int* in_sizes, int n_in, void* d_out, int out_size, void* d_ws, size_t ws_size, hipStream_t stream) {
    static int grid = 0;
    if (grid == 0) {
        if (n_in != 21 || out_size != M * D || ws_size < WS_END) { fprintf(stderr, "kernel_launch: unexpected shapes (n_in %d, out %d, ws %zu < %zu)\n", n_in, out_size, ws_size, (size_t)WS_END); grid = -1; return; }
        int dev = 0, cus = 0, per_cu = 0;
        if (hipGetDevice(&dev) != hipSuccess || hipDeviceGetAttribute(&cus, hipDeviceAttributeMultiprocessorCount, dev) != hipSuccess) { grid = -1; return; }
        if (hipFuncSetAttribute((const void*)mk_fwd, hipFuncAttributeMaxDynamicSharedMemorySize, LDS_BYTES) != hipSuccess) { fprintf(stderr, "kernel_launch: hipFuncSetAttribute failed\n"); grid = -1; return; }
        if (hipOccupancyMaxActiveBlocksPerMultiprocessor(&per_cu, (const void*)mk_fwd, NWAVES * 64, LDS_BYTES) != hipSuccess || per_cu < 1) { fprintf(stderr, "kernel_launch: occupancy query says %d\n", per_cu); }
        (void)hipGetLastError();
        grid = cus;
    }
    if (grid < 0) return;
    (void)hipMemsetAsync((char*)d_ws + WS_CTL, 0, CTL_ZERO_BYTES, stream);
    Args a{};
    for (int i = 0; i < 21; ++i) a.in[i] = d_in[i];
    a.out = (float*)d_out; a.ws = (unsigned char*)d_ws;
#if MK_LAUNCH_PER_PHASE
    for (int p = 0; p < NPH; ++p) { a.ph_lo = p; a.ph_hi = p + 1; hipLaunchKernelGGL(mk_fwd, dim3(grid), dim3(NWAVES * 64), LDS_BYTES, stream, a); }
#else
    a.ph_lo = 0; a.ph_hi = NPH; hipLaunchKernelGGL(mk_fwd, dim3(grid), dim3(NWAVES * 64), LDS_BYTES, stream, a);
#endif
}
```

```cpp
#include <hip/hip_runtime.h>
#include <cstdio>
#include <cstdint>
namespace pg8 {
#define PG8_LAS __attribute__((address_space(3)))
typedef unsigned short bf16_t;
typedef short bf16x8 __attribute__((ext_vector_type(8)));
typedef float f32x4 __attribute__((ext_vector_type(4)));
typedef unsigned u32x4 __attribute__((ext_vector_type(4)));
constexpr int BM = 256, BK = 64, HALF = 128, HTB = HALF * BK * 2  , STAGE_BYTES = 8 * HTB, NXCD = 8, WGM = 8;

__host__ __device__ __forceinline__ int lds_byte(int r, int c) { const int st = (r >> 4) * 2 + (c >> 5), rr = r & 15, cc = c & 31, ob = rr * 64 + cc * 2; return st * 1024 + (ob ^ (((ob >> 9) & 1) << 5)); }
__host__ __device__ __forceinline__ void stage_rc(int b, int& R, int& C) { const int st = b / 1024, sb = b % 1024, swz = sb ^ (((sb >> 9) & 1) << 5); R = (st >> 1) * 16 + swz / 64; C = (st & 1) * 32 + (swz % 64) / 2; }
__host__ __device__ __forceinline__ int perm32(int rho) { const int n = rho >> 4, i = rho & 15; return 8 * (i >> 2) + 4 * n + (i & 3); }

struct Unit { int pm, pn; };
struct Gemm { const bf16_t* A; const bf16_t* Bt; int M, N, K; };

struct StaticOrder {
    int nM, nN, nwg, G, c;
    __host__ __device__ void init(int M, int N, int G_, int c_) { nM = M / BM; nN = N / BM; nwg = nM * nN; G = G_; c = c_; }
    __host__ __device__ bool next(int i, Unit& u) const {
        const long L = (long)i * G + c; if (L >= nwg) return false;
        int wgid = (int)L; { const int q = nwg / NXCD, r = nwg % NXCD, xcd = wgid % NXCD, off = wgid / NXCD; wgid = (xcd < r ? xcd * (q + 1) : r * (q + 1) + (xcd - r) * q) + off; }
        const int nig = WGM * nN, gid = wgid / nig, fm = gid * WGM, gsz = (nM - fm) < WGM ? (nM - fm) : WGM;
        u.pm = fm + ((wgid % nig) % gsz); u.pn = (wgid % nig) / gsz; return true;
    }
    __device__ __forceinline__ void a_ready(const Unit&) const {}
    __device__ __forceinline__ void done(const Unit&) const {}
};

__device__ __forceinline__ unsigned cvt_pk_bf16(float lo, float hi) { unsigned r; asm volatile("v_cvt_pk_bf16_f32 %0, %1, %2" : "=v"(r) : "v"(lo), "v"(hi)); return r; }
typedef float f32x2 __attribute__((ext_vector_type(2)));
__device__ __forceinline__ float silu_f(float v) { return v * __builtin_amdgcn_rcpf(1.0f + __expf(-v)); }

struct EpiGateUp {
    static constexpr bool PERM = true, AFTER_DRAIN = false;
    bf16_t* O; int ldc;
    __device__ __forceinline__ void operator()(const f32x4 (&acc)[2][2][4][2], const Unit& u, int wr, int wc, int fr, int fq) const {
        const int row0 = u.pm * BM + wr * 64 + fr, col0 = u.pn * HALF + wc * 32 + 8 * fq;
#pragma unroll
        for (int ai = 0; ai < 2; ++ai)
#pragma unroll
            for (int m = 0; m < 4; ++m) { bf16_t* rowp = O + (size_t)(row0 + ai * HALF + m * 16) * ldc + col0;
                const f32x4 g0 = acc[ai][0][m][0], g1 = acc[ai][0][m][1], u0 = acc[ai][1][m][0], u1 = acc[ai][1][m][1];
                f32x4 v0, v1;
#pragma unroll
                for (int j = 0; j < 4; ++j) { v0[j] = silu_f(g0[j]) * u0[j]; v1[j] = silu_f(g1[j]) * u1[j]; }
                u32x4 w; w.x = cvt_pk_bf16(v0[0], v0[1]); w.y = cvt_pk_bf16(v0[2], v0[3]); w.z = cvt_pk_bf16(v1[0], v1[1]); w.w = cvt_pk_bf16(v1[2], v1[3]);
                *(u32x4*)rowp = w; }
    }
};
struct EpiYSsq {
    static constexpr bool PERM = false, AFTER_DRAIN = false;
    float* C; int ldc; float* ssq;
    __device__ __forceinline__ void operator()(const f32x4 (&acc)[2][2][4][2], const Unit& u, int wr, int wc, int fr, int fq) const {
        const int row0 = u.pm * BM + wr * 64 + fr, col0 = u.pn * BM + wc * 32 + 4 * fq;
#pragma unroll
        for (int ai = 0; ai < 2; ++ai)
#pragma unroll
            for (int m = 0; m < 4; ++m) { const int row = row0 + ai * HALF + m * 16; float* rowp = C + (size_t)row * ldc + col0; float s = 0.f;
#pragma unroll
                for (int bj = 0; bj < 2; ++bj)
#pragma unroll
                    for (int n = 0; n < 2; ++n) { const f32x4 v = acc[ai][bj][m][n]; *(f32x4*)(rowp + bj * HALF + n * 16) = v; s += (v[0] * v[0] + v[1] * v[1]) + (v[2] * v[2] + v[3] * v[3]); }
                s += __shfl_xor(s, 16); s += __shfl_xor(s, 32);
                if (fq == 0) ssq[(size_t)row * 32 + u.pn * 4 + wc] = s; }
    }
};
struct EpiProj {
    static constexpr bool PERM = true, AFTER_DRAIN = false;
    bf16_t* O; int ldo; int nbf; float* Fo; int ldf;
    __device__ __forceinline__ void operator()(const f32x4 (&acc)[2][2][4][2], const Unit& u, int wr, int wc, int fr, int fq) const {
        const int row0 = u.pm * BM + wr * 64 + fr;
        if (u.pn < nbf) {
            const int col0 = u.pn * BM + wc * 32 + 8 * fq;
#pragma unroll
            for (int ai = 0; ai < 2; ++ai)
#pragma unroll
                for (int m = 0; m < 4; ++m) { bf16_t* rowp = O + (size_t)(row0 + ai * HALF + m * 16) * ldo + col0;
#pragma unroll
                    for (int bj = 0; bj < 2; ++bj) { const f32x4 v0 = acc[ai][bj][m][0], v1 = acc[ai][bj][m][1];
                        u32x4 w; w.x = cvt_pk_bf16(v0[0], v0[1]); w.y = cvt_pk_bf16(v0[2], v0[3]); w.z = cvt_pk_bf16(v1[0], v1[1]); w.w = cvt_pk_bf16(v1[2], v1[3]);
                        *(u32x4*)(rowp + bj * HALF) = w; } }
        } else {
            const int col0 = (u.pn - nbf) * BM + wc * 32 + 8 * fq;
#pragma unroll
            for (int ai = 0; ai < 2; ++ai)
#pragma unroll
                for (int m = 0; m < 4; ++m) { float* rowp = Fo + (size_t)(row0 + ai * HALF + m * 16) * ldf + col0;
#pragma unroll
                    for (int bj = 0; bj < 2; ++bj) { *(f32x4*)(rowp + bj * HALF) = acc[ai][bj][m][0]; *(f32x4*)(rowp + bj * HALF + 4) = acc[ai][bj][m][1]; } }
        }
    }
};
struct EpiProj0 {
    static constexpr bool PERM = true, AFTER_DRAIN = false;
    bf16_t* O; int ldo; float* Fo; const float* rc; const float* rs;
    __device__ __forceinline__ void operator()(const f32x4 (&acc)[2][2][4][2], const Unit& u, int wr, int wc, int fr, int fq) const {
        const int row0 = u.pm * BM + wr * 64 + fr;
        if (u.pn == 56) {
            const int col0 = wc * 32 + 8 * fq;
#pragma unroll
            for (int ai = 0; ai < 2; ++ai)
#pragma unroll
                for (int m = 0; m < 4; ++m) { float* rowp = Fo + (size_t)(row0 + ai * HALF + m * 16) * 256 + col0;
#pragma unroll
                    for (int bj = 0; bj < 2; ++bj) { *(f32x4*)(rowp + bj * HALF) = acc[ai][bj][m][0]; *(f32x4*)(rowp + bj * HALF + 4) = acc[ai][bj][m][1]; } }
            return;
        }
        const int col0 = u.pn * BM + wc * 32 + 8 * fq;
        const bool rot = (u.pn >= 24 && u.pn < 40); const float sc = (u.pn >= 32) ? 0.0625f : 1.0f;
#pragma unroll
        for (int ai = 0; ai < 2; ++ai)
#pragma unroll
            for (int m = 0; m < 4; ++m) { const int row = row0 + ai * HALF + m * 16; bf16_t* rowp = O + (size_t)row * ldo + col0;
                f32x4 a0 = acc[ai][0][m][0], a1 = acc[ai][0][m][1], b0 = acc[ai][1][m][0], b1 = acc[ai][1][m][1];
                if (rot) { const int i0 = wc * 32 + 8 * fq;
                    const f32x4 c0 = *(const f32x4*)(rc + (size_t)row * 128 + i0), c1 = *(const f32x4*)(rc + (size_t)row * 128 + i0 + 4), s0 = *(const f32x4*)(rs + (size_t)row * 128 + i0), s1 = *(const f32x4*)(rs + (size_t)row * 128 + i0 + 4);
                    const f32x4 x0 = a0, x1 = a1, y0 = b0, y1 = b1;
                    a0 = (x0 * c0 - y0 * s0) * sc; a1 = (x1 * c1 - y1 * s1) * sc; b0 = (x0 * s0 + y0 * c0) * sc; b1 = (x1 * s1 + y1 * c1) * sc; }
                u32x4 w; w.x = cvt_pk_bf16(a0[0], a0[1]); w.y = cvt_pk_bf16(a0[2], a0[3]); w.z = cvt_pk_bf16(a1[0], a1[1]); w.w = cvt_pk_bf16(a1[2], a1[3]);
                *(u32x4*)rowp = w;
                w.x = cvt_pk_bf16(b0[0], b0[1]); w.y = cvt_pk_bf16(b0[2], b0[3]); w.z = cvt_pk_bf16(b1[0], b1[1]); w.w = cvt_pk_bf16(b1[2], b1[3]);
                *(u32x4*)(rowp + HALF) = w; }
    }
};
template <class Epi, class Sched, bool ALIGN_EPI = false, bool SP2 = false>
__device__ __forceinline__ void gemm_phase(PG8_LAS unsigned char* lds, const Gemm g, const Sched& S, const Epi& E) {
    int tid_ = threadIdx.x; asm volatile("" : "+v"(tid_));
    const int tid = tid_, wid = __builtin_amdgcn_readfirstlane(tid >> 6), lane = tid & 63, wr = wid >> 2, wc = wid & 3, fr = lane & 15, fq = lane >> 4;
    const int K = g.K, nt = K / BK;
    unsigned voffA[2], voffB[2];
#pragma unroll
    for (int i = 0; i < 2; ++i) { int R, C; stage_rc(tid * 16 + i * 8192, R, C); const int Rb = Epi::PERM ? ((R & ~31) + perm32(R & 31)) : R;
        voffA[i] = (unsigned)(R * K + C) * 2u; voffB[i] = (unsigned)(Rb * K + C) * 2u; }
    const size_t kstep = (size_t)(BK * 2);
    const size_t hstep = (size_t)HALF * K * 2;
    const size_t tstep = 2 * hstep;
    const unsigned ldsw = (unsigned)wid * 1024u;
    const int aoff = lds_byte(wr * 64 + fr, fq * 8), boff = lds_byte(wc * 32 + fr, fq * 8);
#define PG8_SA(b, h) (((b) * 2 + (h)) * HTB)
#define PG8_SB(b, h) ((4 + (b) * 2 + (h)) * HTB)
#define PG8_STAGE(bufoff, gbase, voff) do { _Pragma("unroll") for (int _i = 0; _i < 2; ++_i) \
        __builtin_amdgcn_global_load_lds((const unsigned*)((const char*)(gbase) + (voff)[_i]), (PG8_LAS unsigned*)(lds + (bufoff) + ldsw + _i * 8192), 16, 0, 0); } while (0)
#define PG8_LDA(dst, b, h) do { _Pragma("unroll") for (int m = 0; m < 4; ++m) _Pragma("unroll") for (int k = 0; k < 2; ++k) dst[m][k] = *(const PG8_LAS bf16x8*)(lds + PG8_SA(b, h) + aoff + m * 2048 + k * 1024); } while (0)
#define PG8_LDB(dst, b, h) do { _Pragma("unroll") for (int n = 0; n < 2; ++n) _Pragma("unroll") for (int k = 0; k < 2; ++k) dst[n][k] = *(const PG8_LAS bf16x8*)(lds + PG8_SB(b, h) + boff + n * 2048 + k * 1024); } while (0)
#define PG8_MMA(ai, bj, At, Bt) do { __builtin_amdgcn_s_setprio(1); _Pragma("unroll") for (int m = 0; m < 4; ++m) _Pragma("unroll") for (int n = 0; n < 2; ++n) _Pragma("unroll") for (int k = 0; k < 2; ++k) \
        acc[ai][bj][m][n] = __builtin_amdgcn_mfma_f32_16x16x32_bf16(Bt[n][k], At[m][k], acc[ai][bj][m][n], 0, 0, 0); __builtin_amdgcn_s_setprio(0); } while (0)
#define PG8_WAIT_V(n) asm volatile("s_waitcnt vmcnt(" #n ")" ::: "memory")
#define PG8_WAIT_L(n) asm volatile("s_waitcnt lgkmcnt(" #n ")" ::: "memory")
#define PG8_BAR __builtin_amdgcn_s_barrier()
#define PG8_SCHED __builtin_amdgcn_sched_barrier(0)
    Unit cur, nxt; int ui = 0;
    if (!S.next(0, cur)) return;
    f32x4 acc[2][2][4][2];
#pragma unroll
    for (int a = 0; a < 2; ++a)
#pragma unroll
        for (int b = 0; b < 2; ++b)
#pragma unroll
            for (int m = 0; m < 4; ++m)
#pragma unroll
                for (int n = 0; n < 2; ++n) acc[a][b][m][n] = (f32x4){0.f, 0.f, 0.f, 0.f};
    bf16x8 At[4][2], B0[2][2], B1[2][2];
    const char* cA = (const char*)g.A + (size_t)cur.pm * tstep; const char* cB = (const char*)g.Bt + (size_t)cur.pn * tstep;
    S.a_ready(cur);
    if constexpr (SP2) {
        PG8_STAGE(PG8_SB(0, 0), cB, voffB); PG8_STAGE(PG8_SB(0, 1), cB + hstep, voffB); PG8_STAGE(PG8_SA(0, 0), cA, voffA); PG8_STAGE(PG8_SA(0, 1), cA + hstep, voffA);
        if (wr == 1) PG8_BAR;
        PG8_WAIT_V(2); PG8_BAR;
        PG8_STAGE(PG8_SB(1, 0), cB + kstep, voffB); PG8_STAGE(PG8_SA(1, 0), cA + kstep, voffA); PG8_STAGE(PG8_SB(1, 1), cB + hstep + kstep, voffB);
        PG8_WAIT_V(6); PG8_BAR;
    } else {
        PG8_STAGE(PG8_SB(0, 0), cB, voffB); PG8_STAGE(PG8_SA(0, 0), cA, voffA); PG8_STAGE(PG8_SB(0, 1), cB + hstep, voffB); PG8_STAGE(PG8_SA(0, 1), cA + hstep, voffA);
        if (wr == 1) PG8_BAR;
        PG8_WAIT_V(4); PG8_BAR;
        PG8_STAGE(PG8_SB(1, 0), cB + kstep, voffB); PG8_STAGE(PG8_SA(1, 0), cA + kstep, voffA); PG8_STAGE(PG8_SB(1, 1), cB + hstep + kstep, voffB);
        PG8_WAIT_V(6); PG8_BAR;
    }
    for (;;) {
        const bool has_next = S.next(ui + 1, nxt);
        const char* nA = has_next ? (const char*)g.A + (size_t)nxt.pm * tstep : cA; const char* nB = has_next ? (const char*)g.Bt + (size_t)nxt.pn * tstep : cB;
        for (int t = 0; t < nt; t += 2) {
            const bool last = (t == nt - 2);
            const char* a1 = cA + (size_t)(t + 1) * kstep;
            const char* a2 = last ? nA : cA + (size_t)(t + 2) * kstep; const char* b2 = last ? nB : cB + (size_t)(t + 2) * kstep;
            const char* a3 = a2 + kstep; const char* b3 = b2 + kstep;
            if (last && has_next) S.a_ready(nxt);
            if constexpr (SP2) {
            PG8_LDB(B0, 0, 0); PG8_LDB(B1, 0, 1); PG8_SCHED; PG8_LDA(At, 0, 0); PG8_STAGE(PG8_SA(1, 1), a1 + hstep, voffA);
            PG8_WAIT_V(8); PG8_WAIT_L(0); PG8_BAR; PG8_MMA(0, 0, At, B0); PG8_MMA(0, 1, At, B1); PG8_BAR; PG8_SCHED;
            PG8_LDA(At, 0, 1); PG8_STAGE(PG8_SB(0, 0), b2, voffB); PG8_STAGE(PG8_SB(0, 1), b2 + hstep, voffB); PG8_STAGE(PG8_SA(0, 0), a2, voffA);
            PG8_WAIT_V(8); PG8_WAIT_L(0); PG8_BAR; PG8_MMA(1, 0, At, B0); PG8_MMA(1, 1, At, B1); PG8_BAR; PG8_SCHED;
            PG8_LDB(B0, 1, 0); PG8_LDB(B1, 1, 1); PG8_SCHED; PG8_LDA(At, 1, 0); PG8_STAGE(PG8_SA(0, 1), a2 + hstep, voffA);
            PG8_WAIT_V(8); PG8_WAIT_L(0); PG8_BAR; PG8_MMA(0, 0, At, B0); PG8_MMA(0, 1, At, B1); PG8_BAR; PG8_SCHED;
            PG8_LDA(At, 1, 1); PG8_STAGE(PG8_SB(1, 0), b3, voffB); PG8_STAGE(PG8_SB(1, 1), b3 + hstep, voffB); PG8_STAGE(PG8_SA(1, 0), a3, voffA);
            PG8_WAIT_V(8); PG8_WAIT_L(0); PG8_BAR; PG8_MMA(1, 0, At, B0); PG8_MMA(1, 1, At, B1); PG8_BAR; PG8_SCHED;
            } else {
            PG8_LDB(B0, 0, 0); PG8_SCHED; PG8_LDA(At, 0, 0); PG8_STAGE(PG8_SA(1, 1), a1 + hstep, voffA);
            PG8_WAIT_L(8); PG8_BAR; PG8_WAIT_L(0); PG8_MMA(0, 0, At, B0); PG8_BAR; PG8_SCHED;
            PG8_LDB(B1, 0, 1); PG8_STAGE(PG8_SB(0, 0), b2, voffB);
            PG8_BAR; PG8_WAIT_L(0); PG8_MMA(0, 1, At, B1); PG8_BAR;
            PG8_LDA(At, 0, 1); PG8_STAGE(PG8_SA(0, 0), a2, voffA);
            PG8_BAR; PG8_WAIT_L(0); PG8_MMA(1, 0, At, B0); PG8_BAR; PG8_SCHED;
            PG8_STAGE(PG8_SB(0, 1), b2 + hstep, voffB);
            PG8_WAIT_V(6); PG8_BAR; PG8_MMA(1, 1, At, B1); PG8_BAR;
            PG8_LDB(B0, 1, 0); PG8_SCHED; PG8_LDA(At, 1, 0); PG8_STAGE(PG8_SA(0, 1), a2 + hstep, voffA);
            PG8_WAIT_L(8); PG8_BAR; PG8_WAIT_L(0); PG8_MMA(0, 0, At, B0); PG8_BAR; PG8_SCHED;
            PG8_LDB(B1, 1, 1); PG8_STAGE(PG8_SB(1, 0), b3, voffB);
            PG8_BAR; PG8_WAIT_L(0); PG8_MMA(0, 1, At, B1); PG8_BAR;
            PG8_LDA(At, 1, 1); PG8_STAGE(PG8_SA(1, 0), a3, voffA);
            PG8_BAR; PG8_WAIT_L(0); PG8_MMA(1, 0, At, B0); PG8_BAR; PG8_SCHED;
            PG8_STAGE(PG8_SB(1, 1), b3 + hstep, voffB);
            PG8_WAIT_V(6); PG8_BAR; PG8_MMA(1, 1, At, B1); PG8_BAR;
            }
        }
        if constexpr (ALIGN_EPI) { if (wr == 0) PG8_BAR; }
        if constexpr (!Epi::AFTER_DRAIN) { E(acc, cur, wr, wc, fr, fq); S.done(cur); }
        if (!has_next) break;
#pragma unroll
        for (int a = 0; a < 2; ++a)
#pragma unroll
            for (int b = 0; b < 2; ++b)
#pragma unroll
                for (int m = 0; m < 4; ++m)
#pragma unroll
                    for (int n = 0; n < 2; ++n) acc[a][b][m][n] = (f32x4){0.f, 0.f, 0.f, 0.f};
        cur = nxt; cA = nA; cB = nB; ++ui;
        if constexpr (ALIGN_EPI) { if (wr == 1) PG8_BAR; }
    }
    PG8_WAIT_V(0);
    if constexpr (!ALIGN_EPI) { if (wr == 0) PG8_BAR; }
    PG8_BAR;
    if constexpr (Epi::AFTER_DRAIN) { E.fused(acc, cur, wr, wc, fr, fq, lds, wid, lane); S.done(cur); }
#undef PG8_SA
#undef PG8_SB
#undef PG8_STAGE
#undef PG8_LDA
#undef PG8_LDB
#undef PG8_MMA
#undef PG8_WAIT_V
#undef PG8_WAIT_L
#undef PG8_BAR
#undef PG8_SCHED
}
}
#define GAS __attribute__((address_space(1)))
#define LAS __attribute__((address_space(3)))
typedef unsigned short bf16;
typedef unsigned v4u __attribute__((ext_vector_type(4)));
typedef float f32x4 __attribute__((ext_vector_type(4)));
typedef short bf16x8 __attribute__((ext_vector_type(8)));
typedef GAS unsigned gu32;
typedef GAS unsigned long long gu64;
#define RLX_AGENT __ATOMIC_RELAXED, __HIP_MEMORY_SCOPE_AGENT
#define LDS_WAIT() asm volatile("s_waitcnt lgkmcnt(0)" ::: "memory")
#define VM_WAIT() asm volatile("s_waitcnt vmcnt(0)" ::: "memory")
__device__ __forceinline__ unsigned long long rt() { return __builtin_amdgcn_s_memrealtime(); }
__device__ __forceinline__ unsigned f2bf(float f) { unsigned u = __builtin_bit_cast(unsigned, f); return (u + 0x7fffu + ((u >> 16) & 1u)) >> 16; }
__device__ __forceinline__ unsigned pk2(float lo, float hi) { return f2bf(lo) | (f2bf(hi) << 16); }

#define XB_TMO      128
#define XB_XCNT(j)  (256  + 64 * (j))
#define XB_XSUB(j)  (1280 + 64 * (j))
#define XB_XGEN(j)  (2304 + 64 * (j))
#define XB_TOP      3328
#define XB_TOPGEN   3392
#define XCD_BAR_WORDS 3456
#define XB_SPIN_CAP (1u << 18)

__device__ __forceinline__ unsigned xb_ld(unsigned* p)              { return __hip_atomic_load(p, __ATOMIC_RELAXED, __HIP_MEMORY_SCOPE_AGENT); }
__device__ __forceinline__ unsigned xb_add(unsigned* p, unsigned v) { return __hip_atomic_fetch_add(p, v, __ATOMIC_RELAXED, __HIP_MEMORY_SCOPE_AGENT); }
__device__ __forceinline__ unsigned xb_xcc_id() { return (unsigned)__builtin_amdgcn_s_getreg((3 << 11) | 20) & 0xFu; }
#define XB_SPIN(cond, bar) do { unsigned _sp = 0; while (cond) { __builtin_amdgcn_s_sleep(1); \
    if ((++_sp & 255u) == 0u) { if (xb_ld(&(bar)[XB_TMO])) break; if (_sp > XB_SPIN_CAP) { atomicAdd(&(bar)[XB_TMO], 1u); break; } } } } while (0)

struct XcdBarrier {
    unsigned* bar; unsigned x;
    volatile LAS unsigned* st;
};

__device__ __forceinline__ XcdBarrier xcd_barrier_post(unsigned* bar, volatile LAS unsigned* st) {
    XcdBarrier b; b.bar = bar; b.x = xb_xcc_id(); b.st = st;
    if (threadIdx.x == 0) (void)xb_add(&bar[XB_XCNT(b.x)], 1u);
    return b;
}
__device__ __forceinline__ void xcd_barrier_complete(unsigned* bar, unsigned x, unsigned& nloc, unsigned& nx) {
    const unsigned G = gridDim.x * gridDim.y * gridDim.z;
    unsigned sum, cnt, mine, sp = 0u;
    for (;;) {
        sum = 0u; cnt = 0u; mine = 0u;
#pragma unroll
        for (unsigned j = 0; j < 16; ++j) { const unsigned c = xb_ld(&bar[XB_XCNT(j)]); sum += c; cnt += (c > 0u) ? 1u : 0u; mine = (j == x) ? c : mine; }
        if (sum == G) break;
        __builtin_amdgcn_s_sleep(1);
        if ((++sp & 255u) == 0u) { if (xb_ld(&bar[XB_TMO])) break; if (sp > XB_SPIN_CAP) { atomicAdd(&bar[XB_TMO], 1u); break; } }
    }
    nloc = mine > 0u ? mine : 1u; nx = cnt > 0u ? cnt : 1u;
}

__device__ __forceinline__ void xcd_barrier(const XcdBarrier& b) {
    asm volatile("s_waitcnt vmcnt(0)" ::: "memory");
    __syncthreads();
    if (threadIdx.x == 0) {
        unsigned* bar = b.bar;
        __builtin_amdgcn_s_waitcnt(0);
        unsigned nloc = b.st[0], nx = b.st[1];
        if (nloc == 0u) { xcd_barrier_complete(bar, b.x, nloc, nx); b.st[0] = nloc; b.st[1] = nx; }
        const unsigned old = xb_add(&bar[XB_XSUB(b.x)], 1u);
        const unsigned gen = old / nloc;
        if (old + 1u == (gen + 1u) * nloc) {
            __builtin_amdgcn_fence(__ATOMIC_RELEASE, "agent");
            asm volatile("s_waitcnt vmcnt(0)" ::: "memory");
            const unsigned og = xb_add(&bar[XB_TOP], 1u);
            const unsigned tg = og / nx;
            if (og + 1u == (tg + 1u) * nx) xb_add(&bar[XB_TOPGEN], 1u);
            else XB_SPIN(xb_ld(&bar[XB_TOPGEN]) == tg, bar);
            __builtin_amdgcn_fence(__ATOMIC_ACQUIRE, "agent");
            xb_add(&bar[XB_XGEN(b.x)], 1u);
            asm volatile("s_waitcnt vmcnt(0)" ::: "memory");
        } else {
            XB_SPIN(xb_ld(&bar[XB_XGEN(b.x)]) == gen, bar);
            __builtin_amdgcn_fence(__ATOMIC_ACQUIRE, "agent");
            asm volatile("s_waitcnt vmcnt(0)" ::: "memory");
        }
    }
    __syncthreads();
}


#ifndef MK_LAUNCH_PER_PHASE
#define MK_LAUNCH_PER_PHASE 0
#endif
constexpr int NWAVES = 8;
#ifndef PHASE_MASK
#define PHASE_MASK 0xFFFFFFFFu
#endif
#define PON(i) ((PHASE_MASK >> (i)) & 1u)
#ifndef PROBE_REP_MASK
#define PROBE_REP_MASK 0u
#endif

constexpr int NB = 4, SEQ = 2048, D = 2048, M = NB * SEQ, FF = 5632;
constexpr int IN0 = 14368, IN0P = 14592, IN1 = 3408, IN1P = 3584;
constexpr int MODW = 9 * D;
constexpr float EPS = 1e-6f;
constexpr int NPH = 27;

constexpr size_t MiB = 1u << 20;
constexpr size_t WS_CTL = 0, CTL_ZERO_BYTES = 1 * MiB;
constexpr size_t WS_MODS = 1 * MiB;
constexpr size_t WS_RTC = 2 * MiB, WS_RTS = 6 * MiB;
constexpr size_t WS_RTQ = 10 * MiB;
constexpr size_t WS_RTI = 11 * MiB;
constexpr size_t WS_SSQ = 12 * MiB;
constexpr size_t WS_DTB = 13 * MiB;
constexpr size_t WS_WGU = 24 * MiB;
constexpr size_t WS_WD = 200 * MiB;
constexpr size_t WS_WIN0 = 288 * MiB;
constexpr size_t WS_WOUT0 = 345 * MiB;
constexpr size_t WS_WIN1 = 361 * MiB;
constexpr size_t WS_WOUT1 = 375 * MiB;
constexpr size_t WS_H = 384 * MiB;
constexpr size_t WS_Y = 416 * MiB;
constexpr size_t WS_MIX = 480 * MiB;
constexpr size_t WS_BIG = 544 * MiB;
constexpr size_t WS_CD = 21 * MiB;
constexpr size_t WS_XC = 772 * MiB;
constexpr size_t WS_QR = 836 * MiB, WS_KR = 868 * MiB;
constexpr size_t WS_RST = 900 * MiB;
constexpr size_t WS_RPT = 1028 * MiB;
constexpr size_t WS_SST = WS_Y;
constexpr size_t WS_HP = WS_H;
constexpr size_t WS_IDX = 772 * MiB;
constexpr size_t WS_QA = 812 * MiB;
constexpr size_t WS_KAB = 844 * MiB, WS_VAB = 846 * MiB;
constexpr size_t WS_QIH = 848 * MiB, WS_QIL = 864 * MiB;
constexpr size_t WS_KIH = 880 * MiB, WS_KIL = 881 * MiB;
constexpr size_t WS_WI = 882 * MiB;
constexpr size_t WS_SEL = 884 * MiB;
constexpr size_t WS_NSEL = 892 * MiB;
constexpr size_t WS_END = 1092 * MiB;
constexpr size_t WGU_ELEMS = (size_t)2 * FF * D, WD_ELEMS = (size_t)D * FF;
constexpr int CW_BAR = 4096;

constexpr int RING_BYTES = 131072;
constexpr int LDSCTL_OFF = 146432, MISC_OFF = LDSCTL_OFF + 320;
constexpr int LDS_BYTES = 147456;

__device__ __forceinline__ float bf2f(unsigned short b) { return __uint_as_float(((unsigned)b) << 16); }
__device__ __forceinline__ float bflo(unsigned w) { return __uint_as_float(w << 16); }
__device__ __forceinline__ float bfhi(unsigned w) { return __uint_as_float(w & 0xffff0000u); }
__device__ __forceinline__ float silu(float v) { return v / (1.0f + __expf(-v)); }
__device__ __forceinline__ float wave_sum(float v) {
#pragma unroll
    for (int o = 1; o < 64; o <<= 1) v += __shfl_xor(v, o);
    return v;
}

struct Frame {
    LAS unsigned char* lds;
    int vcu, G;
    const float *x, *c, *mod_w, *mod_b, *norm_w, *w_gate, *w_up, *w_down, *hy_w_in, *conv_w, *conv_b, *A_log, *dt_bias, *ssd_D, *ssd_norm_w, *ret_norm_w, *hy_w_out, *dsa_w_in, *idx_k_norm_w, *dsa_w_out;
    const int* positions;
    float* out;
    unsigned char* ws;
};
#define WSP(T, off) ((T*)(F.ws + (off)))

__device__ __forceinline__ void tr_item(const float* W, int ldn, int K, int k0, int sc, int ncl, bf16* WT, int dr, LAS float* scr, int lane) {
    int cc = sc + (lane & 31); cc = cc < ncl ? cc : ncl - 1;
#pragma unroll 8
    for (int i = 0; i < 32; ++i) { const int kk = 2 * i + (lane >> 5); scr[kk * 33 + (lane & 31)] = W[(size_t)(k0 + kk) * ldn + cc]; }
    LDS_WAIT(); asm volatile("" ::: "memory");
    const int c = lane & 7;
#pragma unroll
    for (int j = 0; j < 4; ++j) { const int n = (lane >> 3) + 8 * j; const LAS float* s = scr + (8 * c) * 33 + n;
        v4u o; o.x = pk2(s[0 * 33], s[1 * 33]); o.y = pk2(s[2 * 33], s[3 * 33]); o.z = pk2(s[4 * 33], s[5 * 33]); o.w = pk2(s[6 * 33], s[7 * 33]);
        *(GAS v4u*)(WT + (size_t)(dr + n) * K + k0 + 8 * c) = o; }
    LDS_WAIT(); asm volatile("" ::: "memory");
}
__device__ __forceinline__ int in0_dst_col(int sc) {
    if (sc < 6144) return sc;
    if (sc < 6176) return 14336 + (sc - 6144);
    return sc - 32;
}
__device__ __forceinline__ void p0_prologue(Frame& F) {
    int tid_ = threadIdx.x; asm volatile("" : "+v"(tid_)); const int TID = tid_, LANE = TID & 63, WAVE = __builtin_amdgcn_readfirstlane(TID >> 6); (void)LANE; (void)WAVE;

    {
        LAS float* cond = (LAS float*)F.lds;
        LAS float* red = (LAS float*)(F.lds + 32768);
        for (int i = TID; i < NB * D; i += NWAVES * 64) cond[i] = silu(F.c[i]);
        __syncthreads();
        float* MODS = WSP(float, WS_MODS);
        for (int u = F.vcu; u < 256; u += F.G) {
            const int col0 = 144 * u, layer = col0 / MODW, j0 = col0 % MODW;
            const int cq = TID % 36, ks = TID / 36;
            if (ks < 14) {
                f32x4 a0 = {0.f, 0.f, 0.f, 0.f}, a1 = a0, a2 = a0, a3 = a0;
                const int kb = ks * 147, ke = (kb + 147 < D) ? kb + 147 : D;
                const float* wp = F.mod_w + (size_t)layer * D * MODW + j0 + 4 * cq;
#pragma unroll 4
                for (int k = kb; k < ke; ++k) { const f32x4 w = *(const f32x4*)(wp + (size_t)k * MODW);
                    a0 += cond[k] * w; a1 += cond[D + k] * w; a2 += cond[2 * D + k] * w; a3 += cond[3 * D + k] * w; }
                LAS float* r = red + (ks * 36 + cq) * 16;
                *(LAS f32x4*)(r) = a0; *(LAS f32x4*)(r + 4) = a1; *(LAS f32x4*)(r + 8) = a2; *(LAS f32x4*)(r + 12) = a3;
            }
            __syncthreads();
            for (int o = TID; o < 576; o += NWAVES * 64) { const int cq2 = o / 16, r = o % 16, b = r / 4, e = r % 4; float s = 0.f;
#pragma unroll
                for (int k2 = 0; k2 < 14; ++k2) s += red[(k2 * 36 + cq2) * 16 + r];
                const int j = j0 + 4 * cq2 + e;
                MODS[(size_t)(layer * 4 + b) * MODW + j] = s + F.mod_b[layer * MODW + j]; }
            __syncthreads();
        }
    }
    {
        const int gt = F.vcu * NWAVES * 64 + TID, NT = F.G * NWAVES * 64;
        const double INV2PI = 0.15915494309189535;
        float* rc = WSP(float, WS_RTC); float* rs = WSP(float, WS_RTS);
        for (int idx = gt; idx < M * 128; idx += NT) { const int row = idx >> 7, i = idx & 127;
            const double inv = exp2(-(double)i * (13.287712379549449 / 128.0));
            const double rev = (double)F.positions[row] * inv * INV2PI; const float fr = (float)(rev - rint(rev));
            rc[idx] = __builtin_amdgcn_cosf(fr); rs[idx] = __builtin_amdgcn_sinf(fr); }
        float* qc = WSP(float, WS_RTQ); float* qs = qc + M * 16;
        for (int idx = gt; idx < M * 16; idx += NT) { const int row = idx >> 4, i = idx & 15;
            const double inv = exp2(-(double)i * (18.931568569324174 / 16.0));
            const double rev = (double)F.positions[row] * inv * INV2PI; const float fr = (float)(rev - rint(rev));
            qc[idx] = __builtin_amdgcn_cosf(fr); qs[idx] = __builtin_amdgcn_sinf(fr); }
        float* ic = WSP(float, WS_RTI); float* is = ic + M * 8;
        for (int idx = gt; idx < M * 8; idx += NT) { const int row = idx >> 3, i = idx & 7;
            const double inv = exp2(-(double)i * (18.931568569324174 / 8.0));
            const double rev = (double)F.positions[row] * inv * INV2PI; const float fr = (float)(rev - rint(rev));
            ic[idx] = __builtin_amdgcn_cosf(fr); is[idx] = __builtin_amdgcn_sinf(fr); }
    }
    {
        LAS float* scr = (LAS float*)(F.lds + WAVE * 8448);
        const int gw = F.vcu * NWAVES + WAVE, NGW = F.G * NWAVES;
        constexpr int I_G = 32 * 176, I_D = 88 * 64, I_FFN = 2 * I_G + I_D;
        constexpr int I_IN0 = 32 * 449, I_OUT0 = 64 * 64, I_IN1 = 32 * 107, I_OUT1 = 32 * 64;
        constexpr int NITEMS = 4 * I_FFN + I_IN0 + I_OUT0 + I_IN1 + I_OUT1;
        bf16* Wgu = WSP(bf16, WS_WGU); bf16* Wd = WSP(bf16, WS_WD);
        for (int it = gw; it < NITEMS; it += NGW) {
            int r = it;
            if (r < 4 * I_FFN) { const int s = r / I_FFN; r -= s * I_FFN;
                if (r < 2 * I_G) { const int up = r / I_G; r -= up * I_G; const int kb = r / 176, nb = r % 176, sc = 32 * nb;
                    const float* W = (up ? F.w_up : F.w_gate) + (size_t)s * D * FF;
                    tr_item(W, FF, D, 64 * kb, sc, FF, Wgu + (size_t)s * WGU_ELEMS, 256 * (sc / 128) + 128 * up + (sc % 128), scr, LANE); }
                else { r -= 2 * I_G; const int kb = r / 64, nb = r % 64;
                    tr_item(F.w_down + (size_t)s * FF * D, D, FF, 64 * kb, 32 * nb, D, Wd + (size_t)s * WD_ELEMS, 32 * nb, scr, LANE); }
                continue; }
            r -= 4 * I_FFN;
            if (r < I_IN0) { const int kb = r / 449, nb = r % 449, sc = 32 * nb; tr_item(F.hy_w_in, IN0, D, 64 * kb, sc, IN0, WSP(bf16, WS_WIN0), in0_dst_col(sc), scr, LANE); continue; }
            r -= I_IN0;
            if (r < I_OUT0) { const int kb = r / 64, nb = r % 64; tr_item(F.hy_w_out, D, 2 * D, 64 * kb, 32 * nb, D, WSP(bf16, WS_WOUT0), 32 * nb, scr, LANE); continue; }
            r -= I_OUT0;
            if (r < I_IN1) { const int kb = r / 107, nb = r % 107; tr_item(F.dsa_w_in, IN1, D, 64 * kb, 32 * nb, IN1, WSP(bf16, WS_WIN1), 32 * nb, scr, LANE); continue; }
            r -= I_IN1;
            { const int kb = r / 64, nb = r % 64; tr_item(F.dsa_w_out, D, D, 64 * kb, 32 * nb, D, WSP(bf16, WS_WOUT1), 32 * nb, scr, LANE); }
        }
    }
}

__device__ __forceinline__ void thin_phase(Frame& F, int prevq, int nextq) {
    int tid_ = threadIdx.x; asm volatile("" : "+v"(tid_)); const int TID = tid_, LANE = TID & 63, WAVE = __builtin_amdgcn_readfirstlane(TID >> 6); (void)LANE; (void)WAVE;

    const int gw = F.vcu * NWAVES + WAVE, NGW = F.G * NWAVES;
    const float* xin = (prevq <= 0) ? F.x : F.out;
    const float* Y = WSP(float, WS_Y); const float* SSQ = WSP(float, WS_SSQ); const float* MODS = WSP(float, WS_MODS); bf16* H = WSP(bf16, WS_H);
    for (int row = gw; row < M; row += NGW) {
        const int b = row >> 11;
        f32x4 xv[8];
        const f32x4* xr = (const f32x4*)(xin + (size_t)row * D) + LANE;
#pragma unroll
        for (int j = 0; j < 8; ++j) xv[j] = xr[64 * j];
        if (prevq >= 0) {
            const int pl = prevq / 3, pj = prevq % 3; const float rw = (pj == 1) ? 1.0f : 0.5f;
            float s = (LANE < 32) ? SSQ[(size_t)row * 32 + LANE] : 0.f; s = wave_sum(s);
            const float sc = rw * rsqrtf(s * (1.0f / D) + EPS);
            const f32x4* yr = (const f32x4*)(Y + (size_t)row * D) + LANE;
            const f32x4* pw = (const f32x4*)(F.norm_w + (size_t)(pl * 6 + 2 * pj + 1) * D) + LANE;
            const f32x4* gt = (const f32x4*)(MODS + (size_t)(pl * 4 + b) * MODW + (3 * pj + 2) * D) + LANE;
            f32x4* xo = (f32x4*)(F.out + (size_t)row * D) + LANE;
#pragma unroll
            for (int j = 0; j < 8; ++j) { xv[j] = xv[j] + sc * (gt[64 * j] * yr[64 * j] * pw[64 * j]); xo[64 * j] = xv[j]; }
        }
        if (nextq >= 0) {
            const int nl = nextq / 3, nj = nextq % 3;
            float s = 0.f;
#pragma unroll
            for (int j = 0; j < 8; ++j) s += (xv[j].x * xv[j].x + xv[j].y * xv[j].y) + (xv[j].z * xv[j].z + xv[j].w * xv[j].w);
            const float rstd = rsqrtf(wave_sum(s) * (1.0f / D) + EPS);
            const f32x4* pw = (const f32x4*)(F.norm_w + (size_t)(nl * 6 + 2 * nj) * D) + LANE;
            const f32x4* sh = (const f32x4*)(MODS + (size_t)(nl * 4 + b) * MODW + (3 * nj) * D) + LANE;
            const f32x4* scp = (const f32x4*)(MODS + (size_t)(nl * 4 + b) * MODW + (3 * nj + 1) * D) + LANE;
            unsigned long long* o8 = (unsigned long long*)(H + (size_t)row * D) + LANE;
#pragma unroll
            for (int j = 0; j < 8; ++j) { const f32x4 h = (xv[j] * rstd) * pw[64 * j] * (scp[64 * j] + 1.0f) + sh[64 * j];
                o8[64 * j] = (unsigned long long)pk2(h.x, h.y) | ((unsigned long long)pk2(h.z, h.w) << 32); }
        }
    }
}

typedef float f32x16 __attribute__((ext_vector_type(16)));
typedef float f32x2v __attribute__((ext_vector_type(2)));
typedef __bf16 bf16x2v __attribute__((ext_vector_type(2)));
__device__ __forceinline__ unsigned pkbf(float lo, float hi) { return __builtin_bit_cast(unsigned, __builtin_convertvector((f32x2v){lo, hi}, bf16x2v)); }
#define MFMA32(a, b, c) __builtin_amdgcn_mfma_f32_32x32x16_bf16((a), (b), (c), 0, 0, 0)
template <int S> __device__ __forceinline__ bf16x8 pack8(const f32x16& x) {
    v4u p; p.x = pkbf(x[8 * S + 0], x[8 * S + 1]); p.y = pkbf(x[8 * S + 2], x[8 * S + 3]); p.z = pkbf(x[8 * S + 4], x[8 * S + 5]); p.w = pkbf(x[8 * S + 6], x[8 * S + 7]);
    return __builtin_bit_cast(bf16x8, p);
}
__device__ __forceinline__ f32x16 zero16() { f32x16 z;
#pragma unroll
    for (int i = 0; i < 16; ++i) z[i] = 0.f;
    return z; }
struct IdFrag { bf16x8 f0, f1; };
__device__ __forceinline__ IdFrag make_id(int r, int hh) { IdFrag I;
#pragma unroll
    for (int j = 0; j < 8; ++j) { I.f0[j] = (r == 8 * hh + j) ? (short)0x3F80 : (short)0; I.f1[j] = (r == 16 + 8 * hh + j) ? (short)0x3F80 : (short)0; }
    return I; }
__device__ __forceinline__ bf16x8 lfrag(const LAS unsigned char* img, int stride, int row, int col) { return *(const LAS bf16x8*)(img + row * stride + col * 2); }
__device__ __forceinline__ f32x16 to_acc_lds(const LAS unsigned char* img, int stride, int row0, int col0, int r, int hh, const IdFrag& I) {
    f32x16 x = MFMA32(lfrag(img, stride, row0 + r, col0 + 8 * hh), I.f0, zero16());
    return MFMA32(lfrag(img, stride, row0 + r, col0 + 16 + 8 * hh), I.f1, x);
}
__device__ __forceinline__ f32x16 to_acc_glb(const bf16* base, size_t ld, int r, int hh, const IdFrag& I) {
    f32x16 x = MFMA32(*(const bf16x8*)(base + (size_t)r * ld + 8 * hh), I.f0, zero16());
    return MFMA32(*(const bf16x8*)(base + (size_t)r * ld + 16 + 8 * hh), I.f1, x);
}
__device__ __forceinline__ int crow(int i, int hh) { return (i & 3) + 8 * (i >> 2) + 4 * hh; }

constexpr int XS_STRIDE = 528, BC_STRIDE = 272;
constexpr int L0_XS = 0, L0_BM = 128 * XS_STRIDE, L0_CM = L0_BM + 128 * BC_STRIDE, L0_TAB = L0_CM + 128 * BC_STRIDE;
constexpr int L0_K = 0, L0_V = 128 * XS_STRIDE, L0_Q = 128 * XS_STRIDE, L0_RS = 2 * 128 * XS_STRIDE;
static_assert(L0_TAB + 3 * 2048 <= LDSCTL_OFF && L0_RS + 4096 + 512 <= LDSCTL_OFF, "LDS map (layer-0 mixer)");

__device__ __forceinline__ void stage_conv(Frame& F, int TID, size_t R0, int g, bool withC) {
    const int ci = TID & 63, rg = TID >> 6;
    if (!withC && ci >= 48) return;
    const int xc = ci < 32 ? g * 256 + 8 * ci : (ci < 48 ? 2048 + g * 128 + 8 * (ci - 32) : 3072 + g * 128 + 8 * (ci - 48));
    LAS unsigned char* dst = F.lds + (ci < 32 ? L0_XS + ci * 16 : (ci < 48 ? L0_BM + (ci - 32) * 16 : L0_CM + (ci - 48) * 16));
    const int dstride = ci < 32 ? XS_STRIDE : BC_STRIDE;
    float w[4][8], a0[8];
#pragma unroll
    for (int j = 0; j < 4; ++j) { const f32x4 p = *(const f32x4*)(F.conv_w + (size_t)j * 4096 + xc), q = *(const f32x4*)(F.conv_w + (size_t)j * 4096 + xc + 4);
        w[j][0] = p.x; w[j][1] = p.y; w[j][2] = p.z; w[j][3] = p.w; w[j][4] = q.x; w[j][5] = q.y; w[j][6] = q.z; w[j][7] = q.w; }
    { const f32x4 p = *(const f32x4*)(F.conv_b + xc), q = *(const f32x4*)(F.conv_b + xc + 4); a0[0] = p.x; a0[1] = p.y; a0[2] = p.z; a0[3] = p.w; a0[4] = q.x; a0[5] = q.y; a0[6] = q.z; a0[7] = q.w; }
    const bf16* src = WSP(bf16, WS_BIG) + (R0 + rg * 16) * IN0P + 2048 + xc;
    const int t0 = (int)(R0 & (SEQ - 1)) + rg * 16;
    float h[3][8];
#pragma unroll
    for (int k = 0; k < 3; ++k) { v4u u = {0u, 0u, 0u, 0u}; if (t0 - 3 + k >= 0) u = *(const v4u*)(src + (ptrdiff_t)(k - 3) * IN0P);
        h[k][0] = bflo(u.x); h[k][1] = bfhi(u.x); h[k][2] = bflo(u.y); h[k][3] = bfhi(u.y); h[k][4] = bflo(u.z); h[k][5] = bfhi(u.z); h[k][6] = bflo(u.w); h[k][7] = bfhi(u.w); }
#pragma unroll 4
    for (int i = 0; i < 16; ++i) { const v4u u = *(const v4u*)(src + (size_t)i * IN0P);
        const float c[8] = {bflo(u.x), bfhi(u.x), bflo(u.y), bfhi(u.y), bflo(u.z), bfhi(u.z), bflo(u.w), bfhi(u.w)};
        float o[8];
#pragma unroll
        for (int e = 0; e < 8; ++e) { o[e] = silu(a0[e] + w[0][e] * h[0][e] + w[1][e] * h[1][e] + w[2][e] * h[2][e] + w[3][e] * c[e]); h[0][e] = h[1][e]; h[1][e] = h[2][e]; h[2][e] = c[e]; }
        v4u p; p.x = pkbf(o[0], o[1]); p.y = pkbf(o[2], o[3]); p.z = pkbf(o[4], o[5]); p.w = pkbf(o[6], o[7]);
        *(LAS v4u*)(dst + (rg * 16 + i) * dstride) = p; }
}
__device__ __forceinline__ void ssd_tables(Frame& F, int TID, int LANE, int WAVE, LAS float* tab, size_t R0, int g, float* cd) {
    LAS float* cuml = tab; LAS float* dtl = tab + 512; LAS float* wl = tab + 1024;
    { const int row = TID >> 2, hd = TID & 3, h2 = g * 4 + hd; const float v = WSP(float, WS_DTB)[(R0 + row) * 256 + h2] + F.dt_bias[h2];
      const float dt = v > 20.f ? v : log1pf(__expf(v)); dtl[hd * 128 + row] = dt; wl[hd * 128 + row] = -dt * __expf(F.A_log[h2]); }
    __syncthreads();
    if (WAVE < 4) { const float a0 = wl[WAVE * 128 + 2 * LANE], a1 = wl[WAVE * 128 + 2 * LANE + 1]; float p = a0 + a1;
#pragma unroll
        for (int o = 1; o < 64; o <<= 1) { const float t = __shfl_up(p, o); if (LANE >= o) p += t; }
        const float tot = __shfl(p, 63), c0 = p - a1;
        cuml[WAVE * 128 + 2 * LANE] = c0; cuml[WAVE * 128 + 2 * LANE + 1] = p;
        wl[WAVE * 128 + 2 * LANE] = dtl[WAVE * 128 + 2 * LANE] * __expf(tot - c0); wl[WAVE * 128 + 2 * LANE + 1] = dtl[WAVE * 128 + 2 * LANE + 1] * __expf(tot - p);
        if (cd != nullptr && LANE == 0) cd[WAVE] = __expf(tot); }
    __syncthreads();
}
__device__ __forceinline__ void m0_states(Frame& F) {
    int tid_ = threadIdx.x; asm volatile("" : "+v"(tid_)); const int TID = tid_, LANE = TID & 63, WAVE = __builtin_amdgcn_readfirstlane(TID >> 6);
    const int r_ = LANE & 31, hh_ = LANE >> 5; const IdFrag I = make_id(r_, hh_);
    for (int u = F.vcu; u < 1024; u += F.G) {
        __syncthreads();
        int r = r_, hh = hh_; asm volatile("" : "+v"(r), "+v"(hh));
        if (u < 512) {
            const int bc = u >> 3, g = u & 7; const size_t R0 = (size_t)bc * 128;
            stage_conv(F, TID, R0, g, false);
            LAS float* tab = (LAS float*)(F.lds + L0_TAB);
            ssd_tables(F, TID, LANE, WAVE, tab, R0, g, WSP(float, WS_CD) + bc * 32 + g * 4);
            const LAS float* wl = tab + 1024;
            const int head = WAVE >> 1, pt = WAVE & 1;
            f32x16 acc[4];
#pragma unroll
            for (int t = 0; t < 4; ++t) acc[t] = zero16();
#pragma unroll 1
            for (int sb = 0; sb < 4; ++sb) {
                f32x16 X = to_acc_lds(F.lds + L0_XS, XS_STRIDE, sb * 32, head * 64 + pt * 32, r, hh, I);
#pragma unroll
                for (int g4 = 0; g4 < 4; ++g4) { const f32x4 wv = *(const LAS f32x4*)(wl + head * 128 + sb * 32 + 8 * g4 + 4 * hh);
#pragma unroll
                    for (int e = 0; e < 4; ++e) X[4 * g4 + e] *= wv[e]; }
                const bf16x8 A0 = pack8<0>(X), A1 = pack8<1>(X);
#pragma unroll
                for (int nt = 0; nt < 4; ++nt) { const f32x16 XB = to_acc_lds(F.lds + L0_BM, BC_STRIDE, sb * 32, nt * 32, r, hh, I);
                    acc[nt] = MFMA32(A0, pack8<0>(XB), acc[nt]); acc[nt] = MFMA32(A1, pack8<1>(XB), acc[nt]); }
            }
            float* dst = WSP(float, WS_SST) + ((size_t)(bc * 32 + g * 4 + head) * 64 + pt * 32) * 128;
#pragma unroll
            for (int nt = 0; nt < 4; ++nt)
#pragma unroll
                for (int i = 0; i < 16; ++i) dst[(size_t)crow(i, hh) * 128 + nt * 32 + r] = acc[nt][i];
        } else {
            const int u2 = u - 512, bc = u2 >> 3, h = u2 & 7; const size_t R0 = (size_t)bc * 128;
            const bf16* PB = WSP(bf16, WS_BIG);
            for (int i = TID; i < 4096; i += NWAVES * 64) { const int row = i >> 5, ch = i & 31;
                *(LAS v4u*)(F.lds + L0_K + row * XS_STRIDE + ch * 16) = *(const v4u*)(PB + (R0 + row) * IN0P + 8192 + h * 256 + ch * 8);
                *(LAS v4u*)(F.lds + L0_V + row * XS_STRIDE + ch * 16) = *(const v4u*)(PB + (R0 + row) * IN0P + 10240 + h * 256 + ch * 8); }
            __syncthreads();
            const float lg = log2f(1.0f - exp2f(-5.0f - (float)h));
            float* dstb = WSP(float, WS_RST) + ((size_t)(bc * 8 + h) * 256 + WAVE * 32) * 256;
#pragma unroll 1
            for (int half = 0; half < 2; ++half) {
                f32x16 acc[4];
#pragma unroll
                for (int t = 0; t < 4; ++t) acc[t] = zero16();
#pragma unroll 1
                for (int sb = 0; sb < 4; ++sb) {
                    const f32x16 XV = to_acc_lds(F.lds + L0_V, XS_STRIDE, sb * 32, WAVE * 32, r, hh, I);
                    const bf16x8 A0 = pack8<0>(XV), A1 = pack8<1>(XV);
#pragma unroll
                    for (int t = 0; t < 4; ++t) { f32x16 XK = to_acc_lds(F.lds + L0_K, XS_STRIDE, sb * 32, (half * 4 + t) * 32, r, hh, I);
#pragma unroll
                        for (int i = 0; i < 16; ++i) XK[i] *= exp2f((float)(127 - (sb * 32 + crow(i, hh))) * lg);
                        acc[t] = MFMA32(A0, pack8<0>(XK), acc[t]); acc[t] = MFMA32(A1, pack8<1>(XK), acc[t]); }
                }
#pragma unroll
                for (int t = 0; t < 4; ++t)
#pragma unroll
                    for (int i = 0; i < 16; ++i) dstb[(size_t)crow(i, hh) * 256 + (half * 4 + t) * 32 + r] = acc[t][i];
            }
        }
    }
}
__device__ __forceinline__ void m0_chunkscan(Frame& F) {
    int tid_ = threadIdx.x; asm volatile("" : "+v"(tid_)); const int TID = tid_;
    const int gt = F.vcu * NWAVES * 64 + TID, NT = F.G * NWAVES * 64;
    const float* SST = WSP(float, WS_SST); const float* CD = WSP(float, WS_CD); bf16* HP = WSP(bf16, WS_HP);
    for (int idx = gt; idx < NB * 32 * 64 * 32; idx += NT) {
        const int b = idx >> 16, rem = idx & 65535, h = rem >> 11;
        f32x4 st = {0.f, 0.f, 0.f, 0.f};
        for (int c = 0; c < 16; ++c) { const size_t off = ((size_t)((b * 16 + c) * 32) * 2048 + rem) * 4;
            *(unsigned long long*)(HP + off) = (unsigned long long)pkbf(st.x, st.y) | ((unsigned long long)pkbf(st.z, st.w) << 32);
            const float a = CD[(b * 16 + c) * 32 + h]; st = st * a + *(const f32x4*)(SST + off); }
    }
    const float* RST = WSP(float, WS_RST); bf16* RPT = WSP(bf16, WS_RPT);
    for (int idx = gt; idx < NB * 8 * 256 * 64; idx += NT) {
        const int b = idx >> 17, rem = idx & 131071, h = rem >> 14;
        const float gc = exp2f(128.0f * log2f(1.0f - exp2f(-5.0f - (float)h)));
        f32x4 st = {0.f, 0.f, 0.f, 0.f};
        for (int c = 0; c < 16; ++c) { const size_t off = ((size_t)((b * 16 + c) * 8) * 16384 + rem) * 4;
            *(unsigned long long*)(RPT + off) = (unsigned long long)pkbf(st.x, st.y) | ((unsigned long long)pkbf(st.z, st.w) << 32);
            st = st * gc + *(const f32x4*)(RST + off); }
    }
}
__device__ __forceinline__ void m0_out_ssd(Frame& F) {
    int tid_ = threadIdx.x; asm volatile("" : "+v"(tid_)); const int TID = tid_, LANE = TID & 63, WAVE = __builtin_amdgcn_readfirstlane(TID >> 6);
    const int r_ = LANE & 31, hh_ = LANE >> 5; const IdFrag I = make_id(r_, hh_);
    const bf16* PB = WSP(bf16, WS_BIG); bf16* MIX = WSP(bf16, WS_MIX);
    for (int u = F.vcu; u < 512; u += F.G) {
        __syncthreads();
        int r = r_, hh = hh_; asm volatile("" : "+v"(r), "+v"(hh));
        {
            const int bc = u >> 3, g = u & 7; const size_t R0 = (size_t)bc * 128;
            stage_conv(F, TID, R0, g, true);
            LAS float* tab = (LAS float*)(F.lds + L0_TAB);
            ssd_tables(F, TID, LANE, WAVE, tab, R0, g, nullptr);
            const int head = WAVE >> 1, pt = WAVE & 1, hd = g * 4 + head;
            const LAS float* cuml = tab + head * 128; const LAS float* dtl = tab + 512 + head * 128;
            const float Dh = F.ssd_D[hd];
            bf16x8 hpf[8];
            { const bf16* hp = WSP(bf16, WS_HP) + ((size_t)(bc * 32 + hd) * 64 + pt * 32 + r) * 128 + 8 * hh;
#pragma unroll
              for (int ks = 0; ks < 8; ++ks) hpf[ks] = *(const bf16x8*)(hp + 16 * ks); }
#pragma unroll 1
            for (int lt = 0; lt < 4; ++lt) {
                f32x16 y = zero16();
#pragma unroll
                for (int ks = 0; ks < 8; ++ks) y = MFMA32(lfrag(F.lds + L0_CM, BC_STRIDE, lt * 32 + r, 16 * ks + 8 * hh), hpf[ks], y);
#pragma unroll
                for (int i = 0; i < 16; ++i) y[i] *= __expf(cuml[lt * 32 + crow(i, hh)]);
                const float cl = cuml[lt * 32 + r];
                f32x16 XS = zero16();
#pragma unroll 1
                for (int st = 0; st <= lt; ++st) {
                    f32x16 cbt = zero16();
#pragma unroll
                    for (int ks = 0; ks < 8; ++ks) cbt = MFMA32(lfrag(F.lds + L0_BM, BC_STRIDE, st * 32 + r, 16 * ks + 8 * hh), lfrag(F.lds + L0_CM, BC_STRIDE, lt * 32 + r, 16 * ks + 8 * hh), cbt);
#pragma unroll
                    for (int g4 = 0; g4 < 4; ++g4) { const f32x4 cs = *(const LAS f32x4*)(cuml + st * 32 + 8 * g4 + 4 * hh), ds = *(const LAS f32x4*)(dtl + st * 32 + 8 * g4 + 4 * hh);
#pragma unroll
                        for (int e = 0; e < 4; ++e) { const int s = st * 32 + 8 * g4 + 4 * hh + e; const float v = cbt[4 * g4 + e] * __expf(cl - cs[e]) * ds[e]; cbt[4 * g4 + e] = (s <= lt * 32 + r) ? v : 0.f; } }
                    XS = to_acc_lds(F.lds + L0_XS, XS_STRIDE, st * 32, head * 64 + pt * 32, r, hh, I);
                    y = MFMA32(pack8<0>(cbt), pack8<0>(XS), y); y = MFMA32(pack8<1>(cbt), pack8<1>(XS), y);
                }
                const f32x16 Z = to_acc_glb(PB + (R0 + lt * 32) * IN0P + hd * 64 + pt * 32, IN0P, r, hh, I);
                bf16* dst = MIX + (R0 + lt * 32) * 4096 + hd * 64 + pt * 32 + r;
#pragma unroll
                for (int i = 0; i < 16; ++i) { const float v = (y[i] + Dh * XS[i]) * silu(Z[i]); dst[(size_t)crow(i, hh) * 4096] = (bf16)(pkbf(v, v) & 0xffffu); }
            }
        }
    }
    __syncthreads();
}
__device__ __forceinline__ void m0_out_ret(Frame& F) {
    int tid_ = threadIdx.x; asm volatile("" : "+v"(tid_)); const int TID = tid_, LANE = TID & 63, WAVE = __builtin_amdgcn_readfirstlane(TID >> 6);
    const int r_ = LANE & 31, hh_ = LANE >> 5; const IdFrag I = make_id(r_, hh_);
    const bf16* PB = WSP(bf16, WS_BIG); bf16* MIX = WSP(bf16, WS_MIX);
    for (int u = 512 + F.vcu; u < 1024; u += F.G) {
        __syncthreads();
        int r = r_, hh = hh_; asm volatile("" : "+v"(r), "+v"(hh));
        const int u2 = u - 512, bc = u2 >> 3, h = u2 & 7; const size_t R0 = (size_t)bc * 128;
        for (int i = TID; i < 4096; i += NWAVES * 64) { const int row = i >> 5, ch = i & 31;
            *(LAS v4u*)(F.lds + L0_K + row * XS_STRIDE + ch * 16) = *(const v4u*)(PB + (R0 + row) * IN0P + 8192 + h * 256 + ch * 8);
            *(LAS v4u*)(F.lds + L0_Q + row * XS_STRIDE + ch * 16) = *(const v4u*)(PB + (R0 + row) * IN0P + 6144 + h * 256 + ch * 8); }
        __syncthreads();
        const float lg = log2f(1.0f - exp2f(-5.0f - (float)h));
        const int dv0 = WAVE * 32;
        f32x16 y[4];
        {
            const bf16* rpt = WSP(bf16, WS_RPT) + ((size_t)(bc * 8 + h) * 256 + dv0 + r) * 256 + 8 * hh;
#pragma unroll
            for (int lt = 0; lt < 4; ++lt) y[lt] = zero16();
#pragma unroll 2
            for (int ks = 0; ks < 16; ++ks) { const bf16x8 rf = *(const bf16x8*)(rpt + 16 * ks);
#pragma unroll
                for (int lt = 0; lt < 4; ++lt) y[lt] = MFMA32(lfrag(F.lds + L0_Q, XS_STRIDE, lt * 32 + r, 16 * ks + 8 * hh), rf, y[lt]); }
#pragma unroll
            for (int lt = 0; lt < 4; ++lt)
#pragma unroll
                for (int i = 0; i < 16; ++i) y[lt][i] *= exp2f((float)(lt * 32 + crow(i, hh) + 1) * lg);
        }
#pragma unroll
        for (int lt = 0; lt < 4; ++lt) {
#pragma unroll 1
            for (int st = 0; st <= lt; ++st) {
                const f32x16 XV = to_acc_glb(PB + (R0 + st * 32) * IN0P + 10240 + h * 256 + dv0, IN0P, r, hh, I);
                f32x16 sct = zero16();
#pragma unroll 4
                for (int ks = 0; ks < 16; ++ks) sct = MFMA32(lfrag(F.lds + L0_K, XS_STRIDE, st * 32 + r, 16 * ks + 8 * hh), lfrag(F.lds + L0_Q, XS_STRIDE, lt * 32 + r, 16 * ks + 8 * hh), sct);
#pragma unroll
                for (int i = 0; i < 16; ++i) { const int d = (lt - st) * 32 + r - crow(i, hh); sct[i] = (d >= 0) ? sct[i] * exp2f((float)d * lg) : 0.f; }
                y[lt] = MFMA32(pack8<0>(sct), pack8<0>(XV), y[lt]); y[lt] = MFMA32(pack8<1>(sct), pack8<1>(XV), y[lt]);
            }
            __builtin_amdgcn_sched_barrier(0);
        }
        asm volatile("" : "+v"(r), "+v"(hh));
        LAS float* rsum = (LAS float*)(F.lds + L0_RS);
#pragma unroll
        for (int lt = 0; lt < 4; ++lt)
#pragma unroll
            for (int i = 0; i < 16; ++i) { float s = y[lt][i] * y[lt][i];
#pragma unroll
                for (int o = 1; o < 32; o <<= 1) s += __shfl_xor(s, o);
                if (r == 0) rsum[(lt * 32 + crow(i, hh)) * 8 + WAVE] = s; __builtin_amdgcn_sched_barrier(0); }
        __syncthreads();
        if (TID < 128) { const f32x4 s0 = *(const LAS f32x4*)(rsum + TID * 8), s1 = *(const LAS f32x4*)(rsum + TID * 8 + 4);
            rsum[1024 + TID] = rsqrtf((((s0.x + s0.y) + (s0.z + s0.w)) + ((s1.x + s1.y) + (s1.z + s1.w))) * (1.0f / 256.0f) + EPS); }
        __syncthreads();
        asm volatile("" : "+v"(r), "+v"(hh));
        const float w = F.ret_norm_w[h * 256 + dv0 + r];
#pragma unroll
        for (int lt = 0; lt < 4; ++lt) {
            const f32x16 G = to_acc_glb(PB + (R0 + lt * 32) * IN0P + 12288 + h * 256 + dv0, IN0P, r, hh, I);
            bf16* dst = MIX + (R0 + lt * 32) * 4096 + 2048 + h * 256 + dv0 + r;
#pragma unroll
            for (int i = 0; i < 16; ++i) { const float rstd = rsum[1024 + lt * 32 + crow(i, hh)];
                const float v = silu(G[i]) * (y[lt][i] * rstd * w); dst[(size_t)crow(i, hh) * 4096] = (bf16)(pkbf(v, v) & 0xffffu); }
            __builtin_amdgcn_sched_barrier(0); }
    }
    __syncthreads();
}
__device__ __forceinline__ void m0_post(Frame& F) {
    int tid_ = threadIdx.x; asm volatile("" : "+v"(tid_)); const int TID = tid_, LANE = TID & 63, WAVE = __builtin_amdgcn_readfirstlane(TID >> 6);
    const int gw = F.vcu * NWAVES + WAVE, NGW = F.G * NWAVES;
    bf16* MIX = WSP(bf16, WS_MIX);
    for (int row = gw; row < M; row += NGW) {
        v4u v[4]; float s = 0.f;
#pragma unroll
        for (int j = 0; j < 4; ++j) { v[j] = *(const v4u*)(MIX + (size_t)row * 4096 + 8 * LANE + 512 * j);
            const float a0 = bflo(v[j].x), a1 = bfhi(v[j].x), a2 = bflo(v[j].y), a3 = bfhi(v[j].y), a4 = bflo(v[j].z), a5 = bfhi(v[j].z), a6 = bflo(v[j].w), a7 = bfhi(v[j].w);
            s += ((a0 * a0 + a1 * a1) + (a2 * a2 + a3 * a3)) + ((a4 * a4 + a5 * a5) + (a6 * a6 + a7 * a7)); }
        const float rstd = rsqrtf(wave_sum(s) * (1.0f / 2048.0f) + EPS);
#pragma unroll
        for (int j = 0; j < 4; ++j) { const int c = 8 * LANE + 512 * j; const f32x4 w0 = *(const f32x4*)(F.ssd_norm_w + c), w1 = *(const f32x4*)(F.ssd_norm_w + c + 4);
            v4u o; o.x = pkbf(bflo(v[j].x) * rstd * w0.x, bfhi(v[j].x) * rstd * w0.y); o.y = pkbf(bflo(v[j].y) * rstd * w0.z, bfhi(v[j].y) * rstd * w0.w);
            o.z = pkbf(bflo(v[j].z) * rstd * w1.x, bfhi(v[j].z) * rstd * w1.y); o.w = pkbf(bflo(v[j].w) * rstd * w1.z, bfhi(v[j].w) * rstd * w1.w);
            *(v4u*)(MIX + (size_t)row * 4096 + c) = o; }
    }
}
__device__ __forceinline__ void split_store8(bf16* hi, bf16* lo, const float (&v)[8]) {
    v4u h, l; unsigned hw[4], lw[4];
#pragma unroll
    for (int e = 0; e < 4; ++e) { hw[e] = pkbf(v[2 * e], v[2 * e + 1]); lw[e] = pkbf(v[2 * e] - bflo(hw[e]), v[2 * e + 1] - bfhi(hw[e])); }
    h.x = hw[0]; h.y = hw[1]; h.z = hw[2]; h.w = hw[3]; l.x = lw[0]; l.y = lw[1]; l.z = lw[2]; l.w = lw[3];
    *(v4u*)hi = h; *(v4u*)lo = l;
}
__device__ __forceinline__ void m1_prep(Frame& F) {
    int tid_ = threadIdx.x; asm volatile("" : "+v"(tid_)); const int TID = tid_;
    const int gt = F.vcu * NWAVES * 64 + TID, NT = F.G * NWAVES * 64;
    const bf16* PB = WSP(bf16, WS_BIG); const float* IDX = WSP(float, WS_IDX);
    const float* qc = WSP(float, WS_RTQ); const float* qs = qc + M * 16; const float* ic = WSP(float, WS_RTI); const float* is = ic + M * 8;
    bf16* QA = WSP(bf16, WS_QA); bf16* KAb = WSP(bf16, WS_KAB); bf16* VAb = WSP(bf16, WS_VAB);
    for (int idx = gt; idx < M * 288; idx += NT) {
        const int row = idx / 288, ch = idx % 288, hd = ch >> 4, c = ch & 15;
        const bf16* src = PB + (size_t)row * 2304 + ch * 8;
        bf16* dst = hd < 16 ? QA + (size_t)row * 2048 + ch * 8 : (hd == 16 ? KAb + (size_t)row * 128 + c * 8 : VAb + (size_t)row * 128 + c * 8);
        if (hd == 17 || c >= 4) { *(v4u*)dst = *(const v4u*)src; continue; }
        if (c >= 2) continue;
        const v4u u1 = *(const v4u*)src, u2 = *(const v4u*)(src + 16);
        const float x1[8] = {bflo(u1.x), bfhi(u1.x), bflo(u1.y), bfhi(u1.y), bflo(u1.z), bfhi(u1.z), bflo(u1.w), bfhi(u1.w)};
        const float x2[8] = {bflo(u2.x), bfhi(u2.x), bflo(u2.y), bfhi(u2.y), bflo(u2.z), bfhi(u2.z), bflo(u2.w), bfhi(u2.w)};
        float o1[8], o2[8];
#pragma unroll
        for (int e = 0; e < 8; ++e) { const float cs = qc[row * 16 + c * 8 + e], sn = qs[row * 16 + c * 8 + e]; o1[e] = x1[e] * cs - x2[e] * sn; o2[e] = x1[e] * sn + x2[e] * cs; }
        v4u w1, w2; w1.x = pkbf(o1[0], o1[1]); w1.y = pkbf(o1[2], o1[3]); w1.z = pkbf(o1[4], o1[5]); w1.w = pkbf(o1[6], o1[7]);
        w2.x = pkbf(o2[0], o2[1]); w2.y = pkbf(o2[2], o2[3]); w2.z = pkbf(o2[4], o2[5]); w2.w = pkbf(o2[6], o2[7]);
        *(v4u*)dst = w1; *(v4u*)(dst + 16) = w2;
    }
    bf16* QIH = WSP(bf16, WS_QIH); bf16* QIL = WSP(bf16, WS_QIL);
    for (int idx = gt; idx < M * 128; idx += NT) {
        const int row = idx >> 7, ch = idx & 127, c = ch & 7;
        const float* src = IDX + (size_t)row * 1280 + ch * 8;
        if (c == 1) continue;
        float v[8]; { const f32x4 a = *(const f32x4*)src, b = *(const f32x4*)(src + 4); v[0] = a.x; v[1] = a.y; v[2] = a.z; v[3] = a.w; v[4] = b.x; v[5] = b.y; v[6] = b.z; v[7] = b.w; }
        if (c == 0) { float x2[8], o2[8]; { const f32x4 a = *(const f32x4*)(src + 8), b = *(const f32x4*)(src + 12); x2[0] = a.x; x2[1] = a.y; x2[2] = a.z; x2[3] = a.w; x2[4] = b.x; x2[5] = b.y; x2[6] = b.z; x2[7] = b.w; }
#pragma unroll
            for (int e = 0; e < 8; ++e) { const float cs = ic[row * 8 + e], sn = is[row * 8 + e]; const float x1 = v[e]; v[e] = x1 * cs - x2[e] * sn; o2[e] = x1 * sn + x2[e] * cs; }
            split_store8(QIH + (size_t)row * 1024 + ch * 8 + 8, QIL + (size_t)row * 1024 + ch * 8 + 8, o2); }
        split_store8(QIH + (size_t)row * 1024 + ch * 8, QIL + (size_t)row * 1024 + ch * 8, v);
    }
    bf16* KIH = WSP(bf16, WS_KIH); bf16* KIL = WSP(bf16, WS_KIL); float* WI = WSP(float, WS_WI);
    for (int row = gt; row < M; row += NT) {
        const float* si = IDX + (size_t)row * 1280 + 1024;
        float ss = 0.f;
#pragma unroll 4
        for (int i = 0; i < 64; i += 4) { const f32x4 a = *(const f32x4*)(si + i); ss += (a.x * a.x + a.y * a.y) + (a.z * a.z + a.w * a.w); }
        const float rstd = rsqrtf(ss * (1.0f / 64.0f) + EPS);
#pragma unroll 1
        for (int c = 0; c < 8; ++c) { if (c == 1) continue;
            float v[8];
#pragma unroll
            for (int e = 0; e < 8; ++e) v[e] = si[c * 8 + e] * rstd * F.idx_k_norm_w[c * 8 + e];
            if (c == 0) { float o2[8];
#pragma unroll
                for (int e = 0; e < 8; ++e) { const float x2 = si[8 + e] * rstd * F.idx_k_norm_w[8 + e], cs = ic[row * 8 + e], sn = is[row * 8 + e], x1 = v[e]; v[e] = x1 * cs - x2 * sn; o2[e] = x1 * sn + x2 * cs; }
                split_store8(KIH + (size_t)row * 64 + 8, KIL + (size_t)row * 64 + 8, o2); }
            split_store8(KIH + (size_t)row * 64 + c * 8, KIL + (size_t)row * 64 + c * 8, v); }
#pragma unroll
        for (int h4 = 0; h4 < 4; ++h4) { const f32x4 a = *(const f32x4*)(IDX + (size_t)row * 1280 + 1088 + 4 * h4); *(f32x4*)(WI + (size_t)row * 16 + 4 * h4) = a * 0.03125f; }
    }
}
__device__ __forceinline__ void m1_index(Frame& F) {
    int tid_ = threadIdx.x; asm volatile("" : "+v"(tid_)); const int TID = tid_, LANE = TID & 63, WAVE = __builtin_amdgcn_readfirstlane(TID >> 6);
    const int r = LANE & 31, hh = LANE >> 5;
    LAS unsigned* sc = (LAS unsigned*)(F.lds + WAVE * 16384);
    const int gw = F.vcu * NWAVES + WAVE, NGW = F.G * NWAVES;
    const bf16* QIH = WSP(bf16, WS_QIH); const bf16* QIL = WSP(bf16, WS_QIL); const bf16* KIH = WSP(bf16, WS_KIH); const bf16* KIL = WSP(bf16, WS_KIL);
    const float* WI = WSP(float, WS_WI); int* SEL = WSP(int, WS_SEL); int* NSEL = WSP(int, WS_NSEL);
    const unsigned long long ltmask = (1ull << LANE) - 1ull;
    for (int it = 0;; ++it) {
        int pr;
        if (NGW == 2048) { if (it >= 2) break; pr = it == 0 ? gw : 4095 - gw; } else { pr = gw + it * NGW; if (pr >= 4096) break; }
        const int row0 = 2 * pr, b = row0 >> 11, qp0 = row0 & (SEQ - 1);
        if (qp0 + 1 <= 255) {
#pragma unroll 1
            for (int qq = 0; qq < 2; ++qq) { const int nv = qp0 + qq + 1; for (int i = LANE; i < nv; i += 64) SEL[(size_t)(row0 + qq) * 256 + i] = i; if (LANE == 0) NSEL[row0 + qq] = nv; }
            continue; }
        bf16x8 Ah[4], Al[4];
        { const int qq = (r >> 2) & 1, hd = (r & 3) + 4 * (r >> 3); const size_t o = (size_t)(row0 + qq) * 1024 + hd * 64 + 8 * hh;
#pragma unroll
          for (int ks = 0; ks < 4; ++ks) { Ah[ks] = *(const bf16x8*)(QIH + o + 16 * ks); Al[ks] = *(const bf16x8*)(QIL + o + 16 * ks); } }
        float wv[16];
#pragma unroll
        for (int h4 = 0; h4 < 4; ++h4) { const f32x4 a = *(const f32x4*)(WI + (size_t)(row0 + hh) * 16 + 4 * h4); wv[4 * h4] = a.x; wv[4 * h4 + 1] = a.y; wv[4 * h4 + 2] = a.z; wv[4 * h4 + 3] = a.w; }
        const int ntile = (qp0 + 1) / 32 + 1;
#pragma unroll 1
        for (int kt = 0; kt < ntile; ++kt) {
            const size_t ko = ((size_t)b * SEQ + kt * 32 + r) * 64 + 8 * hh;
            f32x16 acc = zero16();
#pragma unroll
            for (int ks = 0; ks < 4; ++ks) { const bf16x8 Bh = *(const bf16x8*)(KIH + ko + 16 * ks), Bl = *(const bf16x8*)(KIL + ko + 16 * ks);
                acc = MFMA32(Ah[ks], Bh, acc); acc = MFMA32(Ah[ks], Bl, acc); acc = MFMA32(Al[ks], Bh, acc); }
            float s = 0.f;
#pragma unroll
            for (int i = 0; i < 16; ++i) s += fmaxf(acc[i], 0.f) * wv[i];
            s += 0.0f;
            const int key = kt * 32 + r; const unsigned uu = __float_as_uint(s); const unsigned ok = (uu & 0x80000000u) ? ~uu : (uu | 0x80000000u);
            sc[hh * 2048 + key] = (key <= qp0 + hh) ? ok : 0u;
        }
        if (ntile & 1) sc[hh * 2048 + ntile * 32 + r] = 0u;
        asm volatile("s_waitcnt lgkmcnt(0)" ::: "memory");
#pragma unroll 1
        for (int qq = 0; qq < 2; ++qq) {
            const int nv = qp0 + qq + 1, nj = (nv + 63) >> 6; const int row = row0 + qq;
            unsigned vals[32];
#pragma unroll
            for (int j = 0; j < 32; ++j) vals[j] = (j < nj) ? sc[qq * 2048 + j * 64 + LANE] : 0u;
            unsigned prefix = 0u; bool exact = false;
#pragma unroll 1
            for (int bit = 31; bit >= 0; --bit) { const unsigned cand = prefix | (1u << bit); int cnt = 0;
#pragma unroll
                for (int j = 0; j < 32; ++j) cnt += __popcll(__ballot(vals[j] >= cand));
                if (cnt >= 256) prefix = cand;
                if (cnt == 256) { exact = true; break; } }
            const unsigned T = exact ? prefix - 1u : prefix;
            int base = 0;
#pragma unroll
            for (int j = 0; j < 32; ++j) { const bool p = vals[j] > T; const unsigned long long mk = __ballot(p);
                if (p) SEL[(size_t)row * 256 + base + __popcll(mk & ltmask)] = j * 64 + LANE; base += __popcll(mk); }
            if (!exact) { int need = 256 - base;
#pragma unroll
                for (int j = 0; j < 32; ++j) { const bool p = vals[j] == T; const unsigned long long mk = __ballot(p); const int rank = __popcll(mk & ltmask);
                    if (p && rank < need) SEL[(size_t)row * 256 + base + rank] = j * 64 + LANE;
                    const int c = __popcll(mk); const int take = c < need ? c : need; base += take; need -= take; } }
            if (LANE == 0) NSEL[row] = 256;
        }
    }
}
__device__ __forceinline__ void m1_attn(Frame& F) {
    int tid_ = threadIdx.x; asm volatile("" : "+v"(tid_)); const int TID = tid_, LANE = TID & 63, WAVE = __builtin_amdgcn_readfirstlane(TID >> 6);
    const int r_ = LANE & 31, hh_ = LANE >> 5; const IdFrag I = make_id(r_, hh_);
    const int gw = F.vcu * NWAVES + WAVE, NGW = F.G * NWAVES;
    const bf16* QA = WSP(bf16, WS_QA); const bf16* KAb = WSP(bf16, WS_KAB); const bf16* VAb = WSP(bf16, WS_VAB); const int* SEL = WSP(int, WS_SEL); const int* NSEL = WSP(int, WS_NSEL); bf16* MIX = WSP(bf16, WS_MIX);
#pragma unroll 1
    for (int q = gw; q < M; q += NGW) {
        int r = r_, hh = hh_; asm volatile("" : "+v"(r), "+v"(hh));
        const int b = q >> 11, nsel = NSEL[q], ntile = (nsel + 31) >> 5;
        bf16x8 qf[8];
#pragma unroll
        for (int ks = 0; ks < 8; ++ks) qf[ks] = *(const bf16x8*)(QA + (size_t)q * 2048 + (r & 15) * 128 + 16 * ks + 8 * hh);
        float mx = -3.0e38f;
#pragma unroll 1
        for (int kt = 0; kt < ntile; ++kt) {
            const int sid = (kt * 32 + r < nsel) ? SEL[(size_t)q * 256 + kt * 32 + r] : 0;
            const bf16* kp = KAb + ((size_t)b * SEQ + sid) * 128 + 8 * hh;
            f32x16 L = zero16();
#pragma unroll
            for (int ks = 0; ks < 8; ++ks) L = MFMA32(*(const bf16x8*)(kp + 16 * ks), qf[ks], L);
#pragma unroll
            for (int i = 0; i < 16; ++i) mx = fmaxf(mx, (kt * 32 + crow(i, hh) < nsel) ? L[i] * 0.08838834764831845f : -3.0e38f);
        }
        mx = fmaxf(mx, __shfl_xor(mx, 32));
        float sum = 0.f;
        f32x16 o[4];
#pragma unroll
        for (int dt = 0; dt < 4; ++dt) o[dt] = zero16();
#pragma unroll 1
        for (int kt = 0; kt < ntile; ++kt) {
            const int sid = (kt * 32 + r < nsel) ? SEL[(size_t)q * 256 + kt * 32 + r] : 0;
            const bf16* kp = KAb + ((size_t)b * SEQ + sid) * 128 + 8 * hh;
            f32x16 L = zero16();
#pragma unroll
            for (int ks = 0; ks < 8; ++ks) L = MFMA32(*(const bf16x8*)(kp + 16 * ks), qf[ks], L);
#pragma unroll
            for (int i = 0; i < 16; ++i) { const float e = (kt * 32 + crow(i, hh) < nsel) ? __expf(L[i] * 0.08838834764831845f - mx) : 0.f; L[i] = e; sum += e; }
            const bf16x8 P0 = pack8<0>(L), P1 = pack8<1>(L);
            const bf16* vp = VAb + ((size_t)b * SEQ + sid) * 128 + 8 * hh;
#pragma unroll
            for (int dt = 0; dt < 4; ++dt) { f32x16 xv = MFMA32(*(const bf16x8*)(vp + dt * 32), I.f0, zero16()); xv = MFMA32(*(const bf16x8*)(vp + dt * 32 + 16), I.f1, xv);
                o[dt] = MFMA32(P0, pack8<0>(xv), o[dt]); o[dt] = MFMA32(P1, pack8<1>(xv), o[dt]); }
        }
        sum += __shfl_xor(sum, 32);
        const float inv = 1.0f / sum;
#pragma unroll
        for (int i = 0; i < 8; ++i) { const int head = crow(i, hh); const float ih = __shfl(inv, head);
#pragma unroll
            for (int dt = 0; dt < 4; ++dt) { const float v = o[dt][i] * ih; MIX[(size_t)q * 2048 + head * 128 + dt * 32 + r] = (bf16)(pkbf(v, v) & 0xffffu); } }
    }
}
struct Args { const void* in[21]; float* out; unsigned char* ws; int ph_lo, ph_hi; };
__global__ void __launch_bounds__(NWAVES * 64, 2) mk_fwd(Args args) {
    extern __shared__ __attribute__((aligned(16))) unsigned char lds_raw[];
    Frame F;
    F.lds = (LAS unsigned char*)lds_raw;
    F.G = gridDim.x; { const int bx = blockIdx.x; F.vcu = (F.G % 8 == 0) ? (bx % 8) * (F.G / 8) + bx / 8 : bx; }
    F.x = (const float*)args.in[0]; F.c = (const float*)args.in[1]; F.positions = (const int*)args.in[2]; F.mod_w = (const float*)args.in[3]; F.mod_b = (const float*)args.in[4];
    F.norm_w = (const float*)args.in[5]; F.w_gate = (const float*)args.in[6]; F.w_up = (const float*)args.in[7]; F.w_down = (const float*)args.in[8]; F.hy_w_in = (const float*)args.in[9];
    F.conv_w = (const float*)args.in[10]; F.conv_b = (const float*)args.in[11]; F.A_log = (const float*)args.in[12]; F.dt_bias = (const float*)args.in[13]; F.ssd_D = (const float*)args.in[14];
    F.ssd_norm_w = (const float*)args.in[15]; F.ret_norm_w = (const float*)args.in[16]; F.hy_w_out = (const float*)args.in[17]; F.dsa_w_in = (const float*)args.in[18];
    F.idx_k_norm_w = (const float*)args.in[19]; F.dsa_w_out = (const float*)args.in[20];
    F.out = args.out; F.ws = args.ws;
    const int TID = threadIdx.x;
    volatile LAS unsigned* MISC = (volatile LAS unsigned*)(F.lds + MISC_OFF);
    for (int u = TID; u < (LDS_BYTES - LDSCTL_OFF) / 4; u += NWAVES * 64) ((LAS unsigned*)(F.lds + LDSCTL_OFF))[u] = 0u;
    __syncthreads();
    const int lo = args.ph_lo, hi = args.ph_hi;
    XcdBarrier bar; bar.bar = (unsigned*)(F.ws + WS_CTL) + CW_BAR; bar.x = 0; bar.st = nullptr;
    if (hi - lo > 1) bar = xcd_barrier_post((unsigned*)(F.ws + WS_CTL) + CW_BAR, MISC + 8);
#define RUN(k) (lo <= (k) && (k) < hi)
#define REPS(i) (1 + (int)((PROBE_REP_MASK >> (i)) & 1u))
#define SEAM(k) do { if (RUN(k) && RUN((k) + 1)) xcd_barrier(bar); } while (0)
    bf16* H = WSP(bf16, WS_H); bf16* ACT = WSP(bf16, WS_BIG); bf16* PB = WSP(bf16, WS_BIG); bf16* MIX = WSP(bf16, WS_MIX); float* Y = WSP(float, WS_Y); float* SSQ = WSP(float, WS_SSQ);

    if (PON(0) && RUN(0)) for (int rep_ = 0; rep_ < REPS(0); ++rep_) { p0_prologue(F); __syncthreads(); }
    SEAM(0);
    if (PON(1) && RUN(1)) thin_phase(F, -1, 0);
    SEAM(1);
    int ph = 2, q = 0;
    for (int s = 0; s < 4; ++s) {
        if (PON(2) && RUN(ph)) for (int rep_ = 0; rep_ < REPS(2); ++rep_) { pg8::Gemm g{H, WSP(bf16, WS_WGU) + (size_t)s * WGU_ELEMS, M, 2 * FF, D}; pg8::StaticOrder S; S.init(M, 2 * FF, F.G, (int)blockIdx.x);
            pg8::EpiGateUp E{ACT, FF}; pg8::gemm_phase<pg8::EpiGateUp, pg8::StaticOrder, true, true>(F.lds, g, S, E); }
        SEAM(ph); ++ph;
        if (PON(3) && RUN(ph)) for (int rep_ = 0; rep_ < REPS(3); ++rep_) { pg8::Gemm g{ACT, WSP(bf16, WS_WD) + (size_t)s * WD_ELEMS, M, D, FF}; pg8::StaticOrder S; S.init(M, D, F.G, (int)blockIdx.x);
            pg8::EpiYSsq E{Y, D, SSQ}; pg8::gemm_phase<pg8::EpiYSsq, pg8::StaticOrder, true, true>(F.lds, g, S, E); }
        SEAM(ph); ++ph;
        if (PON(1) && RUN(ph)) thin_phase(F, q, q < 5 ? q + 1 : -1);
        SEAM(ph); ++ph; ++q;
        if (s == 0) {
            if (PON(4) && RUN(ph)) for (int rep_ = 0; rep_ < REPS(4); ++rep_) { pg8::Gemm g{H, WSP(bf16, WS_WIN0), M, IN0P, D}; pg8::StaticOrder S; S.init(M, IN0P, F.G, (int)blockIdx.x);
                pg8::EpiProj0 E{PB, IN0P, WSP(float, WS_DTB), WSP(float, WS_RTC), WSP(float, WS_RTS)}; pg8::gemm_phase<pg8::EpiProj0, pg8::StaticOrder, true, true>(F.lds, g, S, E); }
            SEAM(ph); ++ph;
            if (PON(6) && RUN(ph)) for (int rep_ = 0; rep_ < REPS(6); ++rep_) { m0_states(F); __syncthreads(); }
            SEAM(ph); ++ph;
            if (PON(14) && RUN(ph)) for (int rep_ = 0; rep_ < REPS(14); ++rep_) { m0_chunkscan(F); __syncthreads(); }
            SEAM(ph); ++ph;
            if (PON(15) && RUN(ph)) for (int rep_ = 0; rep_ < REPS(15); ++rep_) {
#ifndef T_NO_SSD
 m0_out_ssd(F);
#endif
#ifndef T_NO_RET
 m0_out_ret(F);
#endif
 }
            SEAM(ph); ++ph;
            if (PON(7) && RUN(ph)) m0_post(F);
            SEAM(ph); ++ph;
            if (PON(8) && RUN(ph)) for (int rep_ = 0; rep_ < REPS(8); ++rep_) { pg8::Gemm g{MIX, WSP(bf16, WS_WOUT0), M, D, 2 * D}; pg8::StaticOrder S; S.init(M, D, F.G, (int)blockIdx.x);
                pg8::EpiYSsq E{Y, D, SSQ}; pg8::gemm_phase<pg8::EpiYSsq, pg8::StaticOrder, true, true>(F.lds, g, S, E); }
            SEAM(ph); ++ph;
            if (PON(1) && RUN(ph)) thin_phase(F, q, q + 1);
            SEAM(ph); ++ph; ++q;
        }
        if (s == 2) {
            if (PON(9) && RUN(ph)) for (int rep_ = 0; rep_ < REPS(9); ++rep_) { pg8::Gemm g{H, WSP(bf16, WS_WIN1), M, IN1P, D}; pg8::StaticOrder S; S.init(M, IN1P, F.G, (int)blockIdx.x);
                pg8::EpiProj E{PB, 2304, 9, WSP(float, WS_IDX), 1280}; pg8::gemm_phase<pg8::EpiProj, pg8::StaticOrder, true, true>(F.lds, g, S, E); }
            SEAM(ph); ++ph;
            if (PON(10) && RUN(ph)) for (int rep_ = 0; rep_ < REPS(10); ++rep_) { m1_prep(F); __syncthreads(); }
            SEAM(ph); ++ph;
            if (PON(11) && RUN(ph)) for (int rep_ = 0; rep_ < REPS(11); ++rep_) { m1_index(F); __syncthreads(); }
            SEAM(ph); ++ph;
            if (PON(12) && RUN(ph)) for (int rep_ = 0; rep_ < REPS(12); ++rep_) { m1_attn(F); __syncthreads(); }
            SEAM(ph); ++ph;
            if (PON(13) && RUN(ph)) for (int rep_ = 0; rep_ < REPS(13); ++rep_) { pg8::Gemm g{MIX, WSP(bf16, WS_WOUT1), M, D, D}; pg8::StaticOrder S; S.init(M, D, F.G, (int)blockIdx.x);
                pg8::EpiYSsq E{Y, D, SSQ}; pg8::gemm_phase<pg8::EpiYSsq, pg8::StaticOrder, true, true>(F.lds, g, S, E); }
            SEAM(ph); ++ph;
            if (PON(1) && RUN(ph)) thin_phase(F, q, q + 1);
            SEAM(ph); ++ph; ++q;
        }
    }
#undef RUN
#undef SEAM
}

extern "C" void kernel_launch(void* const* d_in, const int* in_sizes, int n_in, void* d_out, int out_size, void* d_ws, size_t ws_size, hipStream_t stream) {
    static int grid = 0;
    if (grid == 0) {
        if (n_in != 21 || out_size != M * D || ws_size < WS_END) { fprintf(stderr, "kernel_launch: unexpected shapes (n_in %d, out %d, ws %zu < %zu)\n", n_in, out_size, ws_size, (size_t)WS_END); grid = -1; return; }
        int dev = 0, cus = 0, per_cu = 0;
        if (hipGetDevice(&dev) != hipSuccess || hipDeviceGetAttribute(&cus, hipDeviceAttributeMultiprocessorCount, dev) != hipSuccess) { grid = -1; return; }
        if (hipFuncSetAttribute((const void*)mk_fwd, hipFuncAttributeMaxDynamicSharedMemorySize, LDS_BYTES) != hipSuccess) { fprintf(stderr, "kernel_launch: hipFuncSetAttribute failed\n"); grid = -1; return; }
        if (hipOccupancyMaxActiveBlocksPerMultiprocessor(&per_cu, (const void*)mk_fwd, NWAVES * 64, LDS_BYTES) != hipSuccess || per_cu < 1) { fprintf(stderr, "kernel_launch: occupancy query says %d\n", per_cu); }
        (void)hipGetLastError();
        grid = cus;
    }
    if (grid < 0) return;
    (void)hipMemsetAsync((char*)d_ws + WS_CTL, 0, CTL_ZERO_BYTES, stream);
    Args a{};
    for (int i = 0; i < 21; ++i) a.in[i] = d_in[i];
    a.out = (float*)d_out; a.ws = (unsigned char*)d_ws;
#if MK_LAUNCH_PER_PHASE
    for (int p = 0; p < NPH; ++p) { a.ph_lo = p; a.ph_hi = p + 1; hipLaunchKernelGGL(mk_fwd, dim3(grid), dim3(NWAVES * 64), LDS_BYTES, stream, a); }
#else
    a.ph_lo = 0; a.ph_hi = NPH; hipLaunchKernelGGL(mk_fwd, dim3(grid), dim3(NWAVES * 64), LDS_BYTES, stream, a);
#endif
}
```

```cpp
#include <hip/hip_runtime.h>
#include <cstdio>
#include <cstdint>
namespace pg8 {
#define PG8_LAS __attribute__((address_space(3)))
typedef unsigned short bf16_t;
typedef short bf16x8 __attribute__((ext_vector_type(8)));
typedef float f32x4 __attribute__((ext_vector_type(4)));
typedef unsigned u32x4 __attribute__((ext_vector_type(4)));
constexpr int BM = 256, BK = 64, HALF = 128, HTB = HALF * BK * 2  , STAGE_BYTES = 8 * HTB, NXCD = 8, WGM = 8;

__host__ __device__ __forceinline__ int lds_byte(int r, int c) { const int st = (r >> 4) * 2 + (c >> 5), rr = r & 15, cc = c & 31, ob = rr * 64 + cc * 2; return st * 1024 + (ob ^ (((ob >> 9) & 1) << 5)); }
__host__ __device__ __forceinline__ void stage_rc(int b, int& R, int& C) { const int st = b / 1024, sb = b % 1024, swz = sb ^ (((sb >> 9) & 1) << 5); R = (st >> 1) * 16 + swz / 64; C = (st & 1) * 32 + (swz % 64) / 2; }
__host__ __device__ __forceinline__ int perm32(int rho) { const int n = rho >> 4, i = rho & 15; return 8 * (i >> 2) + 4 * n + (i & 3); }

struct Unit { int pm, pn; };
struct Gemm { const bf16_t* A; const bf16_t* Bt; int M, N, K; };

struct StaticOrder {
    int nM, nN, nwg, G, c;
    __host__ __device__ void init(int M, int N, int G_, int c_) { nM = M / BM; nN = N / BM; nwg = nM * nN; G = G_; c = c_; }
    __host__ __device__ bool next(int i, Unit& u) const {
        const long L = (long)i * G + c; if (L >= nwg) return false;
        int wgid = (int)L; { const int q = nwg / NXCD, r = nwg % NXCD, xcd = wgid % NXCD, off = wgid / NXCD; wgid = (xcd < r ? xcd * (q + 1) : r * (q + 1) + (xcd - r) * q) + off; }
        const int nig = WGM * nN, gid = wgid / nig, fm = gid * WGM, gsz = (nM - fm) < WGM ? (nM - fm) : WGM;
        u.pm = fm + ((wgid % nig) % gsz); u.pn = (wgid % nig) / gsz; return true;
    }
    __device__ __forceinline__ void a_ready(const Unit&) const {}
    __device__ __forceinline__ void done(const Unit&) const {}
};

__device__ __forceinline__ unsigned cvt_pk_bf16(float lo, float hi) { unsigned r; asm volatile("v_cvt_pk_bf16_f32 %0, %1, %2" : "=v"(r) : "v"(lo), "v"(hi)); return r; }
typedef float f32x2 __attribute__((ext_vector_type(2)));
__device__ __forceinline__ float silu_f(float v) { return v * __builtin_amdgcn_rcpf(1.0f + __expf(-v)); }

struct EpiGateUp {
    static constexpr bool PERM = true, AFTER_DRAIN = false;
    bf16_t* O; int ldc;
    __device__ __forceinline__ void operator()(const f32x4 (&acc)[2][2][4][2], const Unit& u, int wr, int wc, int fr, int fq) const {
        const int row0 = u.pm * BM + wr * 64 + fr, col0 = u.pn * HALF + wc * 32 + 8 * fq;
#pragma unroll
        for (int ai = 0; ai < 2; ++ai)
#pragma unroll
            for (int m = 0; m < 4; ++m) { bf16_t* rowp = O + (size_t)(row0 + ai * HALF + m * 16) * ldc + col0;
                const f32x4 g0 = acc[ai][0][m][0], g1 = acc[ai][0][m][1], u0 = acc[ai][1][m][0], u1 = acc[ai][1][m][1];
                f32x4 v0, v1;
#pragma unroll
                for (int j = 0; j < 4; ++j) { v0[j] = silu_f(g0[j]) * u0[j]; v1[j] = silu_f(g1[j]) * u1[j]; }
                u32x4 w; w.x = cvt_pk_bf16(v0[0], v0[1]); w.y = cvt_pk_bf16(v0[2], v0[3]); w.z = cvt_pk_bf16(v1[0], v1[1]); w.w = cvt_pk_bf16(v1[2], v1[3]);
                *(u32x4*)rowp = w; }
    }
};
struct EpiYSsq {
    static constexpr bool PERM = false, AFTER_DRAIN = false;
    float* C; int ldc; float* ssq;
    __device__ __forceinline__ void operator()(const f32x4 (&acc)[2][2][4][2], const Unit& u, int wr, int wc, int fr, int fq) const {
        const int row0 = u.pm * BM + wr * 64 + fr, col0 = u.pn * BM + wc * 32 + 4 * fq;
#pragma unroll
        for (int ai = 0; ai < 2; ++ai)
#pragma unroll
            for (int m = 0; m < 4; ++m) { const int row = row0 + ai * HALF + m * 16; float* rowp = C + (size_t)row * ldc + col0; float s = 0.f;
#pragma unroll
                for (int bj = 0; bj < 2; ++bj)
#pragma unroll
                    for (int n = 0; n < 2; ++n) { const f32x4 v = acc[ai][bj][m][n]; *(f32x4*)(rowp + bj * HALF + n * 16) = v; s += (v[0] * v[0] + v[1] * v[1]) + (v[2] * v[2] + v[3] * v[3]); }
                s += __shfl_xor(s, 16); s += __shfl_xor(s, 32);
                if (fq == 0) ssq[(size_t)row * 32 + u.pn * 4 + wc] = s; }
    }
};
struct EpiProj {
    static constexpr bool PERM = true, AFTER_DRAIN = false;
    bf16_t* O; int ldo; int nbf; float* Fo; int ldf;
    __device__ __forceinline__ void operator()(const f32x4 (&acc)[2][2][4][2], const Unit& u, int wr, int wc, int fr, int fq) const {
        const int row0 = u.pm * BM + wr * 64 + fr;
        if (u.pn < nbf) {
            const int col0 = u.pn * BM + wc * 32 + 8 * fq;
#pragma unroll
            for (int ai = 0; ai < 2; ++ai)
#pragma unroll
                for (int m = 0; m < 4; ++m) { bf16_t* rowp = O + (size_t)(row0 + ai * HALF + m * 16) * ldo + col0;
#pragma unroll
                    for (int bj = 0; bj < 2; ++bj) { const f32x4 v0 = acc[ai][bj][m][0], v1 = acc[ai][bj][m][1];
                        u32x4 w; w.x = cvt_pk_bf16(v0[0], v0[1]); w.y = cvt_pk_bf16(v0[2], v0[3]); w.z = cvt_pk_bf16(v1[0], v1[1]); w.w = cvt_pk_bf16(v1[2], v1[3]);
                        *(u32x4*)(rowp + bj * HALF) = w; } }
        } else {
            const int col0 = (u.pn - nbf) * BM + wc * 32 + 8 * fq;
#pragma unroll
            for (int ai = 0; ai < 2; ++ai)
#pragma unroll
                for (int m = 0; m < 4; ++m) { float* rowp = Fo + (size_t)(row0 + ai * HALF + m * 16) * ldf + col0;
#pragma unroll
                    for (int bj = 0; bj < 2; ++bj) { *(f32x4*)(rowp + bj * HALF) = acc[ai][bj][m][0]; *(f32x4*)(rowp + bj * HALF + 4) = acc[ai][bj][m][1]; } }
        }
    }
};
struct EpiProj0 {
    static constexpr bool PERM = true, AFTER_DRAIN = false;
    bf16_t* O; int ldo; float* Fo; const float* rc; const float* rs;
    __device__ __forceinline__ void operator()(const f32x4 (&acc)[2][2][4][2], const Unit& u, int wr, int wc, int fr, int fq) const {
        const int row0 = u.pm * BM + wr * 64 + fr;
        if (u.pn == 56) {
            const int col0 = wc * 32 + 8 * fq;
#pragma unroll
            for (int ai = 0; ai < 2; ++ai)
#pragma unroll
                for (int m = 0; m < 4; ++m) { float* rowp = Fo + (size_t)(row0 + ai * HALF + m * 16) * 256 + col0;
#pragma unroll
                    for (int bj = 0; bj < 2; ++bj) { *(f32x4*)(rowp + bj * HALF) = acc[ai][bj][m][0]; *(f32x4*)(rowp + bj * HALF + 4) = acc[ai][bj][m][1]; } }
            return;
        }
        const int col0 = u.pn * BM + wc * 32 + 8 * fq;
        const bool rot = (u.pn >= 24 && u.pn < 40); const float sc = (u.pn >= 32) ? 0.0625f : 1.0f;
#pragma unroll
        for (int ai = 0; ai < 2; ++ai)
#pragma unroll
            for (int m = 0; m < 4; ++m) { const int row = row0 + ai * HALF + m * 16; bf16_t* rowp = O + (size_t)row * ldo + col0;
                f32x4 a0 = acc[ai][0][m][0], a1 = acc[ai][0][m][1], b0 = acc[ai][1][m][0], b1 = acc[ai][1][m][1];
                if (rot) { const int i0 = wc * 32 + 8 * fq;
                    const f32x4 c0 = *(const f32x4*)(rc + (size_t)row * 128 + i0), c1 = *(const f32x4*)(rc + (size_t)row * 128 + i0 + 4), s0 = *(const f32x4*)(rs + (size_t)row * 128 + i0), s1 = *(const f32x4*)(rs + (size_t)row * 128 + i0 + 4);
                    const f32x4 x0 = a0, x1 = a1, y0 = b0, y1 = b1;
                    a0 = (x0 * c0 - y0 * s0) * sc; a1 = (x1 * c1 - y1 * s1) * sc; b0 = (x0 * s0 + y0 * c0) * sc; b1 = (x1 * s1 + y1 * c1) * sc; }
                u32x4 w; w.x = cvt_pk_bf16(a0[0], a0[1]); w.y = cvt_pk_bf16(a0[2], a0[3]); w.z = cvt_pk_bf16(a1[0], a1[1]); w.w = cvt_pk_bf16(a1[2], a1[3]);
                *(u32x4*)rowp = w;
                w.x = cvt_pk_bf16(b0[0], b0[1]); w.y = cvt_pk_bf16(b0[2], b0[3]); w.z = cvt_pk_bf16(b1[0], b1[1]); w.w = cvt_pk_bf16(b1[2], b1[3]);
                *(u32x4*)(rowp + HALF) = w; }
    }
};
template <class Epi, class Sched, bool ALIGN_EPI = false, bool SP2 = false>
__device__ __forceinline__ void gemm_phase(PG8_LAS unsigned char* lds, const Gemm g, const Sched& S, const Epi& E) {
    int tid_ = threadIdx.x; asm volatile("" : "+v"(tid_));
    const int tid = tid_, wid = __builtin_amdgcn_readfirstlane(tid >> 6), lane = tid & 63, wr = wid >> 2, wc = wid & 3, fr = lane & 15, fq = lane >> 4;
    const int K = g.K, nt = K / BK;
    unsigned voffA[2], voffB[2];
#pragma unroll
    for (int i = 0; i < 2; ++i) { int R, C; stage_rc(tid * 16 + i * 8192, R, C); const int Rb = Epi::PERM ? ((R & ~31) + perm32(R & 31)) : R;
        voffA[i] = (unsigned)(R * K + C) * 2u; voffB[i] = (unsigned)(Rb * K + C) * 2u; }
    const size_t kstep = (size_t)(BK * 2);
    const size_t hstep = (size_t)HALF * K * 2;
    const size_t tstep = 2 * hstep;
    const unsigned ldsw = (unsigned)wid * 1024u;
    const int aoff = lds_byte(wr * 64 + fr, fq * 8), boff = lds_byte(wc * 32 + fr, fq * 8);
#define PG8_SA(b, h) (((b) * 2 + (h)) * HTB)
#define PG8_SB(b, h) ((4 + (b) * 2 + (h)) * HTB)
#define PG8_STAGE(bufoff, gbase, voff) do { _Pragma("unroll") for (int _i = 0; _i < 2; ++_i) \
        __builtin_amdgcn_global_load_lds((const unsigned*)((const char*)(gbase) + (voff)[_i]), (PG8_LAS unsigned*)(lds + (bufoff) + ldsw + _i * 8192), 16, 0, 0); } while (0)
#define PG8_LDA(dst, b, h) do { _Pragma("unroll") for (int m = 0; m < 4; ++m) _Pragma("unroll") for (int k = 0; k < 2; ++k) dst[m][k] = *(const PG8_LAS bf16x8*)(lds + PG8_SA(b, h) + aoff + m * 2048 + k * 1024); } while (0)
#define PG8_LDB(dst, b, h) do { _Pragma("unroll") for (int n = 0; n < 2; ++n) _Pragma("unroll") for (int k = 0; k < 2; ++k) dst[n][k] = *(const PG8_LAS bf16x8*)(lds + PG8_SB(b, h) + boff + n * 2048 + k * 1024); } while (0)
#define PG8_MMA(ai, bj, At, Bt) do { __builtin_amdgcn_s_setprio(1); _Pragma("unroll") for (int m = 0; m < 4; ++m) _Pragma("unroll") for (int n = 0; n < 2; ++n) _Pragma("unroll") for (int k = 0; k < 2; ++k) \
        acc[ai][bj][m][n] = __builtin_amdgcn_mfma_f32_16x16x32_bf16(Bt[n][k], At[m][k], acc[ai][bj][m][n], 0, 0, 0); __builtin_amdgcn_s_setprio(0); } while (0)
#define PG8_WAIT_V(n) asm volatile("s_waitcnt vmcnt(" #n ")" ::: "memory")
#define PG8_WAIT_L(n) asm volatile("s_waitcnt lgkmcnt(" #n ")" ::: "memory")
#define PG8_BAR __builtin_amdgcn_s_barrier()
#define PG8_SCHED __builtin_amdgcn_sched_barrier(0)
    Unit cur, nxt; int ui = 0;
    if (!S.next(0, cur)) return;
    f32x4 acc[2][2][4][2];
#pragma unroll
    for (int a = 0; a < 2; ++a)
#pragma unroll
        for (int b = 0; b < 2; ++b)
#pragma unroll
            for (int m = 0; m < 4; ++m)
#pragma unroll
                for (int n = 0; n < 2; ++n) acc[a][b][m][n] = (f32x4){0.f, 0.f, 0.f, 0.f};
    bf16x8 At[4][2], B0[2][2], B1[2][2];
    const char* cA = (const char*)g.A + (size_t)cur.pm * tstep; const char* cB = (const char*)g.Bt + (size_t)cur.pn * tstep;
    S.a_ready(cur);
    if constexpr (SP2) {
        PG8_STAGE(PG8_SB(0, 0), cB, voffB); PG8_STAGE(PG8_SB(0, 1), cB + hstep, voffB); PG8_STAGE(PG8_SA(0, 0), cA, voffA); PG8_STAGE(PG8_SA(0, 1), cA + hstep, voffA);
        if (wr == 1) PG8_BAR;
        PG8_WAIT_V(2); PG8_BAR;
        PG8_STAGE(PG8_SB(1, 0), cB + kstep, voffB); PG8_STAGE(PG8_SA(1, 0), cA + kstep, voffA); PG8_STAGE(PG8_SB(1, 1), cB + hstep + kstep, voffB);
        PG8_WAIT_V(6); PG8_BAR;
    } else {
        PG8_STAGE(PG8_SB(0, 0), cB, voffB); PG8_STAGE(PG8_SA(0, 0), cA, voffA); PG8_STAGE(PG8_SB(0, 1), cB + hstep, voffB); PG8_STAGE(PG8_SA(0, 1), cA + hstep, voffA);
        if (wr == 1) PG8_BAR;
        PG8_WAIT_V(4); PG8_BAR;
        PG8_STAGE(PG8_SB(1, 0), cB + kstep, voffB); PG8_STAGE(PG8_SA(1, 0), cA + kstep, voffA); PG8_STAGE(PG8_SB(1, 1), cB + hstep + kstep, voffB);
        PG8_WAIT_V(6); PG8_BAR;
    }
    for (;;) {
        const bool has_next = S.next(ui + 1, nxt);
        const char* nA = has_next ? (const char*)g.A + (size_t)nxt.pm * tstep : cA; const char* nB = has_next ? (const char*)g.Bt + (size_t)nxt.pn * tstep : cB;
        for (int t = 0; t < nt; t += 2) {
            const bool last = (t == nt - 2);
            const char* a1 = cA + (size_t)(t + 1) * kstep;
            const char* a2 = last ? nA : cA + (size_t)(t + 2) * kstep; const char* b2 = last ? nB : cB + (size_t)(t + 2) * kstep;
            const char* a3 = a2 + kstep; const char* b3 = b2 + kstep;
            if (last && has_next) S.a_ready(nxt);
            if constexpr (SP2) {
            PG8_LDB(B0, 0, 0); PG8_LDB(B1, 0, 1); PG8_SCHED; PG8_LDA(At, 0, 0); PG8_STAGE(PG8_SA(1, 1), a1 + hstep, voffA);
            PG8_WAIT_V(8); PG8_WAIT_L(0); PG8_BAR; PG8_MMA(0, 0, At, B0); PG8_MMA(0, 1, At, B1); PG8_BAR; PG8_SCHED;
            PG8_LDA(At, 0, 1); PG8_STAGE(PG8_SB(0, 0), b2, voffB); PG8_STAGE(PG8_SB(0, 1), b2 + hstep, voffB); PG8_STAGE(PG8_SA(0, 0), a2, voffA);
            PG8_WAIT_V(8); PG8_WAIT_L(0); PG8_BAR; PG8_MMA(1, 0, At, B0); PG8_MMA(1, 1, At, B1); PG8_BAR; PG8_SCHED;
            PG8_LDB(B0, 1, 0); PG8_LDB(B1, 1, 1); PG8_SCHED; PG8_LDA(At, 1, 0); PG8_STAGE(PG8_SA(0, 1), a2 + hstep, voffA);
            PG8_WAIT_V(8); PG8_WAIT_L(0); PG8_BAR; PG8_MMA(0, 0, At, B0); PG8_MMA(0, 1, At, B1); PG8_BAR; PG8_SCHED;
            PG8_LDA(At, 1, 1); PG8_STAGE(PG8_SB(1, 0), b3, voffB); PG8_STAGE(PG8_SB(1, 1), b3 + hstep, voffB); PG8_STAGE(PG8_SA(1, 0), a3, voffA);
            PG8_WAIT_V(8); PG8_WAIT_L(0); PG8_BAR; PG8_MMA(1, 0, At, B0); PG8_MMA(1, 1, At, B1); PG8_BAR; PG8_SCHED;
            } else {
            PG8_LDB(B0, 0, 0); PG8_SCHED; PG8_LDA(At, 0, 0); PG8_STAGE(PG8_SA(1, 1), a1 + hstep, voffA);
            PG8_WAIT_L(8); PG8_BAR; PG8_WAIT_L(0); PG8_MMA(0, 0, At, B0); PG8_BAR; PG8_SCHED;
            PG8_LDB(B1, 0, 1); PG8_STAGE(PG8_SB(0, 0), b2, voffB);
            PG8_BAR; PG8_WAIT_L(0); PG8_MMA(0, 1, At, B1); PG8_BAR;
            PG8_LDA(At, 0, 1); PG8_STAGE(PG8_SA(0, 0), a2, voffA);
            PG8_BAR; PG8_WAIT_L(0); PG8_MMA(1, 0, At, B0); PG8_BAR; PG8_SCHED;
            PG8_STAGE(PG8_SB(0, 1), b2 + hstep, voffB);
            PG8_WAIT_V(6); PG8_BAR; PG8_MMA(1, 1, At, B1); PG8_BAR;
            PG8_LDB(B0, 1, 0); PG8_SCHED; PG8_LDA(At, 1, 0); PG8_STAGE(PG8_SA(0, 1), a2 + hstep, voffA);
            PG8_WAIT_L(8); PG8_BAR; PG8_WAIT_L(0); PG8_MMA(0, 0, At, B0); PG8_BAR; PG8_SCHED;
            PG8_LDB(B1, 1, 1); PG8_STAGE(PG8_SB(1, 0), b3, voffB);
            PG8_BAR; PG8_WAIT_L(0); PG8_MMA(0, 1, At, B1); PG8_BAR;
            PG8_LDA(At, 1, 1); PG8_STAGE(PG8_SA(1, 0), a3, voffA);
            PG8_BAR; PG8_WAIT_L(0); PG8_MMA(1, 0, At, B0); PG8_BAR; PG8_SCHED;
            PG8_STAGE(PG8_SB(1, 1), b3 + hstep, voffB);
            PG8_WAIT_V(6); PG8_BAR; PG8_MMA(1, 1, At, B1); PG8_BAR;
            }
        }
        if constexpr (ALIGN_EPI) { if (wr == 0) PG8_BAR; }
        if constexpr (!Epi::AFTER_DRAIN) { E(acc, cur, wr, wc, fr, fq); S.done(cur); }
        if (!has_next) break;
#pragma unroll
        for (int a = 0; a < 2; ++a)
#pragma unroll
            for (int b = 0; b < 2; ++b)
#pragma unroll
                for (int m = 0; m < 4; ++m)
#pragma unroll
                    for (int n = 0; n < 2; ++n) acc[a][b][m][n] = (f32x4){0.f, 0.f, 0.f, 0.f};
        cur = nxt; cA = nA; cB = nB; ++ui;
        if constexpr (ALIGN_EPI) { if (wr == 1) PG8_BAR; }
    }
    PG8_WAIT_V(0);
    if constexpr (!ALIGN_EPI) { if (wr == 0) PG8_BAR; }
    PG8_BAR;
    if constexpr (Epi::AFTER_DRAIN) { E.fused(acc, cur, wr, wc, fr, fq, lds, wid, lane); S.done(cur); }
#undef PG8_SA
#undef PG8_SB
#undef PG8_STAGE
#undef PG8_LDA
#undef PG8_LDB
#undef PG8_MMA
#undef PG8_WAIT_V
#undef PG8_WAIT_L
#undef PG8_BAR
#undef PG8_SCHED
}
}
#define GAS __attribute__((address_space(1)))
#define LAS __attribute__((address_space(3)))
typedef unsigned short bf16;
typedef unsigned v4u __attribute__((ext_vector_type(4)));
typedef float f32x4 __attribute__((ext_vector_type(4)));
typedef short bf16x8 __attribute__((ext_vector_type(8)));
typedef GAS unsigned gu32;
typedef GAS unsigned long long gu64;
#define RLX_AGENT __ATOMIC_RELAXED, __HIP_MEMORY_SCOPE_AGENT
#define LDS_WAIT() asm volatile("s_waitcnt lgkmcnt(0)" ::: "memory")
#define VM_WAIT() asm volatile("s_waitcnt vmcnt(0)" ::: "memory")
__device__ __forceinline__ unsigned long long rt() { return __builtin_amdgcn_s_memrealtime(); }
__device__ __forceinline__ unsigned f2bf(float f) { unsigned u = __builtin_bit_cast(unsigned, f); return (u + 0x7fffu + ((u >> 16) & 1u)) >> 16; }
__device__ __forceinline__ unsigned pk2(float lo, float hi) { return f2bf(lo) | (f2bf(hi) << 16); }

#define XB_TMO      128
#define XB_XCNT(j)  (256  + 64 * (j))
#define XB_XSUB(j)  (1280 + 64 * (j))
#define XB_XGEN(j)  (2304 + 64 * (j))
#define XB_TOP      3328
#define XB_TOPGEN   3392
#define XCD_BAR_WORDS 3456
#define XB_SPIN_CAP (1u << 18)

__device__ __forceinline__ unsigned xb_ld(unsigned* p)              { return __hip_atomic_load(p, __ATOMIC_RELAXED, __HIP_MEMORY_SCOPE_AGENT); }
__device__ __forceinline__ unsigned xb_add(unsigned* p, unsigned v) { return __hip_atomic_fetch_add(p, v, __ATOMIC_RELAXED, __HIP_MEMORY_SCOPE_AGENT); }
__device__ __forceinline__ unsigned xb_xcc_id() { return (unsigned)__builtin_amdgcn_s_getreg((3 << 11) | 20) & 0xFu; }
#define XB_SPIN(cond, bar) do { unsigned _sp = 0; while (cond) { __builtin_amdgcn_s_sleep(1); \
    if ((++_sp & 255u) == 0u) { if (xb_ld(&(bar)[XB_TMO])) break; if (_sp > XB_SPIN_CAP) { atomicAdd(&(bar)[XB_TMO], 1u); break; } } } } while (0)

struct XcdBarrier {
    unsigned* bar; unsigned x;
    volatile LAS unsigned* st;
};

__device__ __forceinline__ XcdBarrier xcd_barrier_post(unsigned* bar, volatile LAS unsigned* st) {
    XcdBarrier b; b.bar = bar; b.x = xb_xcc_id(); b.st = st;
    if (threadIdx.x == 0) (void)xb_add(&bar[XB_XCNT(b.x)], 1u);
    return b;
}
__device__ __forceinline__ void xcd_barrier_complete(unsigned* bar, unsigned x, unsigned& nloc, unsigned& nx) {
    const unsigned G = gridDim.x * gridDim.y * gridDim.z;
    unsigned sum, cnt, mine, sp = 0u;
    for (;;) {
        sum = 0u; cnt = 0u; mine = 0u;
#pragma unroll
        for (unsigned j = 0; j < 16; ++j) { const unsigned c = xb_ld(&bar[XB_XCNT(j)]); sum += c; cnt += (c > 0u) ? 1u : 0u; mine = (j == x) ? c : mine; }
        if (sum == G) break;
        __builtin_amdgcn_s_sleep(1);
        if ((++sp & 255u) == 0u) { if (xb_ld(&bar[XB_TMO])) break; if (sp > XB_SPIN_CAP) { atomicAdd(&bar[XB_TMO], 1u); break; } }
    }
    nloc = mine > 0u ? mine : 1u; nx = cnt > 0u ? cnt : 1u;
}

__device__ __forceinline__ void xcd_barrier(const XcdBarrier& b) {
    asm volatile("s_waitcnt vmcnt(0)" ::: "memory");
    __syncthreads();
    if (threadIdx.x == 0) {
        unsigned* bar = b.bar;
        __builtin_amdgcn_s_waitcnt(0);
        unsigned nloc = b.st[0], nx = b.st[1];
        if (nloc == 0u) { xcd_barrier_complete(bar, b.x, nloc, nx); b.st[0] = nloc; b.st[1] = nx; }
        const unsigned old = xb_add(&bar[XB_XSUB(b.x)], 1u);
        const unsigned gen = old / nloc;
        if (old + 1u == (gen + 1u) * nloc) {
            __builtin_amdgcn_fence(__ATOMIC_RELEASE, "agent");
            asm volatile("s_waitcnt vmcnt(0)" ::: "memory");
            const unsigned og = xb_add(&bar[XB_TOP], 1u);
            const unsigned tg = og / nx;
            if (og + 1u == (tg + 1u) * nx) xb_add(&bar[XB_TOPGEN], 1u);
            else XB_SPIN(xb_ld(&bar[XB_TOPGEN]) == tg, bar);
            __builtin_amdgcn_fence(__ATOMIC_ACQUIRE, "agent");
            xb_add(&bar[XB_XGEN(b.x)], 1u);
            asm volatile("s_waitcnt vmcnt(0)" ::: "memory");
        } else {
            XB_SPIN(xb_ld(&bar[XB_XGEN(b.x)]) == gen, bar);
            __builtin_amdgcn_fence(__ATOMIC_ACQUIRE, "agent");
            asm volatile("s_waitcnt vmcnt(0)" ::: "memory");
        }
    }
    __syncthreads();
}


#ifndef MK_LAUNCH_PER_PHASE
#define MK_LAUNCH_PER_PHASE 0
#endif
constexpr int NWAVES = 8;
#ifndef PHASE_MASK
#define PHASE_MASK 0xFFFFFFFFu
#endif
#define PON(i) ((PHASE_MASK >> (i)) & 1u)
#ifndef PROBE_REP_MASK
#define PROBE_REP_MASK 0u
#endif
#ifndef PROBE_OUT_SEL
#define PROBE_OUT_SEL 0
#endif

constexpr int NB = 4, SEQ = 2048, D = 2048, M = NB * SEQ, FF = 5632;
constexpr int IN0 = 14368, IN0P = 14592, IN1 = 3408, IN1P = 3584;
constexpr int MODW = 9 * D;
constexpr float EPS = 1e-6f;
constexpr int NPH = 27;

constexpr size_t MiB = 1u << 20;
constexpr size_t WS_CTL = 0, CTL_ZERO_BYTES = 1 * MiB;
constexpr size_t WS_MODS = 1 * MiB;
constexpr size_t WS_RTC = 2 * MiB, WS_RTS = 6 * MiB;
constexpr size_t WS_RTQ = 10 * MiB;
constexpr size_t WS_RTI = 11 * MiB;
constexpr size_t WS_SSQ = 12 * MiB;
constexpr size_t WS_DTB = 13 * MiB;
constexpr size_t WS_WGU = 24 * MiB;
constexpr size_t WS_WD = 200 * MiB;
constexpr size_t WS_WIN0 = 288 * MiB;
constexpr size_t WS_WOUT0 = 345 * MiB;
constexpr size_t WS_WIN1 = 361 * MiB;
constexpr size_t WS_WOUT1 = 375 * MiB;
constexpr size_t WS_H = 384 * MiB;
constexpr size_t WS_Y = 416 * MiB;
constexpr size_t WS_MIX = 480 * MiB;
constexpr size_t WS_BIG = 544 * MiB;
constexpr size_t WS_CD = 21 * MiB;
constexpr size_t WS_XC = 772 * MiB;
constexpr size_t WS_QR = 836 * MiB, WS_KR = 868 * MiB;
constexpr size_t WS_RST = 900 * MiB;
constexpr size_t WS_RPT = 1028 * MiB;
constexpr size_t WS_SST = WS_Y;
constexpr size_t WS_HP = WS_H;
constexpr size_t WS_IDX = 772 * MiB;
constexpr size_t WS_QA = 812 * MiB;
constexpr size_t WS_KAB = 844 * MiB, WS_VAB = 846 * MiB;
constexpr size_t WS_QIH = 848 * MiB, WS_QIL = 864 * MiB;
constexpr size_t WS_KIH = 880 * MiB, WS_KIL = 881 * MiB;
constexpr size_t WS_WI = 882 * MiB;
constexpr size_t WS_SEL = 884 * MiB;
constexpr size_t WS_NSEL = 892 * MiB;
constexpr size_t WS_END = 1092 * MiB;
constexpr size_t WGU_ELEMS = (size_t)2 * FF * D, WD_ELEMS = (size_t)D * FF;
constexpr int CW_BAR = 4096;

constexpr int RING_BYTES = 131072;
constexpr int LDSCTL_OFF = 146432, MISC_OFF = LDSCTL_OFF + 320;
constexpr int LDS_BYTES = 147456;

__device__ __forceinline__ float bf2f(unsigned short b) { return __uint_as_float(((unsigned)b) << 16); }
__device__ __forceinline__ float bflo(unsigned w) { return __uint_as_float(w << 16); }
__device__ __forceinline__ float bfhi(unsigned w) { return __uint_as_float(w & 0xffff0000u); }
__device__ __forceinline__ float silu(float v) { return v / (1.0f + __expf(-v)); }
__device__ __forceinline__ float wave_sum(float v) {
#pragma unroll
    for (int o = 1; o < 64; o <<= 1) v += __shfl_xor(v, o);
    return v;
}

struct Frame {
    LAS unsigned char* lds;
    int vcu, G;
    const float *x, *c, *mod_w, *mod_b, *norm_w, *w_gate, *w_up, *w_down, *hy_w_in, *conv_w, *conv_b, *A_log, *dt_bias, *ssd_D, *ssd_norm_w, *ret_norm_w, *hy_w_out, *dsa_w_in, *idx_k_norm_w, *dsa_w_out;
    const int* positions;
    float* out;
    unsigned char* ws;
};
#define WSP(T, off) ((T*)(F.ws + (off)))

__device__ __forceinline__ void tr_item(const float* W, int ldn, int K, int k0, int sc, int ncl, bf16* WT, int dr, LAS float* scr, int lane) {
    int cc = sc + (lane & 31); cc = cc < ncl ? cc : ncl - 1;
#pragma unroll 8
    for (int i = 0; i < 32; ++i) { const int kk = 2 * i + (lane >> 5); scr[kk * 33 + (lane & 31)] = W[(size_t)(k0 + kk) * ldn + cc]; }
    LDS_WAIT(); asm volatile("" ::: "memory");
    const int c = lane & 7;
#pragma unroll
    for (int j = 0; j < 4; ++j) { const int n = (lane >> 3) + 8 * j; const LAS float* s = scr + (8 * c) * 33 + n;
        v4u o; o.x = pk2(s[0 * 33], s[1 * 33]); o.y = pk2(s[2 * 33], s[3 * 33]); o.z = pk2(s[4 * 33], s[5 * 33]); o.w = pk2(s[6 * 33], s[7 * 33]);
        *(GAS v4u*)(WT + (size_t)(dr + n) * K + k0 + 8 * c) = o; }
    LDS_WAIT(); asm volatile("" ::: "memory");
}
__device__ __forceinline__ int in0_dst_col(int sc) {
    if (sc < 6144) return sc;
    if (sc < 6176) return 14336 + (sc - 6144);
    return sc - 32;
}
__device__ __forceinline__ void p0_prologue(Frame& F) {
    int tid_ = threadIdx.x; asm volatile("" : "+v"(tid_)); const int TID = tid_, LANE = TID & 63, WAVE = __builtin_amdgcn_readfirstlane(TID >> 6); (void)LANE; (void)WAVE;

    {
        LAS float* cond = (LAS float*)F.lds;
        LAS float* red = (LAS float*)(F.lds + 32768);
        for (int i = TID; i < NB * D; i += NWAVES * 64) cond[i] = silu(F.c[i]);
        __syncthreads();
        float* MODS = WSP(float, WS_MODS);
        for (int u = F.vcu; u < 256; u += F.G) {
            const int col0 = 144 * u, layer = col0 / MODW, j0 = col0 % MODW;
            const int cq = TID % 36, ks = TID / 36;
            if (ks < 14) {
                f32x4 a0 = {0.f, 0.f, 0.f, 0.f}, a1 = a0, a2 = a0, a3 = a0;
                const int kb = ks * 147, ke = (kb + 147 < D) ? kb + 147 : D;
                const float* wp = F.mod_w + (size_t)layer * D * MODW + j0 + 4 * cq;
#pragma unroll 4
                for (int k = kb; k < ke; ++k) { const f32x4 w = *(const f32x4*)(wp + (size_t)k * MODW);
                    a0 += cond[k] * w; a1 += cond[D + k] * w; a2 += cond[2 * D + k] * w; a3 += cond[3 * D + k] * w; }
                LAS float* r = red + (ks * 36 + cq) * 16;
                *(LAS f32x4*)(r) = a0; *(LAS f32x4*)(r + 4) = a1; *(LAS f32x4*)(r + 8) = a2; *(LAS f32x4*)(r + 12) = a3;
            }
            __syncthreads();
            for (int o = TID; o < 576; o += NWAVES * 64) { const int cq2 = o / 16, r = o % 16, b = r / 4, e = r % 4; float s = 0.f;
#pragma unroll
                for (int k2 = 0; k2 < 14; ++k2) s += red[(k2 * 36 + cq2) * 16 + r];
                const int j = j0 + 4 * cq2 + e;
                MODS[(size_t)(layer * 4 + b) * MODW + j] = s + F.mod_b[layer * MODW + j]; }
            __syncthreads();
        }
    }
    {
        const int gt = F.vcu * NWAVES * 64 + TID, NT = F.G * NWAVES * 64;
        const double INV2PI = 0.15915494309189535;
        float* rc = WSP(float, WS_RTC); float* rs = WSP(float, WS_RTS);
        for (int idx = gt; idx < M * 128; idx += NT) { const int row = idx >> 7, i = idx & 127;
            const double inv = exp2(-(double)i * (13.287712379549449 / 128.0));
            const double rev = (double)F.positions[row] * inv * INV2PI; const float fr = (float)(rev - rint(rev));
            rc[idx] = __builtin_amdgcn_cosf(fr); rs[idx] = __builtin_amdgcn_sinf(fr); }
        float* qc = WSP(float, WS_RTQ); float* qs = qc + M * 16;
        for (int idx = gt; idx < M * 16; idx += NT) { const int row = idx >> 4, i = idx & 15;
            const double inv = exp2(-(double)i * (18.931568569324174 / 16.0));
            const double rev = (double)F.positions[row] * inv * INV2PI; const float fr = (float)(rev - rint(rev));
            qc[idx] = __builtin_amdgcn_cosf(fr); qs[idx] = __builtin_amdgcn_sinf(fr); }
        float* ic = WSP(float, WS_RTI); float* is = ic + M * 8;
        for (int idx = gt; idx < M * 8; idx += NT) { const int row = idx >> 3, i = idx & 7;
            const double inv = exp2(-(double)i * (18.931568569324174 / 8.0));
            const double rev = (double)F.positions[row] * inv * INV2PI; const float fr = (float)(rev - rint(rev));
            ic[idx] = __builtin_amdgcn_cosf(fr); is[idx] = __builtin_amdgcn_sinf(fr); }
    }
    {
        LAS float* scr = (LAS float*)(F.lds + WAVE * 8448);
        const int gw = F.vcu * NWAVES + WAVE, NGW = F.G * NWAVES;
        constexpr int I_G = 32 * 176, I_D = 88 * 64, I_FFN = 2 * I_G + I_D;
        constexpr int I_IN0 = 32 * 449, I_OUT0 = 64 * 64, I_IN1 = 32 * 107, I_OUT1 = 32 * 64;
        constexpr int NITEMS = 4 * I_FFN + I_IN0 + I_OUT0 + I_IN1 + I_OUT1;
        bf16* Wgu = WSP(bf16, WS_WGU); bf16* Wd = WSP(bf16, WS_WD);
        for (int it = gw; it < NITEMS; it += NGW) {
            int r = it;
            if (r < 4 * I_FFN) { const int s = r / I_FFN; r -= s * I_FFN;
                if (r < 2 * I_G) { const int up = r / I_G; r -= up * I_G; const int kb = r / 176, nb = r % 176, sc = 32 * nb;
                    const float* W = (up ? F.w_up : F.w_gate) + (size_t)s * D * FF;
                    tr_item(W, FF, D, 64 * kb, sc, FF, Wgu + (size_t)s * WGU_ELEMS, 256 * (sc / 128) + 128 * up + (sc % 128), scr, LANE); }
                else { r -= 2 * I_G; const int kb = r / 64, nb = r % 64;
                    tr_item(F.w_down + (size_t)s * FF * D, D, FF, 64 * kb, 32 * nb, D, Wd + (size_t)s * WD_ELEMS, 32 * nb, scr, LANE); }
                continue; }
            r -= 4 * I_FFN;
            if (r < I_IN0) { const int kb = r / 449, nb = r % 449, sc = 32 * nb; tr_item(F.hy_w_in, IN0, D, 64 * kb, sc, IN0, WSP(bf16, WS_WIN0), in0_dst_col(sc), scr, LANE); continue; }
            r -= I_IN0;
            if (r < I_OUT0) { const int kb = r / 64, nb = r % 64; tr_item(F.hy_w_out, D, 2 * D, 64 * kb, 32 * nb, D, WSP(bf16, WS_WOUT0), 32 * nb, scr, LANE); continue; }
            r -= I_OUT0;
            if (r < I_IN1) { const int kb = r / 107, nb = r % 107; tr_item(F.dsa_w_in, IN1, D, 64 * kb, 32 * nb, IN1, WSP(bf16, WS_WIN1), 32 * nb, scr, LANE); continue; }
            r -= I_IN1;
            { const int kb = r / 64, nb = r % 64; tr_item(F.dsa_w_out, D, D, 64 * kb, 32 * nb, D, WSP(bf16, WS_WOUT1), 32 * nb, scr, LANE); }
        }
    }
}

__device__ __forceinline__ void thin_phase(Frame& F, int prevq, int nextq) {
    int tid_ = threadIdx.x; asm volatile("" : "+v"(tid_)); const int TID = tid_, LANE = TID & 63, WAVE = __builtin_amdgcn_readfirstlane(TID >> 6); (void)LANE; (void)WAVE;

    const int gw = F.vcu * NWAVES + WAVE, NGW = F.G * NWAVES;
    const float* xin = (prevq <= 0) ? F.x : F.out;
    const float* Y = WSP(float, WS_Y); const float* SSQ = WSP(float, WS_SSQ); const float* MODS = WSP(float, WS_MODS); bf16* H = WSP(bf16, WS_H);
    for (int row = gw; row < M; row += NGW) {
        const int b = row >> 11;
        f32x4 xv[8];
        const f32x4* xr = (const f32x4*)(xin + (size_t)row * D) + LANE;
#pragma unroll
        for (int j = 0; j < 8; ++j) xv[j] = xr[64 * j];
        if (prevq >= 0) {
            const int pl = prevq / 3, pj = prevq % 3; const float rw = (pj == 1) ? 1.0f : 0.5f;
            float s = (LANE < 32) ? SSQ[(size_t)row * 32 + LANE] : 0.f; s = wave_sum(s);
            const float sc = rw * rsqrtf(s * (1.0f / D) + EPS);
            const f32x4* yr = (const f32x4*)(Y + (size_t)row * D) + LANE;
            const f32x4* pw = (const f32x4*)(F.norm_w + (size_t)(pl * 6 + 2 * pj + 1) * D) + LANE;
            const f32x4* gt = (const f32x4*)(MODS + (size_t)(pl * 4 + b) * MODW + (3 * pj + 2) * D) + LANE;
            f32x4* xo = (f32x4*)(F.out + (size_t)row * D) + LANE;
#pragma unroll
            for (int j = 0; j < 8; ++j) { xv[j] = xv[j] + sc * (gt[64 * j] * yr[64 * j] * pw[64 * j]); xo[64 * j] = xv[j]; }
        }
        if (nextq >= 0) {
            const int nl = nextq / 3, nj = nextq % 3;
            float s = 0.f;
#pragma unroll
            for (int j = 0; j < 8; ++j) s += (xv[j].x * xv[j].x + xv[j].y * xv[j].y) + (xv[j].z * xv[j].z + xv[j].w * xv[j].w);
            const float rstd = rsqrtf(wave_sum(s) * (1.0f / D) + EPS);
            const f32x4* pw = (const f32x4*)(F.norm_w + (size_t)(nl * 6 + 2 * nj) * D) + LANE;
            const f32x4* sh = (const f32x4*)(MODS + (size_t)(nl * 4 + b) * MODW + (3 * nj) * D) + LANE;
            const f32x4* scp = (const f32x4*)(MODS + (size_t)(nl * 4 + b) * MODW + (3 * nj + 1) * D) + LANE;
            unsigned long long* o8 = (unsigned long long*)(H + (size_t)row * D) + LANE;
#pragma unroll
            for (int j = 0; j < 8; ++j) { const f32x4 h = (xv[j] * rstd) * pw[64 * j] * (scp[64 * j] + 1.0f) + sh[64 * j];
                o8[64 * j] = (unsigned long long)pk2(h.x, h.y) | ((unsigned long long)pk2(h.z, h.w) << 32); }
        }
    }
}

typedef float f32x16 __attribute__((ext_vector_type(16)));
typedef float f32x2v __attribute__((ext_vector_type(2)));
typedef __bf16 bf16x2v __attribute__((ext_vector_type(2)));
__device__ __forceinline__ unsigned pkbf(float lo, float hi) { return __builtin_bit_cast(unsigned, __builtin_convertvector((f32x2v){lo, hi}, bf16x2v)); }
#define MFMA32(a, b, c) __builtin_amdgcn_mfma_f32_32x32x16_bf16((a), (b), (c), 0, 0, 0)
template <int S> __device__ __forceinline__ bf16x8 pack8(const f32x16& x) {
    v4u p; p.x = pkbf(x[8 * S + 0], x[8 * S + 1]); p.y = pkbf(x[8 * S + 2], x[8 * S + 3]); p.z = pkbf(x[8 * S + 4], x[8 * S + 5]); p.w = pkbf(x[8 * S + 6], x[8 * S + 7]);
    return __builtin_bit_cast(bf16x8, p);
}
__device__ __forceinline__ f32x16 zero16() { f32x16 z;
#pragma unroll
    for (int i = 0; i < 16; ++i) z[i] = 0.f;
    return z; }
struct IdFrag { bf16x8 f0, f1; };
__device__ __forceinline__ IdFrag make_id(int r, int hh) { IdFrag I;
#pragma unroll
    for (int j = 0; j < 8; ++j) { I.f0[j] = (r == 8 * hh + j) ? (short)0x3F80 : (short)0; I.f1[j] = (r == 16 + 8 * hh + j) ? (short)0x3F80 : (short)0; }
    return I; }
__device__ __forceinline__ bf16x8 lfrag(const LAS unsigned char* img, int stride, int row, int col) { return *(const LAS bf16x8*)(img + row * stride + col * 2); }
__device__ __forceinline__ f32x16 to_acc_lds(const LAS unsigned char* img, int stride, int row0, int col0, int r, int hh, const IdFrag& I) {
    f32x16 x = MFMA32(lfrag(img, stride, row0 + r, col0 + 8 * hh), I.f0, zero16());
    return MFMA32(lfrag(img, stride, row0 + r, col0 + 16 + 8 * hh), I.f1, x);
}
__device__ __forceinline__ f32x16 to_acc_glb(const bf16* base, size_t ld, int r, int hh, const IdFrag& I) {
    f32x16 x = MFMA32(*(const bf16x8*)(base + (size_t)r * ld + 8 * hh), I.f0, zero16());
    return MFMA32(*(const bf16x8*)(base + (size_t)r * ld + 16 + 8 * hh), I.f1, x);
}
__device__ __forceinline__ int crow(int i, int hh) { return (i & 3) + 8 * (i >> 2) + 4 * hh; }

constexpr int XS_STRIDE = 528, BC_STRIDE = 272;
constexpr int L0_XS = 0, L0_BM = 128 * XS_STRIDE, L0_CM = L0_BM + 128 * BC_STRIDE, L0_TAB = L0_CM + 128 * BC_STRIDE;
constexpr int L0_K = 0, L0_V = 128 * XS_STRIDE, L0_Q = 128 * XS_STRIDE, L0_RS = 2 * 128 * XS_STRIDE;
static_assert(L0_TAB + 3 * 2048 <= LDSCTL_OFF && L0_RS + 4096 + 512 <= LDSCTL_OFF, "LDS map (layer-0 mixer)");

__device__ __forceinline__ void stage_conv(Frame& F, int TID, size_t R0, int g, bool withC) {
    const int ci = TID & 63, rg = TID >> 6;
    if (!withC && ci >= 48) return;
    const int xc = ci < 32 ? g * 256 + 8 * ci : (ci < 48 ? 2048 + g * 128 + 8 * (ci - 32) : 3072 + g * 128 + 8 * (ci - 48));
    LAS unsigned char* dst = F.lds + (ci < 32 ? L0_XS + ci * 16 : (ci < 48 ? L0_BM + (ci - 32) * 16 : L0_CM + (ci - 48) * 16));
    const int dstride = ci < 32 ? XS_STRIDE : BC_STRIDE;
    float w[4][8], a0[8];
#pragma unroll
    for (int j = 0; j < 4; ++j) { const f32x4 p = *(const f32x4*)(F.conv_w + (size_t)j * 4096 + xc), q = *(const f32x4*)(F.conv_w + (size_t)j * 4096 + xc + 4);
        w[j][0] = p.x; w[j][1] = p.y; w[j][2] = p.z; w[j][3] = p.w; w[j][4] = q.x; w[j][5] = q.y; w[j][6] = q.z; w[j][7] = q.w; }
    { const f32x4 p = *(const f32x4*)(F.conv_b + xc), q = *(const f32x4*)(F.conv_b + xc + 4); a0[0] = p.x; a0[1] = p.y; a0[2] = p.z; a0[3] = p.w; a0[4] = q.x; a0[5] = q.y; a0[6] = q.z; a0[7] = q.w; }
    const bf16* src = WSP(bf16, WS_BIG) + (R0 + rg * 16) * IN0P + 2048 + xc;
    const int t0 = (int)(R0 & (SEQ - 1)) + rg * 16;
    float h[3][8];
#pragma unroll
    for (int k = 0; k < 3; ++k) { v4u u = {0u, 0u, 0u, 0u}; if (t0 - 3 + k >= 0) u = *(const v4u*)(src + (ptrdiff_t)(k - 3) * IN0P);
        h[k][0] = bflo(u.x); h[k][1] = bfhi(u.x); h[k][2] = bflo(u.y); h[k][3] = bfhi(u.y); h[k][4] = bflo(u.z); h[k][5] = bfhi(u.z); h[k][6] = bflo(u.w); h[k][7] = bfhi(u.w); }
#pragma unroll 4
    for (int i = 0; i < 16; ++i) { const v4u u = *(const v4u*)(src + (size_t)i * IN0P);
        const float c[8] = {bflo(u.x), bfhi(u.x), bflo(u.y), bfhi(u.y), bflo(u.z), bfhi(u.z), bflo(u.w), bfhi(u.w)};
        float o[8];
#pragma unroll
        for (int e = 0; e < 8; ++e) { o[e] = silu(a0[e] + w[0][e] * h[0][e] + w[1][e] * h[1][e] + w[2][e] * h[2][e] + w[3][e] * c[e]); h[0][e] = h[1][e]; h[1][e] = h[2][e]; h[2][e] = c[e]; }
        v4u p; p.x = pkbf(o[0], o[1]); p.y = pkbf(o[2], o[3]); p.z = pkbf(o[4], o[5]); p.w = pkbf(o[6], o[7]);
        *(LAS v4u*)(dst + (rg * 16 + i) * dstride) = p; }
}
__device__ __forceinline__ void ssd_tables(Frame& F, int TID, int LANE, int WAVE, LAS float* tab, size_t R0, int g, float* cd) {
    LAS float* cuml = tab; LAS float* dtl = tab + 512; LAS float* wl = tab + 1024;
    { const int row = TID >> 2, hd = TID & 3, h2 = g * 4 + hd; const float v = WSP(float, WS_DTB)[(R0 + row) * 256 + h2] + F.dt_bias[h2];
      const float dt = v > 20.f ? v : log1pf(__expf(v)); dtl[hd * 128 + row] = dt; wl[hd * 128 + row] = -dt * __expf(F.A_log[h2]); }
    __syncthreads();
    if (WAVE < 4) { const float a0 = wl[WAVE * 128 + 2 * LANE], a1 = wl[WAVE * 128 + 2 * LANE + 1]; float p = a0 + a1;
#pragma unroll
        for (int o = 1; o < 64; o <<= 1) { const float t = __shfl_up(p, o); if (LANE >= o) p += t; }
        const float tot = __shfl(p, 63), c0 = p - a1;
        cuml[WAVE * 128 + 2 * LANE] = c0; cuml[WAVE * 128 + 2 * LANE + 1] = p;
        wl[WAVE * 128 + 2 * LANE] = dtl[WAVE * 128 + 2 * LANE] * __expf(tot - c0); wl[WAVE * 128 + 2 * LANE + 1] = dtl[WAVE * 128 + 2 * LANE + 1] * __expf(tot - p);
        if (cd != nullptr && LANE == 0) cd[WAVE] = __expf(tot); }
    __syncthreads();
}
__device__ __forceinline__ void m0_states(Frame& F) {
    int tid_ = threadIdx.x; asm volatile("" : "+v"(tid_)); const int TID = tid_, LANE = TID & 63, WAVE = __builtin_amdgcn_readfirstlane(TID >> 6);
    const int r_ = LANE & 31, hh_ = LANE >> 5; const IdFrag I = make_id(r_, hh_);
    for (int u = F.vcu; u < 1024; u += F.G) {
        __syncthreads();
        int r = r_, hh = hh_; asm volatile("" : "+v"(r), "+v"(hh));
        if (u < 512) {
            const int bc = u >> 3, g = u & 7; const size_t R0 = (size_t)bc * 128;
            stage_conv(F, TID, R0, g, false);
            LAS float* tab = (LAS float*)(F.lds + L0_TAB);
            ssd_tables(F, TID, LANE, WAVE, tab, R0, g, WSP(float, WS_CD) + bc * 32 + g * 4);
            const LAS float* wl = tab + 1024;
            const int head = WAVE >> 1, pt = WAVE & 1;
            f32x16 acc[4];
#pragma unroll
            for (int t = 0; t < 4; ++t) acc[t] = zero16();
#pragma unroll 1
            for (int sb = 0; sb < 4; ++sb) {
                f32x16 X = to_acc_lds(F.lds + L0_XS, XS_STRIDE, sb * 32, head * 64 + pt * 32, r, hh, I);
#pragma unroll
                for (int g4 = 0; g4 < 4; ++g4) { const f32x4 wv = *(const LAS f32x4*)(wl + head * 128 + sb * 32 + 8 * g4 + 4 * hh);
#pragma unroll
                    for (int e = 0; e < 4; ++e) X[4 * g4 + e] *= wv[e]; }
                const bf16x8 A0 = pack8<0>(X), A1 = pack8<1>(X);
#pragma unroll
                for (int nt = 0; nt < 4; ++nt) { const f32x16 XB = to_acc_lds(F.lds + L0_BM, BC_STRIDE, sb * 32, nt * 32, r, hh, I);
                    acc[nt] = MFMA32(A0, pack8<0>(XB), acc[nt]); acc[nt] = MFMA32(A1, pack8<1>(XB), acc[nt]); }
            }
            float* dst = WSP(float, WS_SST) + ((size_t)(bc * 32 + g * 4 + head) * 64 + pt * 32) * 128;
#pragma unroll
            for (int nt = 0; nt < 4; ++nt)
#pragma unroll
                for (int i = 0; i < 16; ++i) dst[(size_t)crow(i, hh) * 128 + nt * 32 + r] = acc[nt][i];
        } else {
            const int u2 = u - 512, bc = u2 >> 3, h = u2 & 7; const size_t R0 = (size_t)bc * 128;
            const bf16* PB = WSP(bf16, WS_BIG);
            for (int i = TID; i < 4096; i += NWAVES * 64) { const int row = i >> 5, ch = i & 31;
                *(LAS v4u*)(F.lds + L0_K + row * XS_STRIDE + ch * 16) = *(const v4u*)(PB + (R0 + row) * IN0P + 8192 + h * 256 + ch * 8);
                *(LAS v4u*)(F.lds + L0_V + row * XS_STRIDE + ch * 16) = *(const v4u*)(PB + (R0 + row) * IN0P + 10240 + h * 256 + ch * 8); }
            __syncthreads();
            const float lg = log2f(1.0f - exp2f(-5.0f - (float)h));
            float* dstb = WSP(float, WS_RST) + ((size_t)(bc * 8 + h) * 256 + WAVE * 32) * 256;
#pragma unroll 1
            for (int half = 0; half < 2; ++half) {
                f32x16 acc[4];
#pragma unroll
                for (int t = 0; t < 4; ++t) acc[t] = zero16();
#pragma unroll 1
                for (int sb = 0; sb < 4; ++sb) {
                    const f32x16 XV = to_acc_lds(F.lds + L0_V, XS_STRIDE, sb * 32, WAVE * 32, r, hh, I);
                    const bf16x8 A0 = pack8<0>(XV), A1 = pack8<1>(XV);
#pragma unroll
                    for (int t = 0; t < 4; ++t) { f32x16 XK = to_acc_lds(F.lds + L0_K, XS_STRIDE, sb * 32, (half * 4 + t) * 32, r, hh, I);
#pragma unroll
                        for (int i = 0; i < 16; ++i) XK[i] *= exp2f((float)(127 - (sb * 32 + crow(i, hh))) * lg);
                        acc[t] = MFMA32(A0, pack8<0>(XK), acc[t]); acc[t] = MFMA32(A1, pack8<1>(XK), acc[t]); }
                }
#pragma unroll
                for (int t = 0; t < 4; ++t)
#pragma unroll
                    for (int i = 0; i < 16; ++i) dstb[(size_t)crow(i, hh) * 256 + (half * 4 + t) * 32 + r] = acc[t][i];
            }
        }
    }
}
__device__ __forceinline__ void m0_chunkscan(Frame& F) {
    int tid_ = threadIdx.x; asm volatile("" : "+v"(tid_)); const int TID = tid_;
    const int gt = F.vcu * NWAVES * 64 + TID, NT = F.G * NWAVES * 64;
    const float* SST = WSP(float, WS_SST); const float* CD = WSP(float, WS_CD); bf16* HP = WSP(bf16, WS_HP);
    for (int idx = gt; idx < NB * 32 * 64 * 32; idx += NT) {
        const int b = idx >> 16, rem = idx & 65535, h = rem >> 11;
        f32x4 st = {0.f, 0.f, 0.f, 0.f};
        for (int c = 0; c < 16; ++c) { const size_t off = ((size_t)((b * 16 + c) * 32) * 2048 + rem) * 4;
            *(unsigned long long*)(HP + off) = (unsigned long long)pkbf(st.x, st.y) | ((unsigned long long)pkbf(st.z, st.w) << 32);
            const float a = CD[(b * 16 + c) * 32 + h]; st = st * a + *(const f32x4*)(SST + off); }
    }
    const float* RST = WSP(float, WS_RST); bf16* RPT = WSP(bf16, WS_RPT);
    for (int idx = gt; idx < NB * 8 * 256 * 64; idx += NT) {
        const int b = idx >> 17, rem = idx & 131071, h = rem >> 14;
        const float gc = exp2f(128.0f * log2f(1.0f - exp2f(-5.0f - (float)h)));
        f32x4 st = {0.f, 0.f, 0.f, 0.f};
        for (int c = 0; c < 16; ++c) { const size_t off = ((size_t)((b * 16 + c) * 8) * 16384 + rem) * 4;
            *(unsigned long long*)(RPT + off) = (unsigned long long)pkbf(st.x, st.y) | ((unsigned long long)pkbf(st.z, st.w) << 32);
            st = st * gc + *(const f32x4*)(RST + off); }
    }
}
__device__ __forceinline__ void m0_out_ssd(Frame& F) {
    int tid_ = threadIdx.x; asm volatile("" : "+v"(tid_)); const int TID = tid_, LANE = TID & 63, WAVE = __builtin_amdgcn_readfirstlane(TID >> 6);
    const int r_ = LANE & 31, hh_ = LANE >> 5; const IdFrag I = make_id(r_, hh_);
    const bf16* PB = WSP(bf16, WS_BIG); bf16* MIX = WSP(bf16, WS_MIX);
    for (int u = F.vcu; u < 512; u += F.G) {
        __syncthreads();
        int r = r_, hh = hh_; asm volatile("" : "+v"(r), "+v"(hh));
        {
            const int bc = u >> 3, g = u & 7; const size_t R0 = (size_t)bc * 128;
            stage_conv(F, TID, R0, g, true);
            LAS float* tab = (LAS float*)(F.lds + L0_TAB);
            ssd_tables(F, TID, LANE, WAVE, tab, R0, g, nullptr);
            const int head = WAVE >> 1, pt = WAVE & 1, hd = g * 4 + head;
            const LAS float* cuml = tab + head * 128; const LAS float* dtl = tab + 512 + head * 128;
            const float Dh = F.ssd_D[hd];
            bf16x8 hpf[8];
            { const bf16* hp = WSP(bf16, WS_HP) + ((size_t)(bc * 32 + hd) * 64 + pt * 32 + r) * 128 + 8 * hh;
#pragma unroll
              for (int ks = 0; ks < 8; ++ks) hpf[ks] = *(const bf16x8*)(hp + 16 * ks); }
#pragma unroll 1
            for (int lt = 0; lt < 4; ++lt) {
                f32x16 y = zero16();
#pragma unroll
                for (int ks = 0; ks < 8; ++ks) y = MFMA32(lfrag(F.lds + L0_CM, BC_STRIDE, lt * 32 + r, 16 * ks + 8 * hh), hpf[ks], y);
#pragma unroll
                for (int i = 0; i < 16; ++i) y[i] *= __expf(cuml[lt * 32 + crow(i, hh)]);
                const float cl = cuml[lt * 32 + r];
                f32x16 XS = zero16();
#pragma unroll 1
                for (int st = 0; st <= lt; ++st) {
                    f32x16 cbt = zero16();
#pragma unroll
                    for (int ks = 0; ks < 8; ++ks) cbt = MFMA32(lfrag(F.lds + L0_BM, BC_STRIDE, st * 32 + r, 16 * ks + 8 * hh), lfrag(F.lds + L0_CM, BC_STRIDE, lt * 32 + r, 16 * ks + 8 * hh), cbt);
#pragma unroll
                    for (int g4 = 0; g4 < 4; ++g4) { const f32x4 cs = *(const LAS f32x4*)(cuml + st * 32 + 8 * g4 + 4 * hh), ds = *(const LAS f32x4*)(dtl + st * 32 + 8 * g4 + 4 * hh);
#pragma unroll
                        for (int e = 0; e < 4; ++e) { const int s = st * 32 + 8 * g4 + 4 * hh + e; const float v = cbt[4 * g4 + e] * __expf(cl - cs[e]) * ds[e]; cbt[4 * g4 + e] = (s <= lt * 32 + r) ? v : 0.f; } }
                    XS = to_acc_lds(F.lds + L0_XS, XS_STRIDE, st * 32, head * 64 + pt * 32, r, hh, I);
                    y = MFMA32(pack8<0>(cbt), pack8<0>(XS), y); y = MFMA32(pack8<1>(cbt), pack8<1>(XS), y);
                }
                const f32x16 Z = to_acc_glb(PB + (R0 + lt * 32) * IN0P + hd * 64 + pt * 32, IN0P, r, hh, I);
                bf16* dst = MIX + (R0 + lt * 32) * 4096 + hd * 64 + pt * 32 + r;
#pragma unroll
                for (int i = 0; i < 16; ++i) { const float v = (y[i] + Dh * XS[i]) * silu(Z[i]); dst[(size_t)crow(i, hh) * 4096] = (bf16)(pkbf(v, v) & 0xffffu); }
            }
        }
    }
    __syncthreads();
}
__device__ __forceinline__ void m0_out_ret(Frame& F) {
    int tid_ = threadIdx.x; asm volatile("" : "+v"(tid_)); const int TID = tid_, LANE = TID & 63, WAVE = __builtin_amdgcn_readfirstlane(TID >> 6);
    const int r_ = LANE & 31, hh_ = LANE >> 5; const IdFrag I = make_id(r_, hh_);
    const bf16* PB = WSP(bf16, WS_BIG); bf16* MIX = WSP(bf16, WS_MIX);
    for (int u = 512 + F.vcu; u < 1024; u += F.G) {
        __syncthreads();
        int r = r_, hh = hh_; asm volatile("" : "+v"(r), "+v"(hh));
        const int u2 = u - 512, bc = u2 >> 3, h = u2 & 7; const size_t R0 = (size_t)bc * 128;
        for (int i = TID; i < 4096; i += NWAVES * 64) { const int row = i >> 5, ch = i & 31;
            *(LAS v4u*)(F.lds + L0_K + row * XS_STRIDE + ch * 16) = *(const v4u*)(PB + (R0 + row) * IN0P + 8192 + h * 256 + ch * 8);
            *(LAS v4u*)(F.lds + L0_Q + row * XS_STRIDE + ch * 16) = *(const v4u*)(PB + (R0 + row) * IN0P + 6144 + h * 256 + ch * 8); }
        __syncthreads();
        const float lg = log2f(1.0f - exp2f(-5.0f - (float)h));
        const int dv0 = WAVE * 32;
        f32x16 y[4];
        {
            const bf16* rpt = WSP(bf16, WS_RPT) + ((size_t)(bc * 8 + h) * 256 + dv0 + r) * 256 + 8 * hh;
#pragma unroll
            for (int lt = 0; lt < 4; ++lt) y[lt] = zero16();
#pragma unroll 2
            for (int ks = 0; ks < 16; ++ks) { const bf16x8 rf = *(const bf16x8*)(rpt + 16 * ks);
#pragma unroll
                for (int lt = 0; lt < 4; ++lt) y[lt] = MFMA32(lfrag(F.lds + L0_Q, XS_STRIDE, lt * 32 + r, 16 * ks + 8 * hh), rf, y[lt]); }
#pragma unroll
            for (int lt = 0; lt < 4; ++lt)
#pragma unroll
                for (int i = 0; i < 16; ++i) y[lt][i] *= exp2f((float)(lt * 32 + crow(i, hh) + 1) * lg);
        }
#pragma unroll
        for (int lt = 0; lt < 4; ++lt) {
#pragma unroll 1
            for (int st = 0; st <= lt; ++st) {
                const f32x16 XV = to_acc_glb(PB + (R0 + st * 32) * IN0P + 10240 + h * 256 + dv0, IN0P, r, hh, I);
                f32x16 sct = zero16();
#pragma unroll 4
                for (int ks = 0; ks < 16; ++ks) sct = MFMA32(lfrag(F.lds + L0_K, XS_STRIDE, st * 32 + r, 16 * ks + 8 * hh), lfrag(F.lds + L0_Q, XS_STRIDE, lt * 32 + r, 16 * ks + 8 * hh), sct);
#pragma unroll
                for (int i = 0; i < 16; ++i) { const int d = (lt - st) * 32 + r - crow(i, hh); sct[i] = (d >= 0) ? sct[i] * exp2f((float)d * lg) : 0.f; }
                y[lt] = MFMA32(pack8<0>(sct), pack8<0>(XV), y[lt]); y[lt] = MFMA32(pack8<1>(sct), pack8<1>(XV), y[lt]);
            }
            __builtin_amdgcn_sched_barrier(0);
        }
        asm volatile("" : "+v"(r), "+v"(hh));
        LAS float* rsum = (LAS float*)(F.lds + L0_RS);
#pragma unroll
        for (int lt = 0; lt < 4; ++lt)
#pragma unroll
            for (int i = 0; i < 16; ++i) { float s = y[lt][i] * y[lt][i];
#pragma unroll
                for (int o = 1; o < 32; o <<= 1) s += __shfl_xor(s, o);
                if (r == 0) rsum[(lt * 32 + crow(i, hh)) * 8 + WAVE] = s; __builtin_amdgcn_sched_barrier(0); }
        __syncthreads();
        if (TID < 128) { const f32x4 s0 = *(const LAS f32x4*)(rsum + TID * 8), s1 = *(const LAS f32x4*)(rsum + TID * 8 + 4);
            rsum[1024 + TID] = rsqrtf((((s0.x + s0.y) + (s0.z + s0.w)) + ((s1.x + s1.y) + (s1.z + s1.w))) * (1.0f / 256.0f) + EPS); }
        __syncthreads();
        asm volatile("" : "+v"(r), "+v"(hh));
        const float w = F.ret_norm_w[h * 256 + dv0 + r];
#pragma unroll
        for (int lt = 0; lt < 4; ++lt) {
            const f32x16 G = to_acc_glb(PB + (R0 + lt * 32) * IN0P + 12288 + h * 256 + dv0, IN0P, r, hh, I);
            bf16* dst = MIX + (R0 + lt * 32) * 4096 + 2048 + h * 256 + dv0 + r;
#pragma unroll
            for (int i = 0; i < 16; ++i) { const float rstd = rsum[1024 + lt * 32 + crow(i, hh)];
                const float v = silu(G[i]) * (y[lt][i] * rstd * w); dst[(size_t)crow(i, hh) * 4096] = (bf16)(pkbf(v, v) & 0xffffu); }
            __builtin_amdgcn_sched_barrier(0); }
    }
    __syncthreads();
}
__device__ __forceinline__ void m0_post(Frame& F) {
    int tid_ = threadIdx.x; asm volatile("" : "+v"(tid_)); const int TID = tid_, LANE = TID & 63, WAVE = __builtin_amdgcn_readfirstlane(TID >> 6);
    const int gw = F.vcu * NWAVES + WAVE, NGW = F.G * NWAVES;
    bf16* MIX = WSP(bf16, WS_MIX);
    for (int row = gw; row < M; row += NGW) {
        v4u v[4]; float s = 0.f;
#pragma unroll
        for (int j = 0; j < 4; ++j) { v[j] = *(const v4u*)(MIX + (size_t)row * 4096 + 8 * LANE + 512 * j);
            const float a0 = bflo(v[j].x), a1 = bfhi(v[j].x), a2 = bflo(v[j].y), a3 = bfhi(v[j].y), a4 = bflo(v[j].z), a5 = bfhi(v[j].z), a6 = bflo(v[j].w), a7 = bfhi(v[j].w);
            s += ((a0 * a0 + a1 * a1) + (a2 * a2 + a3 * a3)) + ((a4 * a4 + a5 * a5) + (a6 * a6 + a7 * a7)); }
        const float rstd = rsqrtf(wave_sum(s) * (1.0f / 2048.0f) + EPS);
#pragma unroll
        for (int j = 0; j < 4; ++j) { const int c = 8 * LANE + 512 * j; const f32x4 w0 = *(const f32x4*)(F.ssd_norm_w + c), w1 = *(const f32x4*)(F.ssd_norm_w + c + 4);
            v4u o; o.x = pkbf(bflo(v[j].x) * rstd * w0.x, bfhi(v[j].x) * rstd * w0.y); o.y = pkbf(bflo(v[j].y) * rstd * w0.z, bfhi(v[j].y) * rstd * w0.w);
            o.z = pkbf(bflo(v[j].z) * rstd * w1.x, bfhi(v[j].z) * rstd * w1.y); o.w = pkbf(bflo(v[j].w) * rstd * w1.z, bfhi(v[j].w) * rstd * w1.w);
            *(v4u*)(MIX + (size_t)row * 4096 + c) = o; }
    }
}
__device__ __forceinline__ void split_store8(bf16* hi, bf16* lo, const float (&v)[8]) {
    v4u h, l; unsigned hw[4], lw[4];
#pragma unroll
    for (int e = 0; e < 4; ++e) { hw[e] = pkbf(v[2 * e], v[2 * e + 1]); lw[e] = pkbf(v[2 * e] - bflo(hw[e]), v[2 * e + 1] - bfhi(hw[e])); }
    h.x = hw[0]; h.y = hw[1]; h.z = hw[2]; h.w = hw[3]; l.x = lw[0]; l.y = lw[1]; l.z = lw[2]; l.w = lw[3];
    *(v4u*)hi = h; *(v4u*)lo = l;
}
__device__ __forceinline__ void m1_prep(Frame& F) {
    int tid_ = threadIdx.x; asm volatile("" : "+v"(tid_)); const int TID = tid_;
    const int gt = F.vcu * NWAVES * 64 + TID, NT = F.G * NWAVES * 64;
    const bf16* PB = WSP(bf16, WS_BIG); const float* IDX = WSP(float, WS_IDX);
    const float* qc = WSP(float, WS_RTQ); const float* qs = qc + M * 16; const float* ic = WSP(float, WS_RTI); const float* is = ic + M * 8;
    bf16* QA = WSP(bf16, WS_QA); bf16* KAb = WSP(bf16, WS_KAB); bf16* VAb = WSP(bf16, WS_VAB);
    for (int idx = gt; idx < M * 288; idx += NT) {
        const int row = idx / 288, ch = idx % 288, hd = ch >> 4, c = ch & 15;
        const bf16* src = PB + (size_t)row * 2304 + ch * 8;
        bf16* dst = hd < 16 ? QA + (size_t)row * 2048 + ch * 8 : (hd == 16 ? KAb + (size_t)row * 128 + c * 8 : VAb + (size_t)row * 128 + c * 8);
        if (hd == 17 || c >= 4) { *(v4u*)dst = *(const v4u*)src; continue; }
        if (c >= 2) continue;
        const v4u u1 = *(const v4u*)src, u2 = *(const v4u*)(src + 16);
        const float x1[8] = {bflo(u1.x), bfhi(u1.x), bflo(u1.y), bfhi(u1.y), bflo(u1.z), bfhi(u1.z), bflo(u1.w), bfhi(u1.w)};
        const float x2[8] = {bflo(u2.x), bfhi(u2.x), bflo(u2.y), bfhi(u2.y), bflo(u2.z), bfhi(u2.z), bflo(u2.w), bfhi(u2.w)};
        float o1[8], o2[8];
#pragma unroll
        for (int e = 0; e < 8; ++e) { const float cs = qc[row * 16 + c * 8 + e], sn = qs[row * 16 + c * 8 + e]; o1[e] = x1[e] * cs - x2[e] * sn; o2[e] = x1[e] * sn + x2[e] * cs; }
        v4u w1, w2; w1.x = pkbf(o1[0], o1[1]); w1.y = pkbf(o1[2], o1[3]); w1.z = pkbf(o1[4], o1[5]); w1.w = pkbf(o1[6], o1[7]);
        w2.x = pkbf(o2[0], o2[1]); w2.y = pkbf(o2[2], o2[3]); w2.z = pkbf(o2[4], o2[5]); w2.w = pkbf(o2[6], o2[7]);
        *(v4u*)dst = w1; *(v4u*)(dst + 16) = w2;
    }
    bf16* QIH = WSP(bf16, WS_QIH); bf16* QIL = WSP(bf16, WS_QIL);
    for (int idx = gt; idx < M * 128; idx += NT) {
        const int row = idx >> 7, ch = idx & 127, c = ch & 7;
        const float* src = IDX + (size_t)row * 1280 + ch * 8;
        if (c == 1) continue;
        float v[8]; { const f32x4 a = *(const f32x4*)src, b = *(const f32x4*)(src + 4); v[0] = a.x; v[1] = a.y; v[2] = a.z; v[3] = a.w; v[4] = b.x; v[5] = b.y; v[6] = b.z; v[7] = b.w; }
        if (c == 0) { float x2[8], o2[8]; { const f32x4 a = *(const f32x4*)(src + 8), b = *(const f32x4*)(src + 12); x2[0] = a.x; x2[1] = a.y; x2[2] = a.z; x2[3] = a.w; x2[4] = b.x; x2[5] = b.y; x2[6] = b.z; x2[7] = b.w; }
#pragma unroll
            for (int e = 0; e < 8; ++e) { const float cs = ic[row * 8 + e], sn = is[row * 8 + e]; const float x1 = v[e]; v[e] = x1 * cs - x2[e] * sn; o2[e] = x1 * sn + x2[e] * cs; }
            split_store8(QIH + (size_t)row * 1024 + ch * 8 + 8, QIL + (size_t)row * 1024 + ch * 8 + 8, o2); }
        split_store8(QIH + (size_t)row * 1024 + ch * 8, QIL + (size_t)row * 1024 + ch * 8, v);
    }
    bf16* KIH = WSP(bf16, WS_KIH); bf16* KIL = WSP(bf16, WS_KIL); float* WI = WSP(float, WS_WI);
    for (int row = gt; row < M; row += NT) {
        const float* si = IDX + (size_t)row * 1280 + 1024;
        float ss = 0.f;
#pragma unroll 4
        for (int i = 0; i < 64; i += 4) { const f32x4 a = *(const f32x4*)(si + i); ss += (a.x * a.x + a.y * a.y) + (a.z * a.z + a.w * a.w); }
        const float rstd = rsqrtf(ss * (1.0f / 64.0f) + EPS);
#pragma unroll 1
        for (int c = 0; c < 8; ++c) { if (c == 1) continue;
            float v[8];
#pragma unroll
            for (int e = 0; e < 8; ++e) v[e] = si[c * 8 + e] * rstd * F.idx_k_norm_w[c * 8 + e];
            if (c == 0) { float o2[8];
#pragma unroll
                for (int e = 0; e < 8; ++e) { const float x2 = si[8 + e] * rstd * F.idx_k_norm_w[8 + e], cs = ic[row * 8 + e], sn = is[row * 8 + e], x1 = v[e]; v[e] = x1 * cs - x2 * sn; o2[e] = x1 * sn + x2 * cs; }
                split_store8(KIH + (size_t)row * 64 + 8, KIL + (size_t)row * 64 + 8, o2); }
            split_store8(KIH + (size_t)row * 64 + c * 8, KIL + (size_t)row * 64 + c * 8, v); }
#pragma unroll
        for (int h4 = 0; h4 < 4; ++h4) { const f32x4 a = *(const f32x4*)(IDX + (size_t)row * 1280 + 1088 + 4 * h4); *(f32x4*)(WI + (size_t)row * 16 + 4 * h4) = a * 0.03125f; }
    }
}
__device__ __forceinline__ void m1_index(Frame& F) {
    int tid_ = threadIdx.x; asm volatile("" : "+v"(tid_)); const int TID = tid_, LANE = TID & 63, WAVE = __builtin_amdgcn_readfirstlane(TID >> 6);
    const int r = LANE & 31, hh = LANE >> 5;
    LAS unsigned* sc = (LAS unsigned*)(F.lds + WAVE * 16384);
    const int gw = F.vcu * NWAVES + WAVE, NGW = F.G * NWAVES;
    const bf16* QIH = WSP(bf16, WS_QIH); const bf16* QIL = WSP(bf16, WS_QIL); const bf16* KIH = WSP(bf16, WS_KIH); const bf16* KIL = WSP(bf16, WS_KIL);
    const float* WI = WSP(float, WS_WI); int* SEL = WSP(int, WS_SEL); int* NSEL = WSP(int, WS_NSEL);
    const unsigned long long ltmask = (1ull << LANE) - 1ull;
    for (int it = 0;; ++it) {
        int pr;
        if (NGW == 2048) { if (it >= 2) break; pr = it == 0 ? gw : 4095 - gw; } else { pr = gw + it * NGW; if (pr >= 4096) break; }
        const int row0 = 2 * pr, b = row0 >> 11, qp0 = row0 & (SEQ - 1);
        if (qp0 + 1 <= 255) {
#pragma unroll 1
            for (int qq = 0; qq < 2; ++qq) { const int nv = qp0 + qq + 1; for (int i = LANE; i < nv; i += 64) SEL[(size_t)(row0 + qq) * 256 + i] = i; if (LANE == 0) NSEL[row0 + qq] = nv; }
            continue; }
        bf16x8 Ah[4], Al[4];
        { const int qq = (r >> 2) & 1, hd = (r & 3) + 4 * (r >> 3); const size_t o = (size_t)(row0 + qq) * 1024 + hd * 64 + 8 * hh;
#pragma unroll
          for (int ks = 0; ks < 4; ++ks) { Ah[ks] = *(const bf16x8*)(QIH + o + 16 * ks); Al[ks] = *(const bf16x8*)(QIL + o + 16 * ks); } }
        float wv[16];
#pragma unroll
        for (int h4 = 0; h4 < 4; ++h4) { const f32x4 a = *(const f32x4*)(WI + (size_t)(row0 + hh) * 16 + 4 * h4); wv[4 * h4] = a.x; wv[4 * h4 + 1] = a.y; wv[4 * h4 + 2] = a.z; wv[4 * h4 + 3] = a.w; }
        const int ntile = (qp0 + 1) / 32 + 1;
        bf16x8 Bh[4], Bl[4];
        { const size_t ko = ((size_t)b * SEQ + r) * 64 + 8 * hh;
#pragma unroll
          for (int ks = 0; ks < 4; ++ks) { Bh[ks] = *(const bf16x8*)(KIH + ko + 16 * ks); Bl[ks] = *(const bf16x8*)(KIL + ko + 16 * ks); } }
#pragma unroll 1
        for (int kt = 0; kt < ntile; ++kt) {
            const int ktn = (kt + 1 < ntile) ? kt + 1 : kt;
            const size_t kon = ((size_t)b * SEQ + ktn * 32 + r) * 64 + 8 * hh;
            bf16x8 Nh[4], Nl[4];
#pragma unroll
            for (int ks = 0; ks < 4; ++ks) { Nh[ks] = *(const bf16x8*)(KIH + kon + 16 * ks); Nl[ks] = *(const bf16x8*)(KIL + kon + 16 * ks); }
            f32x16 acc = zero16();
#pragma unroll
            for (int ks = 0; ks < 4; ++ks) { acc = MFMA32(Ah[ks], Bh[ks], acc); acc = MFMA32(Ah[ks], Bl[ks], acc); acc = MFMA32(Al[ks], Bh[ks], acc); }
            float s = 0.f;
#pragma unroll
            for (int i = 0; i < 16; ++i) s += fmaxf(acc[i], 0.f) * wv[i];
            s += 0.0f;
            const int key = kt * 32 + r; const unsigned uu = __float_as_uint(s); const unsigned ok = (uu & 0x80000000u) ? ~uu : (uu | 0x80000000u);
            sc[hh * 2048 + key] = (key <= qp0 + hh) ? ok : 0u;
#pragma unroll
            for (int ks = 0; ks < 4; ++ks) { Bh[ks] = Nh[ks]; Bl[ks] = Nl[ks]; }
        }
        if (ntile & 1) sc[hh * 2048 + ntile * 32 + r] = 0u;
        asm volatile("s_waitcnt lgkmcnt(0)" ::: "memory");
#pragma unroll 1
        for (int qq = 0; qq < 2; ++qq) {
            const int nv = qp0 + qq + 1, nj = (nv + 63) >> 6; const int row = row0 + qq;
            unsigned vals[32];
#pragma unroll
            for (int j = 0; j < 32; ++j) vals[j] = (j < nj) ? sc[qq * 2048 + j * 64 + LANE] : 0u;
            unsigned prefix = 0u; bool exact = false;
#pragma unroll 1
            for (int bit = 31; bit >= 0; --bit) { const unsigned cand = prefix | (1u << bit); int cnt = 0;
#pragma unroll
                for (int j = 0; j < 32; ++j) cnt += __popcll(__ballot(vals[j] >= cand));
                if (cnt >= 256) prefix = cand;
                if (cnt == 256) { exact = true; break; } }
            const unsigned T = exact ? prefix - 1u : prefix;
            int base = 0;
#pragma unroll
            for (int j = 0; j < 32; ++j) { const bool p = vals[j] > T; const unsigned long long mk = __ballot(p);
                if (p) SEL[(size_t)row * 256 + base + __popcll(mk & ltmask)] = j * 64 + LANE; base += __popcll(mk); }
            if (!exact) { int need = 256 - base;
#pragma unroll
                for (int j = 0; j < 32; ++j) { const bool p = vals[j] == T; const unsigned long long mk = __ballot(p); const int rank = __popcll(mk & ltmask);
                    if (p && rank < need) SEL[(size_t)row * 256 + base + rank] = j * 64 + LANE;
                    const int c = __popcll(mk); const int take = c < need ? c : need; base += take; need -= take; } }
            if (LANE == 0) NSEL[row] = 256;
        }
    }
}
__device__ __forceinline__ void m1_attn(Frame& F) {
    int tid_ = threadIdx.x; asm volatile("" : "+v"(tid_)); const int TID = tid_, LANE = TID & 63, WAVE = __builtin_amdgcn_readfirstlane(TID >> 6);
    const int r_ = LANE & 31, hh_ = LANE >> 5; const IdFrag I = make_id(r_, hh_);
    const int gw = F.vcu * NWAVES + WAVE, NGW = F.G * NWAVES;
    const bf16* QA = WSP(bf16, WS_QA); const bf16* KAb = WSP(bf16, WS_KAB); const bf16* VAb = WSP(bf16, WS_VAB); const int* SEL = WSP(int, WS_SEL); const int* NSEL = WSP(int, WS_NSEL); bf16* MIX = WSP(bf16, WS_MIX);
#pragma unroll 1
    for (int q = gw; q < M; q += NGW) {
        int r = r_, hh = hh_; asm volatile("" : "+v"(r), "+v"(hh));
        const int b = q >> 11, nsel = NSEL[q], ntile = (nsel + 31) >> 5;
        bf16x8 qf[8];
#pragma unroll
        for (int ks = 0; ks < 8; ++ks) qf[ks] = *(const bf16x8*)(QA + (size_t)q * 2048 + (r & 15) * 128 + 16 * ks + 8 * hh);
        float mx = -3.0e38f, sum = 0.f;
        f32x16 o[4];
#pragma unroll
        for (int dt = 0; dt < 4; ++dt) o[dt] = zero16();
#pragma unroll 1
        for (int kt = 0; kt < ntile; ++kt) {
            const int sid = (kt * 32 + r < nsel) ? SEL[(size_t)q * 256 + kt * 32 + r] : 0;
            const bf16* kp = KAb + ((size_t)b * SEQ + sid) * 128 + 8 * hh;
            const bf16* vp = VAb + ((size_t)b * SEQ + sid) * 128 + 8 * hh;
            f32x16 L = zero16();
#pragma unroll
            for (int ks = 0; ks < 8; ++ks) L = MFMA32(*(const bf16x8*)(kp + 16 * ks), qf[ks], L);
            float tm = -3.0e38f;
#pragma unroll
            for (int i = 0; i < 16; ++i) { L[i] = (kt * 32 + crow(i, hh) < nsel) ? L[i] * 0.08838834764831845f : -3.0e38f; tm = fmaxf(tm, L[i]); }
            tm = fmaxf(tm, __shfl_xor(tm, 32));
            const float mn = fmaxf(mx, tm), alpha = __expf(mx - mn); mx = mn;
            float ts = 0.f;
#pragma unroll
            for (int i = 0; i < 16; ++i) { const float e = __expf(L[i] - mn); L[i] = e; ts += e; }
            sum = sum * alpha + ts;
#pragma unroll
            for (int i = 0; i < 8; ++i) { const float ah = __shfl(alpha, crow(i, hh));
#pragma unroll
                for (int dt = 0; dt < 4; ++dt) o[dt][i] *= ah; }
            const bf16x8 P0 = pack8<0>(L), P1 = pack8<1>(L);
#pragma unroll
            for (int dt = 0; dt < 4; ++dt) { f32x16 xv = MFMA32(*(const bf16x8*)(vp + dt * 32), I.f0, zero16()); xv = MFMA32(*(const bf16x8*)(vp + dt * 32 + 16), I.f1, xv);
                o[dt] = MFMA32(P0, pack8<0>(xv), o[dt]); o[dt] = MFMA32(P1, pack8<1>(xv), o[dt]); }
        }
        sum += __shfl_xor(sum, 32);
        const float inv = 1.0f / sum;
#pragma unroll
        for (int i = 0; i < 8; ++i) { const int head = crow(i, hh); const float ih = __shfl(inv, head);
#pragma unroll
            for (int dt = 0; dt < 4; ++dt) { const float v = o[dt][i] * ih; MIX[(size_t)q * 2048 + head * 128 + dt * 32 + r] = (bf16)(pkbf(v, v) & 0xffffu); } }
    }
}
struct Args { const void* in[21]; float* out; unsigned char* ws; int ph_lo, ph_hi; };
__global__ void __launch_bounds__(NWAVES * 64, 2) mk_fwd(Args args) {
    extern __shared__ __attribute__((aligned(16))) unsigned char lds_raw[];
    Frame F;
    F.lds = (LAS unsigned char*)lds_raw;
    F.G = gridDim.x; { const int bx = blockIdx.x; F.vcu = (F.G % 8 == 0) ? (bx % 8) * (F.G / 8) + bx / 8 : bx; }
    F.x = (const float*)args.in[0]; F.c = (const float*)args.in[1]; F.positions = (const int*)args.in[2]; F.mod_w = (const float*)args.in[3]; F.mod_b = (const float*)args.in[4];
    F.norm_w = (const float*)args.in[5]; F.w_gate = (const float*)args.in[6]; F.w_up = (const float*)args.in[7]; F.w_down = (const float*)args.in[8]; F.hy_w_in = (const float*)args.in[9];
    F.conv_w = (const float*)args.in[10]; F.conv_b = (const float*)args.in[11]; F.A_log = (const float*)args.in[12]; F.dt_bias = (const float*)args.in[13]; F.ssd_D = (const float*)args.in[14];
    F.ssd_norm_w = (const float*)args.in[15]; F.ret_norm_w = (const float*)args.in[16]; F.hy_w_out = (const float*)args.in[17]; F.dsa_w_in = (const float*)args.in[18];
    F.idx_k_norm_w = (const float*)args.in[19]; F.dsa_w_out = (const float*)args.in[20];
    F.out = args.out; F.ws = args.ws;
    const int TID = threadIdx.x;
    volatile LAS unsigned* MISC = (volatile LAS unsigned*)(F.lds + MISC_OFF);
    for (int u = TID; u < (LDS_BYTES - LDSCTL_OFF) / 4; u += NWAVES * 64) ((LAS unsigned*)(F.lds + LDSCTL_OFF))[u] = 0u;
    __syncthreads();
    const int lo = args.ph_lo, hi = args.ph_hi;
    XcdBarrier bar; bar.bar = (unsigned*)(F.ws + WS_CTL) + CW_BAR; bar.x = 0; bar.st = nullptr;
    if (hi - lo > 1) bar = xcd_barrier_post((unsigned*)(F.ws + WS_CTL) + CW_BAR, MISC + 8);
#define RUN(k) (lo <= (k) && (k) < hi)
#define REPS(i) (1 + (int)((PROBE_REP_MASK >> (i)) & 1u))
#define SEAM(k) do { if (RUN(k) && RUN((k) + 1)) xcd_barrier(bar); } while (0)
    bf16* H = WSP(bf16, WS_H); bf16* ACT = WSP(bf16, WS_BIG); bf16* PB = WSP(bf16, WS_BIG); bf16* MIX = WSP(bf16, WS_MIX); float* Y = WSP(float, WS_Y); float* SSQ = WSP(float, WS_SSQ);

    if (PON(0) && RUN(0)) for (int rep_ = 0; rep_ < REPS(0); ++rep_) { p0_prologue(F); __syncthreads(); }
    SEAM(0);
    if (PON(1) && RUN(1)) thin_phase(F, -1, 0);
    SEAM(1);
    int ph = 2, q = 0;
    for (int s = 0; s < 4; ++s) {
        if (PON(2) && RUN(ph)) for (int rep_ = 0; rep_ < REPS(2); ++rep_) { pg8::Gemm g{H, WSP(bf16, WS_WGU) + (size_t)s * WGU_ELEMS, M, 2 * FF, D}; pg8::StaticOrder S; S.init(M, 2 * FF, F.G, (int)blockIdx.x);
            pg8::EpiGateUp E{ACT, FF}; pg8::gemm_phase<pg8::EpiGateUp, pg8::StaticOrder, true, true>(F.lds, g, S, E); }
        SEAM(ph); ++ph;
        if (PON(3) && RUN(ph)) for (int rep_ = 0; rep_ < REPS(3); ++rep_) { pg8::Gemm g{ACT, WSP(bf16, WS_WD) + (size_t)s * WD_ELEMS, M, D, FF}; pg8::StaticOrder S; S.init(M, D, F.G, (int)blockIdx.x);
            pg8::EpiYSsq E{Y, D, SSQ}; pg8::gemm_phase<pg8::EpiYSsq, pg8::StaticOrder, true, true>(F.lds, g, S, E); }
        SEAM(ph); ++ph;
        if (PON(1) && RUN(ph)) thin_phase(F, q, q < 5 ? q + 1 : -1);
        SEAM(ph); ++ph; ++q;
        if (s == 0) {
            if (PON(4) && RUN(ph)) for (int rep_ = 0; rep_ < REPS(4); ++rep_) { pg8::Gemm g{H, WSP(bf16, WS_WIN0), M, IN0P, D}; pg8::StaticOrder S; S.init(M, IN0P, F.G, (int)blockIdx.x);
                pg8::EpiProj0 E{PB, IN0P, WSP(float, WS_DTB), WSP(float, WS_RTC), WSP(float, WS_RTS)}; pg8::gemm_phase<pg8::EpiProj0, pg8::StaticOrder, true, true>(F.lds, g, S, E); }
            SEAM(ph); ++ph;
            if (PON(6) && RUN(ph)) for (int rep_ = 0; rep_ < REPS(6); ++rep_) { m0_states(F); __syncthreads(); }
            SEAM(ph); ++ph;
            if (PON(14) && RUN(ph)) for (int rep_ = 0; rep_ < REPS(14); ++rep_) { m0_chunkscan(F); __syncthreads(); }
            SEAM(ph); ++ph;
            if (PON(15) && RUN(ph)) for (int rep_ = 0; rep_ < REPS(15); ++rep_) { if (rep_ == 0 || PROBE_OUT_SEL != 2) m0_out_ssd(F); if (rep_ == 0 || PROBE_OUT_SEL != 1) m0_out_ret(F); }
            SEAM(ph); ++ph;
            if (PON(7) && RUN(ph)) m0_post(F);
            SEAM(ph); ++ph;
            if (PON(8) && RUN(ph)) for (int rep_ = 0; rep_ < REPS(8); ++rep_) { pg8::Gemm g{MIX, WSP(bf16, WS_WOUT0), M, D, 2 * D}; pg8::StaticOrder S; S.init(M, D, F.G, (int)blockIdx.x);
                pg8::EpiYSsq E{Y, D, SSQ}; pg8::gemm_phase<pg8::EpiYSsq, pg8::StaticOrder, true, true>(F.lds, g, S, E); }
            SEAM(ph); ++ph;
            if (PON(1) && RUN(ph)) thin_phase(F, q, q + 1);
            SEAM(ph); ++ph; ++q;
        }
        if (s == 2) {
            if (PON(9) && RUN(ph)) for (int rep_ = 0; rep_ < REPS(9); ++rep_) { pg8::Gemm g{H, WSP(bf16, WS_WIN1), M, IN1P, D}; pg8::StaticOrder S; S.init(M, IN1P, F.G, (int)blockIdx.x);
                pg8::EpiProj E{PB, 2304, 9, WSP(float, WS_IDX), 1280}; pg8::gemm_phase<pg8::EpiProj, pg8::StaticOrder, true, true>(F.lds, g, S, E); }
            SEAM(ph); ++ph;
            if (PON(10) && RUN(ph)) for (int rep_ = 0; rep_ < REPS(10); ++rep_) { m1_prep(F); __syncthreads(); }
            SEAM(ph); ++ph;
            if (PON(11) && RUN(ph)) for (int rep_ = 0; rep_ < REPS(11); ++rep_) { m1_index(F); __syncthreads(); }
            SEAM(ph); ++ph;
            if (PON(12) && RUN(ph)) for (int rep_ = 0; rep_ < REPS(12); ++rep_) { m1_attn(F); __syncthreads(); }
            SEAM(ph); ++ph;
            if (PON(13) && RUN(ph)) for (int rep_ = 0; rep_ < REPS(13); ++rep_) { pg8::Gemm g{MIX, WSP(bf16, WS_WOUT1), M, D, D}; pg8::StaticOrder S; S.init(M, D, F.G, (int)blockIdx.x);
                pg8::EpiYSsq E{Y, D, SSQ}; pg8::gemm_phase<pg8::EpiYSsq, pg8::StaticOrder, true, true>(F.lds, g, S, E); }
            SEAM(ph); ++ph;
            if (PON(1) && RUN(ph)) thin_phase(F, q, q + 1);
            SEAM(ph); ++ph; ++q;
        }
    }
#undef RUN
#undef SEAM
}

extern "C" void kernel_launch(void* const* d_in, const int* in_sizes, int n_in, void* d_out, int out_size, void* d_ws, size_t ws_size, hipStream_t stream) {
    static int grid = 0;
    if (grid == 0) {
        if (n_in != 21 || out_size != M * D || ws_size < WS_END) { fprintf(stderr, "kernel_launch: unexpected shapes (n_in %d, out %d, ws %zu < %zu)\n", n_in, out_size, ws_size, (size_t)WS_END); grid = -1; return; }
        int dev = 0, cus = 0, per_cu = 0;
        if (hipGetDevice(&dev) != hipSuccess || hipDeviceGetAttribute(&cus, hipDeviceAttributeMultiprocessorCount, dev) != hipSuccess) { grid = -1; return; }
        if (hipFuncSetAttribute((const void*)mk_fwd, hipFuncAttributeMaxDynamicSharedMemorySize, LDS_BYTES) != hipSuccess) { fprintf(stderr, "kernel_launch: hipFuncSetAttribute failed\n"); grid = -1; return; }
        if (hipOccupancyMaxActiveBlocksPerMultiprocessor(&per_cu, (const void*)mk_fwd, NWAVES * 64, LDS_BYTES) != hipSuccess || per_cu < 1) { fprintf(stderr, "kernel_launch: occupancy query says %d\n", per_cu); }
        (void)hipGetLastError();
        grid = cus;
    }
    if (grid < 0) return;
    (void)hipMemsetAsync((char*)d_ws + WS_CTL, 0, CTL_ZERO_BYTES, stream);
    Args a{};
    for (int i = 0; i < 21; ++i) a.in[i] = d_in[i];
    a.out = (float*)d_out; a.ws = (unsigned char*)d_ws;
#if MK_LAUNCH_PER_PHASE
    for (int p = 0; p < NPH; ++p) { a.ph_lo = p; a.ph_hi = p + 1; hipLaunchKernelGGL(mk_fwd, dim3(grid), dim3(NWAVES * 64), LDS_BYTES, stream, a); }
#else
    a.ph_lo = 0; a.ph_hi = NPH; hipLaunchKernelGGL(mk_fwd, dim3(grid), dim3(NWAVES * 64), LDS_BYTES, stream, a);
#endif
}
```

```cpp
#include <hip/hip_runtime.h>
#include <cstdio>
#include <cstdint>
namespace pg8 {
#define PG8_LAS __attribute__((address_space(3)))
typedef unsigned short bf16_t;
typedef short bf16x8 __attribute__((ext_vector_type(8)));
typedef float f32x4 __attribute__((ext_vector_type(4)));
typedef unsigned u32x4 __attribute__((ext_vector_type(4)));
constexpr int BM = 256, BK = 64, HALF = 128, HTB = HALF * BK * 2  , STAGE_BYTES = 8 * HTB, NXCD = 8, WGM = 8;

__host__ __device__ __forceinline__ int lds_byte(int r, int c) { const int st = (r >> 4) * 2 + (c >> 5), rr = r & 15, cc = c & 31, ob = rr * 64 + cc * 2; return st * 1024 + (ob ^ (((ob >> 9) & 1) << 5)); }
__host__ __device__ __forceinline__ void stage_rc(int b, int& R, int& C) { const int st = b / 1024, sb = b % 1024, swz = sb ^ (((sb >> 9) & 1) << 5); R = (st >> 1) * 16 + swz / 64; C = (st & 1) * 32 + (swz % 64) / 2; }
__host__ __device__ __forceinline__ int perm32(int rho) { const int n = rho >> 4, i = rho & 15; return 8 * (i >> 2) + 4 * n + (i & 3); }

struct Unit { int pm, pn; };
struct Gemm { const bf16_t* A; const bf16_t* Bt; int M, N, K; };

struct StaticOrder {
    int nM, nN, nwg, G, c;
    __host__ __device__ void init(int M, int N, int G_, int c_) { nM = M / BM; nN = N / BM; nwg = nM * nN; G = G_; c = c_; }
    __host__ __device__ bool next(int i, Unit& u) const {
        const long L = (long)i * G + c; if (L >= nwg) return false;
        int wgid = (int)L; { const int q = nwg / NXCD, r = nwg % NXCD, xcd = wgid % NXCD, off = wgid / NXCD; wgid = (xcd < r ? xcd * (q + 1) : r * (q + 1) + (xcd - r) * q) + off; }
        const int nig = WGM * nN, gid = wgid / nig, fm = gid * WGM, gsz = (nM - fm) < WGM ? (nM - fm) : WGM;
        u.pm = fm + ((wgid % nig) % gsz); u.pn = (wgid % nig) / gsz; return true;
    }
    __device__ __forceinline__ void a_ready(const Unit&) const {}
    __device__ __forceinline__ void done(const Unit&) const {}
};

__device__ __forceinline__ unsigned cvt_pk_bf16(float lo, float hi) { unsigned r; asm volatile("v_cvt_pk_bf16_f32 %0, %1, %2" : "=v"(r) : "v"(lo), "v"(hi)); return r; }
typedef float f32x2 __attribute__((ext_vector_type(2)));
__device__ __forceinline__ float silu_f(float v) { return v * __builtin_amdgcn_rcpf(1.0f + __expf(-v)); }

struct EpiGateUp {
    static constexpr bool PERM = true, AFTER_DRAIN = false;
    bf16_t* O; int ldc;
    __device__ __forceinline__ void operator()(const f32x4 (&acc)[2][2][4][2], const Unit& u, int wr, int wc, int fr, int fq) const {
        const int row0 = u.pm * BM + wr * 64 + fr, col0 = u.pn * HALF + wc * 32 + 8 * fq;
#pragma unroll
        for (int ai = 0; ai < 2; ++ai)
#pragma unroll
            for (int m = 0; m < 4; ++m) { bf16_t* rowp = O + (size_t)(row0 + ai * HALF + m * 16) * ldc + col0;
                const f32x4 g0 = acc[ai][0][m][0], g1 = acc[ai][0][m][1], u0 = acc[ai][1][m][0], u1 = acc[ai][1][m][1];
                f32x4 v0, v1;
#pragma unroll
                for (int j = 0; j < 4; ++j) { v0[j] = silu_f(g0[j]) * u0[j]; v1[j] = silu_f(g1[j]) * u1[j]; }
                u32x4 w; w.x = cvt_pk_bf16(v0[0], v0[1]); w.y = cvt_pk_bf16(v0[2], v0[3]); w.z = cvt_pk_bf16(v1[0], v1[1]); w.w = cvt_pk_bf16(v1[2], v1[3]);
                *(u32x4*)rowp = w; }
    }
};
struct EpiYSsq {
    static constexpr bool PERM = true, AFTER_DRAIN = false;
    bf16_t* C; int ldc; float* ssq;
    __device__ __forceinline__ void operator()(const f32x4 (&acc)[2][2][4][2], const Unit& u, int wr, int wc, int fr, int fq) const {
        const int row0 = u.pm * BM + wr * 64 + fr, col0 = u.pn * BM + wc * 32 + 8 * fq;
#pragma unroll
        for (int ai = 0; ai < 2; ++ai)
#pragma unroll
            for (int m = 0; m < 4; ++m) { const int row = row0 + ai * HALF + m * 16; bf16_t* rowp = C + (size_t)row * ldc + col0; float s = 0.f;
#pragma unroll
                for (int bj = 0; bj < 2; ++bj) { const f32x4 v0 = acc[ai][bj][m][0], v1 = acc[ai][bj][m][1];
                    s += ((v0[0] * v0[0] + v0[1] * v0[1]) + (v0[2] * v0[2] + v0[3] * v0[3])) + ((v1[0] * v1[0] + v1[1] * v1[1]) + (v1[2] * v1[2] + v1[3] * v1[3]));
                    u32x4 w; w.x = cvt_pk_bf16(v0[0], v0[1]); w.y = cvt_pk_bf16(v0[2], v0[3]); w.z = cvt_pk_bf16(v1[0], v1[1]); w.w = cvt_pk_bf16(v1[2], v1[3]);
                    *(u32x4*)(rowp + bj * HALF) = w; }
                s += __shfl_xor(s, 16); s += __shfl_xor(s, 32);
                if (fq == 0) ssq[(size_t)row * 32 + u.pn * 4 + wc] = s; }
    }
};
struct EpiProj {
    static constexpr bool PERM = true, AFTER_DRAIN = false;
    bf16_t* O; int ldo; int nbf; float* Fo; int ldf;
    __device__ __forceinline__ void operator()(const f32x4 (&acc)[2][2][4][2], const Unit& u, int wr, int wc, int fr, int fq) const {
        const int row0 = u.pm * BM + wr * 64 + fr;
        if (u.pn < nbf) {
            const int col0 = u.pn * BM + wc * 32 + 8 * fq;
#pragma unroll
            for (int ai = 0; ai < 2; ++ai)
#pragma unroll
                for (int m = 0; m < 4; ++m) { bf16_t* rowp = O + (size_t)(row0 + ai * HALF + m * 16) * ldo + col0;
#pragma unroll
                    for (int bj = 0; bj < 2; ++bj) { const f32x4 v0 = acc[ai][bj][m][0], v1 = acc[ai][bj][m][1];
                        u32x4 w; w.x = cvt_pk_bf16(v0[0], v0[1]); w.y = cvt_pk_bf16(v0[2], v0[3]); w.z = cvt_pk_bf16(v1[0], v1[1]); w.w = cvt_pk_bf16(v1[2], v1[3]);
                        *(u32x4*)(rowp + bj * HALF) = w; } }
        } else {
            const int col0 = (u.pn - nbf) * BM + wc * 32 + 8 * fq;
#pragma unroll
            for (int ai = 0; ai < 2; ++ai)
#pragma unroll
                for (int m = 0; m < 4; ++m) { float* rowp = Fo + (size_t)(row0 + ai * HALF + m * 16) * ldf + col0;
#pragma unroll
                    for (int bj = 0; bj < 2; ++bj) { *(f32x4*)(rowp + bj * HALF) = acc[ai][bj][m][0]; *(f32x4*)(rowp + bj * HALF + 4) = acc[ai][bj][m][1]; } }
        }
    }
};
struct EpiProj0 {
    static constexpr bool PERM = true, AFTER_DRAIN = false;
    bf16_t* O; int ldo; float* Fo; const float* rc; const float* rs;
    __device__ __forceinline__ void operator()(const f32x4 (&acc)[2][2][4][2], const Unit& u, int wr, int wc, int fr, int fq) const {
        const int row0 = u.pm * BM + wr * 64 + fr;
        if (u.pn == 56) {
            const int col0 = wc * 32 + 8 * fq;
#pragma unroll
            for (int ai = 0; ai < 2; ++ai)
#pragma unroll
                for (int m = 0; m < 4; ++m) { float* rowp = Fo + (size_t)(row0 + ai * HALF + m * 16) * 256 + col0;
#pragma unroll
                    for (int bj = 0; bj < 2; ++bj) { *(f32x4*)(rowp + bj * HALF) = acc[ai][bj][m][0]; *(f32x4*)(rowp + bj * HALF + 4) = acc[ai][bj][m][1]; } }
            return;
        }
        const int col0 = u.pn * BM + wc * 32 + 8 * fq;
        const bool rot = (u.pn >= 24 && u.pn < 40); const float sc = (u.pn >= 32) ? 0.0625f : 1.0f;
#pragma unroll
        for (int ai = 0; ai < 2; ++ai)
#pragma unroll
            for (int m = 0; m < 4; ++m) { const int row = row0 + ai * HALF + m * 16; bf16_t* rowp = O + (size_t)row * ldo + col0;
                f32x4 a0 = acc[ai][0][m][0], a1 = acc[ai][0][m][1], b0 = acc[ai][1][m][0], b1 = acc[ai][1][m][1];
                if (rot) { const int i0 = wc * 32 + 8 * fq;
                    const f32x4 c0 = *(const f32x4*)(rc + (size_t)row * 128 + i0), c1 = *(const f32x4*)(rc + (size_t)row * 128 + i0 + 4), s0 = *(const f32x4*)(rs + (size_t)row * 128 + i0), s1 = *(const f32x4*)(rs + (size_t)row * 128 + i0 + 4);
                    const f32x4 x0 = a0, x1 = a1, y0 = b0, y1 = b1;
                    a0 = (x0 * c0 - y0 * s0) * sc; a1 = (x1 * c1 - y1 * s1) * sc; b0 = (x0 * s0 + y0 * c0) * sc; b1 = (x1 * s1 + y1 * c1) * sc; }
                u32x4 w; w.x = cvt_pk_bf16(a0[0], a0[1]); w.y = cvt_pk_bf16(a0[2], a0[3]); w.z = cvt_pk_bf16(a1[0], a1[1]); w.w = cvt_pk_bf16(a1[2], a1[3]);
                *(u32x4*)rowp = w;
                w.x = cvt_pk_bf16(b0[0], b0[1]); w.y = cvt_pk_bf16(b0[2], b0[3]); w.z = cvt_pk_bf16(b1[0], b1[1]); w.w = cvt_pk_bf16(b1[2], b1[3]);
                *(u32x4*)(rowp + HALF) = w; }
    }
};
template <class Epi, class Sched, bool ALIGN_EPI = false, bool SP2 = false>
__device__ __forceinline__ void gemm_phase(PG8_LAS unsigned char* lds, const Gemm g, const Sched& S, const Epi& E) {
    int tid_ = threadIdx.x; asm volatile("" : "+v"(tid_));
    const int tid = tid_, wid = __builtin_amdgcn_readfirstlane(tid >> 6), lane = tid & 63, wr = wid >> 2, wc = wid & 3, fr = lane & 15, fq = lane >> 4;
    const int K = g.K, nt = K / BK;
    unsigned voffA[2], voffB[2];
#pragma unroll
    for (int i = 0; i < 2; ++i) { int R, C; stage_rc(tid * 16 + i * 8192, R, C); const int Rb = Epi::PERM ? ((R & ~31) + perm32(R & 31)) : R;
        voffA[i] = (unsigned)(R * K + C) * 2u; voffB[i] = (unsigned)(Rb * K + C) * 2u; }
    const size_t kstep = (size_t)(BK * 2);
    const size_t hstep = (size_t)HALF * K * 2;
    const size_t tstep = 2 * hstep;
    const unsigned ldsw = (unsigned)wid * 1024u;
    const int aoff = lds_byte(wr * 64 + fr, fq * 8), boff = lds_byte(wc * 32 + fr, fq * 8);
#define PG8_SA(b, h) (((b) * 2 + (h)) * HTB)
#define PG8_SB(b, h) ((4 + (b) * 2 + (h)) * HTB)
#define PG8_STAGE(bufoff, gbase, voff) do { _Pragma("unroll") for (int _i = 0; _i < 2; ++_i) \
        __builtin_amdgcn_global_load_lds((const unsigned*)((const char*)(gbase) + (voff)[_i]), (PG8_LAS unsigned*)(lds + (bufoff) + ldsw + _i * 8192), 16, 0, 0); } while (0)
#define PG8_LDA(dst, b, h) do { _Pragma("unroll") for (int m = 0; m < 4; ++m) _Pragma("unroll") for (int k = 0; k < 2; ++k) dst[m][k] = *(const PG8_LAS bf16x8*)(lds + PG8_SA(b, h) + aoff + m * 2048 + k * 1024); } while (0)
#define PG8_LDB(dst, b, h) do { _Pragma("unroll") for (int n = 0; n < 2; ++n) _Pragma("unroll") for (int k = 0; k < 2; ++k) dst[n][k] = *(const PG8_LAS bf16x8*)(lds + PG8_SB(b, h) + boff + n * 2048 + k * 1024); } while (0)
#define PG8_MMA(ai, bj, At, Bt) do { __builtin_amdgcn_s_setprio(1); _Pragma("unroll") for (int m = 0; m < 4; ++m) _Pragma("unroll") for (int n = 0; n < 2; ++n) _Pragma("unroll") for (int k = 0; k < 2; ++k) \
        acc[ai][bj][m][n] = __builtin_amdgcn_mfma_f32_16x16x32_bf16(Bt[n][k], At[m][k], acc[ai][bj][m][n], 0, 0, 0); __builtin_amdgcn_s_setprio(0); } while (0)
#define PG8_WAIT_V(n) asm volatile("s_waitcnt vmcnt(" #n ")" ::: "memory")
#define PG8_WAIT_L(n) asm volatile("s_waitcnt lgkmcnt(" #n ")" ::: "memory")
#define PG8_BAR __builtin_amdgcn_s_barrier()
#define PG8_SCHED __builtin_amdgcn_sched_barrier(0)
    Unit cur, nxt; int ui = 0;
    if (!S.next(0, cur)) return;
    f32x4 acc[2][2][4][2];
#pragma unroll
    for (int a = 0; a < 2; ++a)
#pragma unroll
        for (int b = 0; b < 2; ++b)
#pragma unroll
            for (int m = 0; m < 4; ++m)
#pragma unroll
                for (int n = 0; n < 2; ++n) acc[a][b][m][n] = (f32x4){0.f, 0.f, 0.f, 0.f};
    bf16x8 At[4][2], B0[2][2], B1[2][2];
    const char* cA = (const char*)g.A + (size_t)cur.pm * tstep; const char* cB = (const char*)g.Bt + (size_t)cur.pn * tstep;
    S.a_ready(cur);
    if constexpr (SP2) {
        PG8_STAGE(PG8_SB(0, 0), cB, voffB); PG8_STAGE(PG8_SB(0, 1), cB + hstep, voffB); PG8_STAGE(PG8_SA(0, 0), cA, voffA); PG8_STAGE(PG8_SA(0, 1), cA + hstep, voffA);
        if (wr == 1) PG8_BAR;
        PG8_WAIT_V(2); PG8_BAR;
        PG8_STAGE(PG8_SB(1, 0), cB + kstep, voffB); PG8_STAGE(PG8_SA(1, 0), cA + kstep, voffA); PG8_STAGE(PG8_SB(1, 1), cB + hstep + kstep, voffB);
        PG8_WAIT_V(6); PG8_BAR;
    } else {
        PG8_STAGE(PG8_SB(0, 0), cB, voffB); PG8_STAGE(PG8_SA(0, 0), cA, voffA); PG8_STAGE(PG8_SB(0, 1), cB + hstep, voffB); PG8_STAGE(PG8_SA(0, 1), cA + hstep, voffA);
        if (wr == 1) PG8_BAR;
        PG8_WAIT_V(4); PG8_BAR;
        PG8_STAGE(PG8_SB(1, 0), cB + kstep, voffB); PG8_STAGE(PG8_SA(1, 0), cA + kstep, voffA); PG8_STAGE(PG8_SB(1, 1), cB + hstep + kstep, voffB);
        PG8_WAIT_V(6); PG8_BAR;
    }
    for (;;) {
        const bool has_next = S.next(ui + 1, nxt);
        const char* nA = has_next ? (const char*)g.A + (size_t)nxt.pm * tstep : cA; const char* nB = has_next ? (const char*)g.Bt + (size_t)nxt.pn * tstep : cB;
        for (int t = 0; t < nt; t += 2) {
            const bool last = (t == nt - 2);
            const char* a1 = cA + (size_t)(t + 1) * kstep;
            const char* a2 = last ? nA : cA + (size_t)(t + 2) * kstep; const char* b2 = last ? nB : cB + (size_t)(t + 2) * kstep;
            const char* a3 = a2 + kstep; const char* b3 = b2 + kstep;
            if (last && has_next) S.a_ready(nxt);
            if constexpr (SP2) {
            PG8_LDB(B0, 0, 0); PG8_LDB(B1, 0, 1); PG8_SCHED; PG8_LDA(At, 0, 0); PG8_STAGE(PG8_SA(1, 1), a1 + hstep, voffA);
            PG8_WAIT_V(8); PG8_WAIT_L(0); PG8_BAR; PG8_MMA(0, 0, At, B0); PG8_MMA(0, 1, At, B1); PG8_BAR; PG8_SCHED;
            PG8_LDA(At, 0, 1); PG8_STAGE(PG8_SB(0, 0), b2, voffB); PG8_STAGE(PG8_SB(0, 1), b2 + hstep, voffB); PG8_STAGE(PG8_SA(0, 0), a2, voffA);
            PG8_WAIT_V(8); PG8_WAIT_L(0); PG8_BAR; PG8_MMA(1, 0, At, B0); PG8_MMA(1, 1, At, B1); PG8_BAR; PG8_SCHED;
            PG8_LDB(B0, 1, 0); PG8_LDB(B1, 1, 1); PG8_SCHED; PG8_LDA(At, 1, 0); PG8_STAGE(PG8_SA(0, 1), a2 + hstep, voffA);
            PG8_WAIT_V(8); PG8_WAIT_L(0); PG8_BAR; PG8_MMA(0, 0, At, B0); PG8_MMA(0, 1, At, B1); PG8_BAR; PG8_SCHED;
            PG8_LDA(At, 1, 1); PG8_STAGE(PG8_SB(1, 0), b3, voffB); PG8_STAGE(PG8_SB(1, 1), b3 + hstep, voffB); PG8_STAGE(PG8_SA(1, 0), a3, voffA);
            PG8_WAIT_V(8); PG8_WAIT_L(0); PG8_BAR; PG8_MMA(1, 0, At, B0); PG8_MMA(1, 1, At, B1); PG8_BAR; PG8_SCHED;
            } else {
            PG8_LDB(B0, 0, 0); PG8_SCHED; PG8_LDA(At, 0, 0); PG8_STAGE(PG8_SA(1, 1), a1 + hstep, voffA);
            PG8_WAIT_L(8); PG8_BAR; PG8_WAIT_L(0); PG8_MMA(0, 0, At, B0); PG8_BAR; PG8_SCHED;
            PG8_LDB(B1, 0, 1); PG8_STAGE(PG8_SB(0, 0), b2, voffB);
            PG8_BAR; PG8_WAIT_L(0); PG8_MMA(0, 1, At, B1); PG8_BAR;
            PG8_LDA(At, 0, 1); PG8_STAGE(PG8_SA(0, 0), a2, voffA);
            PG8_BAR; PG8_WAIT_L(0); PG8_MMA(1, 0, At, B0); PG8_BAR; PG8_SCHED;
            PG8_STAGE(PG8_SB(0, 1), b2 + hstep, voffB);
            PG8_WAIT_V(6); PG8_BAR; PG8_MMA(1, 1, At, B1); PG8_BAR;
            PG8_LDB(B0, 1, 0); PG8_SCHED; PG8_LDA(At, 1, 0); PG8_STAGE(PG8_SA(0, 1), a2 + hstep, voffA);
            PG8_WAIT_L(8); PG8_BAR; PG8_WAIT_L(0); PG8_MMA(0, 0, At, B0); PG8_BAR; PG8_SCHED;
            PG8_LDB(B1, 1, 1); PG8_STAGE(PG8_SB(1, 0), b3, voffB);
            PG8_BAR; PG8_WAIT_L(0); PG8_MMA(0, 1, At, B1); PG8_BAR;
            PG8_LDA(At, 1, 1); PG8_STAGE(PG8_SA(1, 0), a3, voffA);
            PG8_BAR; PG8_WAIT_L(0); PG8_MMA(1, 0, At, B0); PG8_BAR; PG8_SCHED;
            PG8_STAGE(PG8_SB(1, 1), b3 + hstep, voffB);
            PG8_WAIT_V(6); PG8_BAR; PG8_MMA(1, 1, At, B1); PG8_BAR;
            }
        }
        if constexpr (ALIGN_EPI) { if (wr == 0) PG8_BAR; }
        if constexpr (!Epi::AFTER_DRAIN) { E(acc, cur, wr, wc, fr, fq); S.done(cur); }
        if (!has_next) break;
#pragma unroll
        for (int a = 0; a < 2; ++a)
#pragma unroll
            for (int b = 0; b < 2; ++b)
#pragma unroll
                for (int m = 0; m < 4; ++m)
#pragma unroll
                    for (int n = 0; n < 2; ++n) acc[a][b][m][n] = (f32x4){0.f, 0.f, 0.f, 0.f};
        cur = nxt; cA = nA; cB = nB; ++ui;
        if constexpr (ALIGN_EPI) { if (wr == 1) PG8_BAR; }
    }
    PG8_WAIT_V(0);
    if constexpr (!ALIGN_EPI) { if (wr == 0) PG8_BAR; }
    PG8_BAR;
    if constexpr (Epi::AFTER_DRAIN) { E.fused(acc, cur, wr, wc, fr, fq, lds, wid, lane); S.done(cur); }
#undef PG8_SA
#undef PG8_SB
#undef PG8_STAGE
#undef PG8_LDA
#undef PG8_LDB
#undef PG8_MMA
#undef PG8_WAIT_V
#undef PG8_WAIT_L
#undef PG8_BAR
#undef PG8_SCHED
}
}
#define GAS __attribute__((address_space(1)))
#define LAS __attribute__((address_space(3)))
typedef unsigned short bf16;
typedef unsigned v4u __attribute__((ext_vector_type(4)));
typedef float f32x4 __attribute__((ext_vector_type(4)));
typedef short bf16x8 __attribute__((ext_vector_type(8)));
typedef GAS unsigned gu32;
typedef GAS unsigned long long gu64;
#define RLX_AGENT __ATOMIC_RELAXED, __HIP_MEMORY_SCOPE_AGENT
#define LDS_WAIT() asm volatile("s_waitcnt lgkmcnt(0)" ::: "memory")
#define VM_WAIT() asm volatile("s_waitcnt vmcnt(0)" ::: "memory")
__device__ __forceinline__ unsigned long long rt() { return __builtin_amdgcn_s_memrealtime(); }
__device__ __forceinline__ unsigned f2bf(float f) { unsigned u = __builtin_bit_cast(unsigned, f); return (u + 0x7fffu + ((u >> 16) & 1u)) >> 16; }
__device__ __forceinline__ unsigned pk2(float lo, float hi) { return f2bf(lo) | (f2bf(hi) << 16); }

#define XB_TMO      128
#define XB_XCNT(j)  (256  + 64 * (j))
#define XB_XSUB(j)  (1280 + 64 * (j))
#define XB_XGEN(j)  (2304 + 64 * (j))
#define XB_TOP      3328
#define XB_TOPGEN   3392
#define XCD_BAR_WORDS 3456
#define XB_SPIN_CAP (1u << 18)

__device__ __forceinline__ unsigned xb_ld(unsigned* p)              { return __hip_atomic_load(p, __ATOMIC_RELAXED, __HIP_MEMORY_SCOPE_AGENT); }
__device__ __forceinline__ unsigned xb_add(unsigned* p, unsigned v) { return __hip_atomic_fetch_add(p, v, __ATOMIC_RELAXED, __HIP_MEMORY_SCOPE_AGENT); }
__device__ __forceinline__ unsigned xb_xcc_id() { return (unsigned)__builtin_amdgcn_s_getreg((3 << 11) | 20) & 0xFu; }
#define XB_SPIN(cond, bar) do { unsigned _sp = 0; while (cond) { __builtin_amdgcn_s_sleep(1); \
    if ((++_sp & 255u) == 0u) { if (xb_ld(&(bar)[XB_TMO])) break; if (_sp > XB_SPIN_CAP) { atomicAdd(&(bar)[XB_TMO], 1u); break; } } } } while (0)

struct XcdBarrier {
    unsigned* bar; unsigned x;
    volatile LAS unsigned* st;
};

__device__ __forceinline__ XcdBarrier xcd_barrier_post(unsigned* bar, volatile LAS unsigned* st) {
    XcdBarrier b; b.bar = bar; b.x = xb_xcc_id(); b.st = st;
    if (threadIdx.x == 0) (void)xb_add(&bar[XB_XCNT(b.x)], 1u);
    return b;
}
__device__ __forceinline__ void xcd_barrier_complete(unsigned* bar, unsigned x, unsigned& nloc, unsigned& nx) {
    const unsigned G = gridDim.x * gridDim.y * gridDim.z;
    unsigned sum, cnt, mine, sp = 0u;
    for (;;) {
        sum = 0u; cnt = 0u; mine = 0u;
#pragma unroll
        for (unsigned j = 0; j < 16; ++j) { const unsigned c = xb_ld(&bar[XB_XCNT(j)]); sum += c; cnt += (c > 0u) ? 1u : 0u; mine = (j == x) ? c : mine; }
        if (sum == G) break;
        __builtin_amdgcn_s_sleep(1);
        if ((++sp & 255u) == 0u) { if (xb_ld(&bar[XB_TMO])) break; if (sp > XB_SPIN_CAP) { atomicAdd(&bar[XB_TMO], 1u); break; } }
    }
    nloc = mine > 0u ? mine : 1u; nx = cnt > 0u ? cnt : 1u;
}

__device__ __forceinline__ void xcd_barrier(const XcdBarrier& b) {
    asm volatile("s_waitcnt vmcnt(0)" ::: "memory");
    __syncthreads();
    if (threadIdx.x == 0) {
        unsigned* bar = b.bar;
        __builtin_amdgcn_s_waitcnt(0);
        unsigned nloc = b.st[0], nx = b.st[1];
        if (nloc == 0u) { xcd_barrier_complete(bar, b.x, nloc, nx); b.st[0] = nloc; b.st[1] = nx; }
        const unsigned old = xb_add(&bar[XB_XSUB(b.x)], 1u);
        const unsigned gen = old / nloc;
        if (old + 1u == (gen + 1u) * nloc) {
            __builtin_amdgcn_fence(__ATOMIC_RELEASE, "agent");
            asm volatile("s_waitcnt vmcnt(0)" ::: "memory");
            const unsigned og = xb_add(&bar[XB_TOP], 1u);
            const unsigned tg = og / nx;
            if (og + 1u == (tg + 1u) * nx) xb_add(&bar[XB_TOPGEN], 1u);
            else XB_SPIN(xb_ld(&bar[XB_TOPGEN]) == tg, bar);
            __builtin_amdgcn_fence(__ATOMIC_ACQUIRE, "agent");
            xb_add(&bar[XB_XGEN(b.x)], 1u);
            asm volatile("s_waitcnt vmcnt(0)" ::: "memory");
        } else {
            XB_SPIN(xb_ld(&bar[XB_XGEN(b.x)]) == gen, bar);
            __builtin_amdgcn_fence(__ATOMIC_ACQUIRE, "agent");
            asm volatile("s_waitcnt vmcnt(0)" ::: "memory");
        }
    }
    __syncthreads();
}


#ifndef MK_LAUNCH_PER_PHASE
#define MK_LAUNCH_PER_PHASE 0
#endif
constexpr int NWAVES = 8;
#ifndef PHASE_MASK
#define PHASE_MASK 0xFFFFFFFFu
#endif
#define PON(i) ((PHASE_MASK >> (i)) & 1u)
#ifndef PROBE_REP_MASK
#define PROBE_REP_MASK 0u
#endif
#ifndef PROBE_OUT_SEL
#define PROBE_OUT_SEL 0
#endif

constexpr int NB = 4, SEQ = 2048, D = 2048, M = NB * SEQ, FF = 5632;
constexpr int IN0 = 14368, IN0P = 14592, IN1 = 3408, IN1P = 3584;
constexpr int MODW = 9 * D;
constexpr float EPS = 1e-6f;
constexpr int NPH = 27;

constexpr size_t MiB = 1u << 20;
constexpr size_t WS_CTL = 0, CTL_ZERO_BYTES = 1 * MiB;
constexpr size_t WS_MODS = 1 * MiB;
constexpr size_t WS_RTC = 2 * MiB, WS_RTS = 6 * MiB;
constexpr size_t WS_RTQ = 10 * MiB;
constexpr size_t WS_RTI = 11 * MiB;
constexpr size_t WS_SSQ = 12 * MiB;
constexpr size_t WS_DTB = 13 * MiB;
constexpr size_t WS_WGU = 24 * MiB;
constexpr size_t WS_WD = 200 * MiB;
constexpr size_t WS_WIN0 = 288 * MiB;
constexpr size_t WS_WOUT0 = 345 * MiB;
constexpr size_t WS_WIN1 = 361 * MiB;
constexpr size_t WS_WOUT1 = 375 * MiB;
constexpr size_t WS_H = 384 * MiB;
constexpr size_t WS_Y = 416 * MiB;
constexpr size_t WS_MIX = 480 * MiB;
constexpr size_t WS_BIG = 544 * MiB;
constexpr size_t WS_CD = 21 * MiB;
constexpr size_t WS_XC = 772 * MiB;
constexpr size_t WS_QR = 836 * MiB, WS_KR = 868 * MiB;
constexpr size_t WS_RST = 900 * MiB;
constexpr size_t WS_RPT = 1028 * MiB;
constexpr size_t WS_SST = WS_Y;
constexpr size_t WS_HP = WS_H;
constexpr size_t WS_IDX = 772 * MiB;
constexpr size_t WS_QA = 812 * MiB;
constexpr size_t WS_KAB = 844 * MiB, WS_VAB = 846 * MiB;
constexpr size_t WS_QIH = 848 * MiB, WS_QIL = 864 * MiB;
constexpr size_t WS_KIH = 880 * MiB, WS_KIL = 881 * MiB;
constexpr size_t WS_WI = 882 * MiB;
constexpr size_t WS_SEL = 884 * MiB;
constexpr size_t WS_NSEL = 892 * MiB;
constexpr size_t WS_END = 1092 * MiB;
constexpr size_t WGU_ELEMS = (size_t)2 * FF * D, WD_ELEMS = (size_t)D * FF;
constexpr int CW_BAR = 4096;

constexpr int RING_BYTES = 131072;
constexpr int LDSCTL_OFF = 146432, MISC_OFF = LDSCTL_OFF + 320;
constexpr int LDS_BYTES = 147456;

__device__ __forceinline__ float bf2f(unsigned short b) { return __uint_as_float(((unsigned)b) << 16); }
__device__ __forceinline__ float bflo(unsigned w) { return __uint_as_float(w << 16); }
__device__ __forceinline__ float bfhi(unsigned w) { return __uint_as_float(w & 0xffff0000u); }
__device__ __forceinline__ float silu(float v) { return v / (1.0f + __expf(-v)); }
__device__ __forceinline__ float wave_sum(float v) {
#pragma unroll
    for (int o = 1; o < 64; o <<= 1) v += __shfl_xor(v, o);
    return v;
}

struct Frame {
    LAS unsigned char* lds;
    int vcu, G;
    const float *x, *c, *mod_w, *mod_b, *norm_w, *w_gate, *w_up, *w_down, *hy_w_in, *conv_w, *conv_b, *A_log, *dt_bias, *ssd_D, *ssd_norm_w, *ret_norm_w, *hy_w_out, *dsa_w_in, *idx_k_norm_w, *dsa_w_out;
    const int* positions;
    float* out;
    unsigned char* ws;
};
#define WSP(T, off) ((T*)(F.ws + (off)))

__device__ __forceinline__ void tr_item(const float* W, int ldn, int K, int k0, int sc, int ncl, bf16* WT, int dr, LAS float* scr, int lane) {
    int cc = sc + (lane & 31); cc = cc < ncl ? cc : ncl - 1;
#pragma unroll 8
    for (int i = 0; i < 32; ++i) { const int kk = 2 * i + (lane >> 5); scr[kk * 33 + (lane & 31)] = W[(size_t)(k0 + kk) * ldn + cc]; }
    LDS_WAIT(); asm volatile("" ::: "memory");
    const int c = lane & 7;
#pragma unroll
    for (int j = 0; j < 4; ++j) { const int n = (lane >> 3) + 8 * j; const LAS float* s = scr + (8 * c) * 33 + n;
        v4u o; o.x = pk2(s[0 * 33], s[1 * 33]); o.y = pk2(s[2 * 33], s[3 * 33]); o.z = pk2(s[4 * 33], s[5 * 33]); o.w = pk2(s[6 * 33], s[7 * 33]);
        *(GAS v4u*)(WT + (size_t)(dr + n) * K + k0 + 8 * c) = o; }
    LDS_WAIT(); asm volatile("" ::: "memory");
}
__device__ __forceinline__ int in0_dst_col(int sc) {
    if (sc < 6144) return sc;
    if (sc < 6176) return 14336 + (sc - 6144);
    return sc - 32;
}
__device__ __forceinline__ void p0_prologue(Frame& F) {
    int tid_ = threadIdx.x; asm volatile("" : "+v"(tid_)); const int TID = tid_, LANE = TID & 63, WAVE = __builtin_amdgcn_readfirstlane(TID >> 6); (void)LANE; (void)WAVE;

    {
        LAS float* cond = (LAS float*)F.lds;
        LAS float* red = (LAS float*)(F.lds + 32768);
        for (int i = TID; i < NB * D; i += NWAVES * 64) cond[i] = silu(F.c[i]);
        __syncthreads();
        float* MODS = WSP(float, WS_MODS);
        for (int u = F.vcu; u < 256; u += F.G) {
            const int col0 = 144 * u, layer = col0 / MODW, j0 = col0 % MODW;
            const int cq = TID % 36, ks = TID / 36;
            if (ks < 14) {
                f32x4 a0 = {0.f, 0.f, 0.f, 0.f}, a1 = a0, a2 = a0, a3 = a0;
                const int kb = ks * 147, ke = (kb + 147 < D) ? kb + 147 : D;
                const float* wp = F.mod_w + (size_t)layer * D * MODW + j0 + 4 * cq;
#pragma unroll 4
                for (int k = kb; k < ke; ++k) { const f32x4 w = *(const f32x4*)(wp + (size_t)k * MODW);
                    a0 += cond[k] * w; a1 += cond[D + k] * w; a2 += cond[2 * D + k] * w; a3 += cond[3 * D + k] * w; }
                LAS float* r = red + (ks * 36 + cq) * 16;
                *(LAS f32x4*)(r) = a0; *(LAS f32x4*)(r + 4) = a1; *(LAS f32x4*)(r + 8) = a2; *(LAS f32x4*)(r + 12) = a3;
            }
            __syncthreads();
            for (int o = TID; o < 576; o += NWAVES * 64) { const int cq2 = o / 16, r = o % 16, b = r / 4, e = r % 4; float s = 0.f;
#pragma unroll
                for (int k2 = 0; k2 < 14; ++k2) s += red[(k2 * 36 + cq2) * 16 + r];
                const int j = j0 + 4 * cq2 + e;
                MODS[(size_t)(layer * 4 + b) * MODW + j] = s + F.mod_b[layer * MODW + j]; }
            __syncthreads();
        }
    }
    {
        const int gt = F.vcu * NWAVES * 64 + TID, NT = F.G * NWAVES * 64;
        const double INV2PI = 0.15915494309189535;
        float* rc = WSP(float, WS_RTC); float* rs = WSP(float, WS_RTS);
        for (int idx = gt; idx < M * 128; idx += NT) { const int row = idx >> 7, i = idx & 127;
            const double inv = exp2(-(double)i * (13.287712379549449 / 128.0));
            const double rev = (double)F.positions[row] * inv * INV2PI; const float fr = (float)(rev - rint(rev));
            rc[idx] = __builtin_amdgcn_cosf(fr); rs[idx] = __builtin_amdgcn_sinf(fr); }
        float* qc = WSP(float, WS_RTQ); float* qs = qc + M * 16;
        for (int idx = gt; idx < M * 16; idx += NT) { const int row = idx >> 4, i = idx & 15;
            const double inv = exp2(-(double)i * (18.931568569324174 / 16.0));
            const double rev = (double)F.positions[row] * inv * INV2PI; const float fr = (float)(rev - rint(rev));
            qc[idx] = __builtin_amdgcn_cosf(fr); qs[idx] = __builtin_amdgcn_sinf(fr); }
        float* ic = WSP(float, WS_RTI); float* is = ic + M * 8;
        for (int idx = gt; idx < M * 8; idx += NT) { const int row = idx >> 3, i = idx & 7;
            const double inv = exp2(-(double)i * (18.931568569324174 / 8.0));
            const double rev = (double)F.positions[row] * inv * INV2PI; const float fr = (float)(rev - rint(rev));
            ic[idx] = __builtin_amdgcn_cosf(fr); is[idx] = __builtin_amdgcn_sinf(fr); }
    }
    {
        LAS float* scr = (LAS float*)(F.lds + WAVE * 8448);
        const int gw = F.vcu * NWAVES + WAVE, NGW = F.G * NWAVES;
        constexpr int I_G = 32 * 176, I_D = 88 * 64, I_FFN = 2 * I_G + I_D;
        constexpr int I_IN0 = 32 * 449, I_OUT0 = 64 * 64, I_IN1 = 32 * 107, I_OUT1 = 32 * 64;
        constexpr int NITEMS = 4 * I_FFN + I_IN0 + I_OUT0 + I_IN1 + I_OUT1;
        bf16* Wgu = WSP(bf16, WS_WGU); bf16* Wd = WSP(bf16, WS_WD);
        for (int it = gw; it < NITEMS; it += NGW) {
            int r = it;
            if (r < 4 * I_FFN) { const int s = r / I_FFN; r -= s * I_FFN;
                if (r < 2 * I_G) { const int up = r / I_G; r -= up * I_G; const int kb = r / 176, nb = r % 176, sc = 32 * nb;
                    const float* W = (up ? F.w_up : F.w_gate) + (size_t)s * D * FF;
                    tr_item(W, FF, D, 64 * kb, sc, FF, Wgu + (size_t)s * WGU_ELEMS, 256 * (sc / 128) + 128 * up + (sc % 128), scr, LANE); }
                else { r -= 2 * I_G; const int kb = r / 64, nb = r % 64;
                    tr_item(F.w_down + (size_t)s * FF * D, D, FF, 64 * kb, 32 * nb, D, Wd + (size_t)s * WD_ELEMS, 32 * nb, scr, LANE); }
                continue; }
            r -= 4 * I_FFN;
            if (r < I_IN0) { const int kb = r / 449, nb = r % 449, sc = 32 * nb; tr_item(F.hy_w_in, IN0, D, 64 * kb, sc, IN0, WSP(bf16, WS_WIN0), in0_dst_col(sc), scr, LANE); continue; }
            r -= I_IN0;
            if (r < I_OUT0) { const int kb = r / 64, nb = r % 64; tr_item(F.hy_w_out, D, 2 * D, 64 * kb, 32 * nb, D, WSP(bf16, WS_WOUT0), 32 * nb, scr, LANE); continue; }
            r -= I_OUT0;
            if (r < I_IN1) { const int kb = r / 107, nb = r % 107; tr_item(F.dsa_w_in, IN1, D, 64 * kb, 32 * nb, IN1, WSP(bf16, WS_WIN1), 32 * nb, scr, LANE); continue; }
            r -= I_IN1;
            { const int kb = r / 64, nb = r % 64; tr_item(F.dsa_w_out, D, D, 64 * kb, 32 * nb, D, WSP(bf16, WS_WOUT1), 32 * nb, scr, LANE); }
        }
    }
}

__device__ __forceinline__ void thin_phase(Frame& F, int prevq, int nextq) {
    int tid_ = threadIdx.x; asm volatile("" : "+v"(tid_)); const int TID = tid_, LANE = TID & 63, WAVE = __builtin_amdgcn_readfirstlane(TID >> 6);
    const int gw = F.vcu * NWAVES + WAVE, NGW = F.G * NWAVES;
    const float* xin = (prevq <= 0) ? F.x : F.out;
    const bf16* Y = WSP(bf16, WS_Y); const float* SSQ = WSP(float, WS_SSQ); const float* MODS = WSP(float, WS_MODS); bf16* H = WSP(bf16, WS_H);
    for (int rg = gw; rg < M / 2; rg += NGW) {
        const int row0 = rg * 2, b = row0 >> 11;
        f32x4 xv[2][8];
#pragma unroll
        for (int rr = 0; rr < 2; ++rr) { const f32x4* xr = (const f32x4*)(xin + (size_t)(row0 + rr) * D) + LANE;
#pragma unroll
            for (int j = 0; j < 8; ++j) xv[rr][j] = xr[64 * j]; }
        if (prevq >= 0) {
            const int pl = prevq / 3, pj = prevq % 3; const float rw = (pj == 1) ? 1.0f : 0.5f;
            float sc[2];
#pragma unroll
            for (int rr = 0; rr < 2; ++rr) { float s = (LANE < 32) ? SSQ[(size_t)(row0 + rr) * 32 + LANE] : 0.f; s = wave_sum(s); sc[rr] = rw * rsqrtf(s * (1.0f / D) + EPS); }
            const f32x4* pw = (const f32x4*)(F.norm_w + (size_t)(pl * 6 + 2 * pj + 1) * D) + LANE;
            const f32x4* gt = (const f32x4*)(MODS + (size_t)(pl * 4 + b) * MODW + (3 * pj + 2) * D) + LANE;
#pragma unroll
            for (int j = 0; j < 8; ++j) { const f32x4 gp = gt[64 * j] * pw[64 * j];
#pragma unroll
                for (int rr = 0; rr < 2; ++rr) { const unsigned long long yy = *((const unsigned long long*)(Y + (size_t)(row0 + rr) * D) + LANE + 64 * j); const unsigned y0 = (unsigned)yy, y1 = (unsigned)(yy >> 32);
                    const f32x4 yv = {bflo(y0), bfhi(y0), bflo(y1), bfhi(y1)};
                    xv[rr][j] = xv[rr][j] + sc[rr] * (gp * yv); *((f32x4*)(F.out + (size_t)(row0 + rr) * D) + LANE + 64 * j) = xv[rr][j]; }
                if (j & 1) asm volatile("" ::: "memory"); }
        }
        if (nextq >= 0) {
            const int nl = nextq / 3, nj = nextq % 3;
            float rstd[2];
#pragma unroll
            for (int rr = 0; rr < 2; ++rr) { float s = 0.f;
#pragma unroll
                for (int j = 0; j < 8; ++j) s += (xv[rr][j].x * xv[rr][j].x + xv[rr][j].y * xv[rr][j].y) + (xv[rr][j].z * xv[rr][j].z + xv[rr][j].w * xv[rr][j].w);
                rstd[rr] = rsqrtf(wave_sum(s) * (1.0f / D) + EPS); }
            const f32x4* pw = (const f32x4*)(F.norm_w + (size_t)(nl * 6 + 2 * nj) * D) + LANE;
            const f32x4* sh = (const f32x4*)(MODS + (size_t)(nl * 4 + b) * MODW + (3 * nj) * D) + LANE;
            const f32x4* scp = (const f32x4*)(MODS + (size_t)(nl * 4 + b) * MODW + (3 * nj + 1) * D) + LANE;
#pragma unroll
            for (int j = 0; j < 8; ++j) { const f32x4 ps = pw[64 * j] * (scp[64 * j] + 1.0f), sv = sh[64 * j];
#pragma unroll
                for (int rr = 0; rr < 2; ++rr) { const f32x4 h = (xv[rr][j] * rstd[rr]) * ps + sv;
                    *((unsigned long long*)(H + (size_t)(row0 + rr) * D) + LANE + 64 * j) = (unsigned long long)pk2(h.x, h.y) | ((unsigned long long)pk2(h.z, h.w) << 32); }
                if (j & 1) asm volatile("" ::: "memory"); }
        }
    }
}

typedef float f32x16 __attribute__((ext_vector_type(16)));
typedef float f32x2v __attribute__((ext_vector_type(2)));
typedef __bf16 bf16x2v __attribute__((ext_vector_type(2)));
__device__ __forceinline__ unsigned pkbf(float lo, float hi) { return __builtin_bit_cast(unsigned, __builtin_convertvector((f32x2v){lo, hi}, bf16x2v)); }
#define MFMA32(a, b, c) __builtin_amdgcn_mfma_f32_32x32x16_bf16((a), (b), (c), 0, 0, 0)
template <int S> __device__ __forceinline__ bf16x8 pack8(const f32x16& x) {
    v4u p; p.x = pkbf(x[8 * S + 0], x[8 * S + 1]); p.y = pkbf(x[8 * S + 2], x[8 * S + 3]); p.z = pkbf(x[8 * S + 4], x[8 * S + 5]); p.w = pkbf(x[8 * S + 6], x[8 * S + 7]);
    return __builtin_bit_cast(bf16x8, p);
}
__device__ __forceinline__ f32x16 zero16() { f32x16 z;
#pragma unroll
    for (int i = 0; i < 16; ++i) z[i] = 0.f;
    return z; }
struct IdFrag { bf16x8 f0, f1; };
__device__ __forceinline__ IdFrag make_id(int r, int hh) { IdFrag I;
#pragma unroll
    for (int j = 0; j < 8; ++j) { I.f0[j] = (r == 8 * hh + j) ? (short)0x3F80 : (short)0; I.f1[j] = (r == 16 + 8 * hh + j) ? (short)0x3F80 : (short)0; }
    return I; }
__device__ __forceinline__ bf16x8 lfrag(const LAS unsigned char* img, int stride, int row, int col) { return *(const LAS bf16x8*)(img + row * stride + col * 2); }
__device__ __forceinline__ f32x16 to_acc_lds(const LAS unsigned char* img, int stride, int row0, int col0, int r, int hh, const IdFrag& I) {
    f32x16 x = MFMA32(lfrag(img, stride, row0 + r, col0 + 8 * hh), I.f0, zero16());
    return MFMA32(lfrag(img, stride, row0 + r, col0 + 16 + 8 * hh), I.f1, x);
}
__device__ __forceinline__ f32x16 to_acc_glb(const bf16* base, size_t ld, int r, int hh, const IdFrag& I) {
    f32x16 x = MFMA32(*(const bf16x8*)(base + (size_t)r * ld + 8 * hh), I.f0, zero16());
    return MFMA32(*(const bf16x8*)(base + (size_t)r * ld + 16 + 8 * hh), I.f1, x);
}
__device__ __forceinline__ int crow(int i, int hh) { return (i & 3) + 8 * (i >> 2) + 4 * hh; }

constexpr int XS_STRIDE = 528, BC_STRIDE = 272;
constexpr int L0_XS = 0, L0_BM = 128 * XS_STRIDE, L0_CM = L0_BM + 128 * BC_STRIDE, L0_TAB = L0_CM + 128 * BC_STRIDE;
constexpr int L0_K = 0, L0_V = 128 * XS_STRIDE, L0_Q = 128 * XS_STRIDE, L0_RS = 2 * 128 * XS_STRIDE;
static_assert(L0_TAB + 3 * 2048 <= LDSCTL_OFF && L0_RS + 4096 + 512 <= LDSCTL_OFF, "LDS map (layer-0 mixer)");

__device__ __forceinline__ void stage_conv(Frame& F, int TID, size_t R0, int g, bool withC) {
    const int ci = TID & 63, rg = TID >> 6;
    if (!withC && ci >= 48) return;
    const int xc = ci < 32 ? g * 256 + 8 * ci : (ci < 48 ? 2048 + g * 128 + 8 * (ci - 32) : 3072 + g * 128 + 8 * (ci - 48));
    LAS unsigned char* dst = F.lds + (ci < 32 ? L0_XS + ci * 16 : (ci < 48 ? L0_BM + (ci - 32) * 16 : L0_CM + (ci - 48) * 16));
    const int dstride = ci < 32 ? XS_STRIDE : BC_STRIDE;
    float w[4][8], a0[8];
#pragma unroll
    for (int j = 0; j < 4; ++j) { const f32x4 p = *(const f32x4*)(F.conv_w + (size_t)j * 4096 + xc), q = *(const f32x4*)(F.conv_w + (size_t)j * 4096 + xc + 4);
        w[j][0] = p.x; w[j][1] = p.y; w[j][2] = p.z; w[j][3] = p.w; w[j][4] = q.x; w[j][5] = q.y; w[j][6] = q.z; w[j][7] = q.w; }
    { const f32x4 p = *(const f32x4*)(F.conv_b + xc), q = *(const f32x4*)(F.conv_b + xc + 4); a0[0] = p.x; a0[1] = p.y; a0[2] = p.z; a0[3] = p.w; a0[4] = q.x; a0[5] = q.y; a0[6] = q.z; a0[7] = q.w; }
    const bf16* src = WSP(bf16, WS_BIG) + (R0 + rg * 16) * IN0P + 2048 + xc;
    const int t0 = (int)(R0 & (SEQ - 1)) + rg * 16;
    float h[3][8];
#pragma unroll
    for (int k = 0; k < 3; ++k) { v4u u = {0u, 0u, 0u, 0u}; if (t0 - 3 + k >= 0) u = *(const v4u*)(src + (ptrdiff_t)(k - 3) * IN0P);
        h[k][0] = bflo(u.x); h[k][1] = bfhi(u.x); h[k][2] = bflo(u.y); h[k][3] = bfhi(u.y); h[k][4] = bflo(u.z); h[k][5] = bfhi(u.z); h[k][6] = bflo(u.w); h[k][7] = bfhi(u.w); }
#pragma unroll 4
    for (int i = 0; i < 16; ++i) { const v4u u = *(const v4u*)(src + (size_t)i * IN0P);
        const float c[8] = {bflo(u.x), bfhi(u.x), bflo(u.y), bfhi(u.y), bflo(u.z), bfhi(u.z), bflo(u.w), bfhi(u.w)};
        float o[8];
#pragma unroll
        for (int e = 0; e < 8; ++e) { o[e] = silu(a0[e] + w[0][e] * h[0][e] + w[1][e] * h[1][e] + w[2][e] * h[2][e] + w[3][e] * c[e]); h[0][e] = h[1][e]; h[1][e] = h[2][e]; h[2][e] = c[e]; }
        v4u p; p.x = pkbf(o[0], o[1]); p.y = pkbf(o[2], o[3]); p.z = pkbf(o[4], o[5]); p.w = pkbf(o[6], o[7]);
        *(LAS v4u*)(dst + (rg * 16 + i) * dstride) = p; }
}
__device__ __forceinline__ void ssd_tables(Frame& F, int TID, int LANE, int WAVE, LAS float* tab, size_t R0, int g, float* cd) {
    LAS float* cuml = tab; LAS float* dtl = tab + 512; LAS float* wl = tab + 1024;
    { const int row = TID >> 2, hd = TID & 3, h2 = g * 4 + hd; const float v = WSP(float, WS_DTB)[(R0 + row) * 256 + h2] + F.dt_bias[h2];
      const float dt = v > 20.f ? v : log1pf(__expf(v)); dtl[hd * 128 + row] = dt; wl[hd * 128 + row] = -dt * __expf(F.A_log[h2]); }
    __syncthreads();
    if (WAVE < 4) { const float a0 = wl[WAVE * 128 + 2 * LANE], a1 = wl[WAVE * 128 + 2 * LANE + 1]; float p = a0 + a1;
#pragma unroll
        for (int o = 1; o < 64; o <<= 1) { const float t = __shfl_up(p, o); if (LANE >= o) p += t; }
        const float tot = __shfl(p, 63), c0 = p - a1;
        cuml[WAVE * 128 + 2 * LANE] = c0; cuml[WAVE * 128 + 2 * LANE + 1] = p;
        wl[WAVE * 128 + 2 * LANE] = dtl[WAVE * 128 + 2 * LANE] * __expf(tot - c0); wl[WAVE * 128 + 2 * LANE + 1] = dtl[WAVE * 128 + 2 * LANE + 1] * __expf(tot - p);
        if (cd != nullptr && LANE == 0) cd[WAVE] = __expf(tot); }
    __syncthreads();
}
__device__ __forceinline__ void m0_states(Frame& F) {
    int tid_ = threadIdx.x; asm volatile("" : "+v"(tid_)); const int TID = tid_, LANE = TID & 63, WAVE = __builtin_amdgcn_readfirstlane(TID >> 6);
    const int r_ = LANE & 31, hh_ = LANE >> 5; const IdFrag I = make_id(r_, hh_);
    for (int u = F.vcu; u < 1024; u += F.G) {
        __syncthreads();
        int r = r_, hh = hh_; asm volatile("" : "+v"(r), "+v"(hh));
        if (u < 512) {
            const int bc = u >> 3, g = u & 7; const size_t R0 = (size_t)bc * 128;
            stage_conv(F, TID, R0, g, false);
            LAS float* tab = (LAS float*)(F.lds + L0_TAB);
            ssd_tables(F, TID, LANE, WAVE, tab, R0, g, WSP(float, WS_CD) + bc * 32 + g * 4);
            const LAS float* wl = tab + 1024;
            const int head = WAVE >> 1, pt = WAVE & 1;
            f32x16 acc[4];
#pragma unroll
            for (int t = 0; t < 4; ++t) acc[t] = zero16();
#pragma unroll 1
            for (int sb = 0; sb < 4; ++sb) {
                f32x16 X = to_acc_lds(F.lds + L0_XS, XS_STRIDE, sb * 32, head * 64 + pt * 32, r, hh, I);
#pragma unroll
                for (int g4 = 0; g4 < 4; ++g4) { const f32x4 wv = *(const LAS f32x4*)(wl + head * 128 + sb * 32 + 8 * g4 + 4 * hh);
#pragma unroll
                    for (int e = 0; e < 4; ++e) X[4 * g4 + e] *= wv[e]; }
                const bf16x8 A0 = pack8<0>(X), A1 = pack8<1>(X);
#pragma unroll
                for (int nt = 0; nt < 4; ++nt) { const f32x16 XB = to_acc_lds(F.lds + L0_BM, BC_STRIDE, sb * 32, nt * 32, r, hh, I);
                    acc[nt] = MFMA32(A0, pack8<0>(XB), acc[nt]); acc[nt] = MFMA32(A1, pack8<1>(XB), acc[nt]); }
            }
            float* dst = WSP(float, WS_SST) + ((size_t)(bc * 32 + g * 4 + head) * 64 + pt * 32) * 128;
#pragma unroll
            for (int nt = 0; nt < 4; ++nt)
#pragma unroll
                for (int i = 0; i < 16; ++i) dst[(size_t)crow(i, hh) * 128 + nt * 32 + r] = acc[nt][i];
        } else {
            const int u2 = u - 512, bc = u2 >> 3, h = u2 & 7; const size_t R0 = (size_t)bc * 128;
            const bf16* PB = WSP(bf16, WS_BIG);
            for (int i = TID; i < 4096; i += NWAVES * 64) { const int row = i >> 5, ch = i & 31;
                *(LAS v4u*)(F.lds + L0_K + row * XS_STRIDE + ch * 16) = *(const v4u*)(PB + (R0 + row) * IN0P + 8192 + h * 256 + ch * 8);
                *(LAS v4u*)(F.lds + L0_V + row * XS_STRIDE + ch * 16) = *(const v4u*)(PB + (R0 + row) * IN0P + 10240 + h * 256 + ch * 8); }
            __syncthreads();
            const float lg = log2f(1.0f - exp2f(-5.0f - (float)h));
            float* dstb = WSP(float, WS_RST) + ((size_t)(bc * 8 + h) * 256 + WAVE * 32) * 256;
#pragma unroll 1
            for (int half = 0; half < 2; ++half) {
                f32x16 acc[4];
#pragma unroll
                for (int t = 0; t < 4; ++t) acc[t] = zero16();
#pragma unroll 1
                for (int sb = 0; sb < 4; ++sb) {
                    const f32x16 XV = to_acc_lds(F.lds + L0_V, XS_STRIDE, sb * 32, WAVE * 32, r, hh, I);
                    const bf16x8 A0 = pack8<0>(XV), A1 = pack8<1>(XV);
#pragma unroll
                    for (int t = 0; t < 4; ++t) { f32x16 XK = to_acc_lds(F.lds + L0_K, XS_STRIDE, sb * 32, (half * 4 + t) * 32, r, hh, I);
#pragma unroll
                        for (int i = 0; i < 16; ++i) XK[i] *= exp2f((float)(127 - (sb * 32 + crow(i, hh))) * lg);
                        acc[t] = MFMA32(A0, pack8<0>(XK), acc[t]); acc[t] = MFMA32(A1, pack8<1>(XK), acc[t]); }
                }
#pragma unroll
                for (int t = 0; t < 4; ++t)
#pragma unroll
                    for (int i = 0; i < 16; ++i) dstb[(size_t)crow(i, hh) * 256 + (half * 4 + t) * 32 + r] = acc[t][i];
            }
        }
    }
}
__device__ __forceinline__ void m0_chunkscan(Frame& F) {
    int tid_ = threadIdx.x; asm volatile("" : "+v"(tid_)); const int TID = tid_;
    const int gt = F.vcu * NWAVES * 64 + TID, NT = F.G * NWAVES * 64;
    const float* SST = WSP(float, WS_SST); const float* CD = WSP(float, WS_CD); bf16* HP = WSP(bf16, WS_HP);
    for (int idx = gt; idx < NB * 32 * 64 * 32; idx += NT) {
        const int b = idx >> 16, rem = idx & 65535, h = rem >> 11;
        f32x4 st = {0.f, 0.f, 0.f, 0.f};
        for (int c = 0; c < 16; ++c) { const size_t off = ((size_t)((b * 16 + c) * 32) * 2048 + rem) * 4;
            *(unsigned long long*)(HP + off) = (unsigned long long)pkbf(st.x, st.y) | ((unsigned long long)pkbf(st.z, st.w) << 32);
            const float a = CD[(b * 16 + c) * 32 + h]; st = st * a + *(const f32x4*)(SST + off); }
    }
    const float* RST = WSP(float, WS_RST); bf16* RPT = WSP(bf16, WS_RPT);
    for (int idx = gt; idx < NB * 8 * 256 * 64; idx += NT) {
        const int b = idx >> 17, rem = idx & 131071, h = rem >> 14;
        const float gc = exp2f(128.0f * log2f(1.0f - exp2f(-5.0f - (float)h)));
        f32x4 st = {0.f, 0.f, 0.f, 0.f};
        for (int c = 0; c < 16; ++c) { const size_t off = ((size_t)((b * 16 + c) * 8) * 16384 + rem) * 4;
            *(unsigned long long*)(RPT + off) = (unsigned long long)pkbf(st.x, st.y) | ((unsigned long long)pkbf(st.z, st.w) << 32);
            st = st * gc + *(const f32x4*)(RST + off); }
    }
}
__device__ __forceinline__ void m0_out_ssd(Frame& F) {
    int tid_ = threadIdx.x; asm volatile("" : "+v"(tid_)); const int TID = tid_, LANE = TID & 63, WAVE = __builtin_amdgcn_readfirstlane(TID >> 6);
    const int r_ = LANE & 31, hh_ = LANE >> 5; const IdFrag I = make_id(r_, hh_);
    const bf16* PB = WSP(bf16, WS_BIG); bf16* MIX = WSP(bf16, WS_MIX);
    for (int u = F.vcu; u < 512; u += F.G) {
        __syncthreads();
        int r = r_, hh = hh_; asm volatile("" : "+v"(r), "+v"(hh));
        {
            const int bc = u >> 3, g = u & 7; const size_t R0 = (size_t)bc * 128;
            stage_conv(F, TID, R0, g, true);
            LAS float* tab = (LAS float*)(F.lds + L0_TAB);
            ssd_tables(F, TID, LANE, WAVE, tab, R0, g, nullptr);
            const int head = WAVE >> 1, pt = WAVE & 1, hd = g * 4 + head;
            const LAS float* cuml = tab + head * 128; const LAS float* dtl = tab + 512 + head * 128;
            const float Dh = F.ssd_D[hd];
            bf16x8 hpf[8];
            { const bf16* hp = WSP(bf16, WS_HP) + ((size_t)(bc * 32 + hd) * 64 + pt * 32 + r) * 128 + 8 * hh;
#pragma unroll
              for (int ks = 0; ks < 8; ++ks) hpf[ks] = *(const bf16x8*)(hp + 16 * ks); }
#pragma unroll 1
            for (int lt = 0; lt < 4; ++lt) {
                f32x16 y = zero16();
#pragma unroll
                for (int ks = 0; ks < 8; ++ks) y = MFMA32(lfrag(F.lds + L0_CM, BC_STRIDE, lt * 32 + r, 16 * ks + 8 * hh), hpf[ks], y);
#pragma unroll
                for (int i = 0; i < 16; ++i) y[i] *= __expf(cuml[lt * 32 + crow(i, hh)]);
                const float cl = cuml[lt * 32 + r];
                f32x16 XS = zero16();
#pragma unroll 1
                for (int st = 0; st <= lt; ++st) {
                    f32x16 cbt = zero16();
#pragma unroll
                    for (int ks = 0; ks < 8; ++ks) cbt = MFMA32(lfrag(F.lds + L0_BM, BC_STRIDE, st * 32 + r, 16 * ks + 8 * hh), lfrag(F.lds + L0_CM, BC_STRIDE, lt * 32 + r, 16 * ks + 8 * hh), cbt);
#pragma unroll
                    for (int g4 = 0; g4 < 4; ++g4) { const f32x4 cs = *(const LAS f32x4*)(cuml + st * 32 + 8 * g4 + 4 * hh), ds = *(const LAS f32x4*)(dtl + st * 32 + 8 * g4 + 4 * hh);
#pragma unroll
                        for (int e = 0; e < 4; ++e) { const int s = st * 32 + 8 * g4 + 4 * hh + e; const float v = cbt[4 * g4 + e] * __expf(cl - cs[e]) * ds[e]; cbt[4 * g4 + e] = (s <= lt * 32 + r) ? v : 0.f; } }
                    XS = to_acc_lds(F.lds + L0_XS, XS_STRIDE, st * 32, head * 64 + pt * 32, r, hh, I);
                    y = MFMA32(pack8<0>(cbt), pack8<0>(XS), y); y = MFMA32(pack8<1>(cbt), pack8<1>(XS), y);
                }
                const f32x16 Z = to_acc_glb(PB + (R0 + lt * 32) * IN0P + hd * 64 + pt * 32, IN0P, r, hh, I);
                bf16* dst = MIX + (R0 + lt * 32) * 4096 + hd * 64 + pt * 32 + r;
#pragma unroll
                for (int i = 0; i < 16; ++i) { const float v = (y[i] + Dh * XS[i]) * silu(Z[i]); dst[(size_t)crow(i, hh) * 4096] = (bf16)(pkbf(v, v) & 0xffffu); }
            }
        }
    }
    __syncthreads();
}
__device__ __forceinline__ void m0_out_ret(Frame& F) {
    int tid_ = threadIdx.x; asm volatile("" : "+v"(tid_)); const int TID = tid_, LANE = TID & 63, WAVE = __builtin_amdgcn_readfirstlane(TID >> 6);
    const int r_ = LANE & 31, hh_ = LANE >> 5; const IdFrag I = make_id(r_, hh_);
    const bf16* PB = WSP(bf16, WS_BIG); bf16* MIX = WSP(bf16, WS_MIX);
    for (int u = 512 + F.vcu; u < 1024; u += F.G) {
        __syncthreads();
        int r = r_, hh = hh_; asm volatile("" : "+v"(r), "+v"(hh));
        const int u2 = u - 512, bc = u2 >> 3, h = u2 & 7; const size_t R0 = (size_t)bc * 128;
        for (int i = TID; i < 4096; i += NWAVES * 64) { const int row = i >> 5, ch = i & 31;
            *(LAS v4u*)(F.lds + L0_K + row * XS_STRIDE + ch * 16) = *(const v4u*)(PB + (R0 + row) * IN0P + 8192 + h * 256 + ch * 8);
            *(LAS v4u*)(F.lds + L0_Q + row * XS_STRIDE + ch * 16) = *(const v4u*)(PB + (R0 + row) * IN0P + 6144 + h * 256 + ch * 8); }
        __syncthreads();
        const float lg = log2f(1.0f - exp2f(-5.0f - (float)h));
        const int dv0 = WAVE * 32;
        f32x16 y[4];
        {
            const bf16* rpt = WSP(bf16, WS_RPT) + ((size_t)(bc * 8 + h) * 256 + dv0 + r) * 256 + 8 * hh;
#pragma unroll
            for (int lt = 0; lt < 4; ++lt) y[lt] = zero16();
#pragma unroll 2
            for (int ks = 0; ks < 16; ++ks) { const bf16x8 rf = *(const bf16x8*)(rpt + 16 * ks);
#pragma unroll
                for (int lt = 0; lt < 4; ++lt) y[lt] = MFMA32(lfrag(F.lds + L0_Q, XS_STRIDE, lt * 32 + r, 16 * ks + 8 * hh), rf, y[lt]); }
#pragma unroll
            for (int lt = 0; lt < 4; ++lt)
#pragma unroll
                for (int i = 0; i < 16; ++i) y[lt][i] *= exp2f((float)(lt * 32 + crow(i, hh) + 1) * lg);
        }
#pragma unroll
        for (int lt = 0; lt < 4; ++lt) {
#pragma unroll 1
            for (int st = 0; st <= lt; ++st) {
                const f32x16 XV = to_acc_glb(PB + (R0 + st * 32) * IN0P + 10240 + h * 256 + dv0, IN0P, r, hh, I);
                f32x16 sct = zero16();
#pragma unroll 4
                for (int ks = 0; ks < 16; ++ks) sct = MFMA32(lfrag(F.lds + L0_K, XS_STRIDE, st * 32 + r, 16 * ks + 8 * hh), lfrag(F.lds + L0_Q, XS_STRIDE, lt * 32 + r, 16 * ks + 8 * hh), sct);
#pragma unroll
                for (int i = 0; i < 16; ++i) { const int d = (lt - st) * 32 + r - crow(i, hh); sct[i] = (d >= 0) ? sct[i] * exp2f((float)d * lg) : 0.f; }
                y[lt] = MFMA32(pack8<0>(sct), pack8<0>(XV), y[lt]); y[lt] = MFMA32(pack8<1>(sct), pack8<1>(XV), y[lt]);
            }
        }
        asm volatile("" : "+v"(r), "+v"(hh));
        LAS float* rsum = (LAS float*)(F.lds + L0_RS);
#pragma unroll
        for (int lt = 0; lt < 4; ++lt)
#pragma unroll
            for (int i = 0; i < 16; ++i) { float s = y[lt][i] * y[lt][i];
#pragma unroll
                for (int o = 1; o < 32; o <<= 1) s += __shfl_xor(s, o);
                if (r == 0) rsum[(lt * 32 + crow(i, hh)) * 8 + WAVE] = s; }
        __syncthreads();
        if (TID < 128) { const f32x4 s0 = *(const LAS f32x4*)(rsum + TID * 8), s1 = *(const LAS f32x4*)(rsum + TID * 8 + 4);
            rsum[1024 + TID] = rsqrtf((((s0.x + s0.y) + (s0.z + s0.w)) + ((s1.x + s1.y) + (s1.z + s1.w))) * (1.0f / 256.0f) + EPS); }
        __syncthreads();
        asm volatile("" : "+v"(r), "+v"(hh));
        const float w = F.ret_norm_w[h * 256 + dv0 + r];
#pragma unroll
        for (int lt = 0; lt < 4; ++lt) {
            const f32x16 G = to_acc_glb(PB + (R0 + lt * 32) * IN0P + 12288 + h * 256 + dv0, IN0P, r, hh, I);
            bf16* dst = MIX + (R0 + lt * 32) * 4096 + 2048 + h * 256 + dv0 + r;
#pragma unroll
            for (int i = 0; i < 16; ++i) { const float rstd = rsum[1024 + lt * 32 + crow(i, hh)];
                const float v = silu(G[i]) * (y[lt][i] * rstd * w); dst[(size_t)crow(i, hh) * 4096] = (bf16)(pkbf(v, v) & 0xffffu); }
        }
    }
    __syncthreads();
}
__device__ __forceinline__ void m0_post(Frame& F) {
    int tid_ = threadIdx.x; asm volatile("" : "+v"(tid_)); const int TID = tid_, LANE = TID & 63, WAVE = __builtin_amdgcn_readfirstlane(TID >> 6);
    const int gw = F.vcu * NWAVES + WAVE, NGW = F.G * NWAVES;
    bf16* MIX = WSP(bf16, WS_MIX);
    for (int row = gw; row < M; row += NGW) {
        v4u v[4]; float s = 0.f;
#pragma unroll
        for (int j = 0; j < 4; ++j) { v[j] = *(const v4u*)(MIX + (size_t)row * 4096 + 8 * LANE + 512 * j);
            const float a0 = bflo(v[j].x), a1 = bfhi(v[j].x), a2 = bflo(v[j].y), a3 = bfhi(v[j].y), a4 = bflo(v[j].z), a5 = bfhi(v[j].z), a6 = bflo(v[j].w), a7 = bfhi(v[j].w);
            s += ((a0 * a0 + a1 * a1) + (a2 * a2 + a3 * a3)) + ((a4 * a4 + a5 * a5) + (a6 * a6 + a7 * a7)); }
        const float rstd = rsqrtf(wave_sum(s) * (1.0f / 2048.0f) + EPS);
#pragma unroll
        for (int j = 0; j < 4; ++j) { const int c = 8 * LANE + 512 * j; const f32x4 w0 = *(const f32x4*)(F.ssd_norm_w + c), w1 = *(const f32x4*)(F.ssd_norm_w + c + 4);
            v4u o; o.x = pkbf(bflo(v[j].x) * rstd * w0.x, bfhi(v[j].x) * rstd * w0.y); o.y = pkbf(bflo(v[j].y) * rstd * w0.z, bfhi(v[j].y) * rstd * w0.w);
            o.z = pkbf(bflo(v[j].z) * rstd * w1.x, bfhi(v[j].z) * rstd * w1.y); o.w = pkbf(bflo(v[j].w) * rstd * w1.z, bfhi(v[j].w) * rstd * w1.w);
            *(v4u*)(MIX + (size_t)row * 4096 + c) = o; }
    }
}
__device__ __forceinline__ void split_store8(bf16* hi, bf16* lo, const float (&v)[8]) {
    v4u h, l; unsigned hw[4], lw[4];
#pragma unroll
    for (int e = 0; e < 4; ++e) { hw[e] = pkbf(v[2 * e], v[2 * e + 1]); lw[e] = pkbf(v[2 * e] - bflo(hw[e]), v[2 * e + 1] - bfhi(hw[e])); }
    h.x = hw[0]; h.y = hw[1]; h.z = hw[2]; h.w = hw[3]; l.x = lw[0]; l.y = lw[1]; l.z = lw[2]; l.w = lw[3];
    *(v4u*)hi = h; *(v4u*)lo = l;
}
__device__ __forceinline__ void m1_prep(Frame& F) {
    int tid_ = threadIdx.x; asm volatile("" : "+v"(tid_)); const int TID = tid_;
    const int gt = F.vcu * NWAVES * 64 + TID, NT = F.G * NWAVES * 64;
    const bf16* PB = WSP(bf16, WS_BIG); const float* IDX = WSP(float, WS_IDX);
    const float* qc = WSP(float, WS_RTQ); const float* qs = qc + M * 16; const float* ic = WSP(float, WS_RTI); const float* is = ic + M * 8;
    bf16* QA = WSP(bf16, WS_QA); bf16* KAb = WSP(bf16, WS_KAB); bf16* VAb = WSP(bf16, WS_VAB);
    for (int idx = gt; idx < M * 288; idx += NT) {
        const int row = idx / 288, ch = idx % 288, hd = ch >> 4, c = ch & 15;
        const bf16* src = PB + (size_t)row * 2304 + ch * 8;
        bf16* dst = hd < 16 ? QA + (size_t)row * 2048 + ch * 8 : (hd == 16 ? KAb + (size_t)row * 128 + c * 8 : VAb + (size_t)row * 128 + c * 8);
        if (hd == 17 || c >= 4) { *(v4u*)dst = *(const v4u*)src; continue; }
        if (c >= 2) continue;
        const v4u u1 = *(const v4u*)src, u2 = *(const v4u*)(src + 16);
        const float x1[8] = {bflo(u1.x), bfhi(u1.x), bflo(u1.y), bfhi(u1.y), bflo(u1.z), bfhi(u1.z), bflo(u1.w), bfhi(u1.w)};
        const float x2[8] = {bflo(u2.x), bfhi(u2.x), bflo(u2.y), bfhi(u2.y), bflo(u2.z), bfhi(u2.z), bflo(u2.w), bfhi(u2.w)};
        float o1[8], o2[8];
#pragma unroll
        for (int e = 0; e < 8; ++e) { const float cs = qc[row * 16 + c * 8 + e], sn = qs[row * 16 + c * 8 + e]; o1[e] = x1[e] * cs - x2[e] * sn; o2[e] = x1[e] * sn + x2[e] * cs; }
        v4u w1, w2; w1.x = pkbf(o1[0], o1[1]); w1.y = pkbf(o1[2], o1[3]); w1.z = pkbf(o1[4], o1[5]); w1.w = pkbf(o1[6], o1[7]);
        w2.x = pkbf(o2[0], o2[1]); w2.y = pkbf(o2[2], o2[3]); w2.z = pkbf(o2[4], o2[5]); w2.w = pkbf(o2[6], o2[7]);
        *(v4u*)dst = w1; *(v4u*)(dst + 16) = w2;
    }
    bf16* QIH = WSP(bf16, WS_QIH); bf16* QIL = WSP(bf16, WS_QIL);
    for (int idx = gt; idx < M * 128; idx += NT) {
        const int row = idx >> 7, ch = idx & 127, c = ch & 7;
        const float* src = IDX + (size_t)row * 1280 + ch * 8;
        if (c == 1) continue;
        float v[8]; { const f32x4 a = *(const f32x4*)src, b = *(const f32x4*)(src + 4); v[0] = a.x; v[1] = a.y; v[2] = a.z; v[3] = a.w; v[4] = b.x; v[5] = b.y; v[6] = b.z; v[7] = b.w; }
        if (c == 0) { float x2[8], o2[8]; { const f32x4 a = *(const f32x4*)(src + 8), b = *(const f32x4*)(src + 12); x2[0] = a.x; x2[1] = a.y; x2[2] = a.z; x2[3] = a.w; x2[4] = b.x; x2[5] = b.y; x2[6] = b.z; x2[7] = b.w; }
#pragma unroll
            for (int e = 0; e < 8; ++e) { const float cs = ic[row * 8 + e], sn = is[row * 8 + e]; const float x1 = v[e]; v[e] = x1 * cs - x2[e] * sn; o2[e] = x1 * sn + x2[e] * cs; }
            split_store8(QIH + (size_t)row * 1024 + ch * 8 + 8, QIL + (size_t)row * 1024 + ch * 8 + 8, o2); }
        split_store8(QIH + (size_t)row * 1024 + ch * 8, QIL + (size_t)row * 1024 + ch * 8, v);
    }
    bf16* KIH = WSP(bf16, WS_KIH); bf16* KIL = WSP(bf16, WS_KIL); float* WI = WSP(float, WS_WI);
    for (int row = gt; row < M; row += NT) {
        const float* si = IDX + (size_t)row * 1280 + 1024;
        float ss = 0.f;
#pragma unroll 4
        for (int i = 0; i < 64; i += 4) { const f32x4 a = *(const f32x4*)(si + i); ss += (a.x * a.x + a.y * a.y) + (a.z * a.z + a.w * a.w); }
        const float rstd = rsqrtf(ss * (1.0f / 64.0f) + EPS);
#pragma unroll 1
        for (int c = 0; c < 8; ++c) { if (c == 1) continue;
            float v[8];
#pragma unroll
            for (int e = 0; e < 8; ++e) v[e] = si[c * 8 + e] * rstd * F.idx_k_norm_w[c * 8 + e];
            if (c == 0) { float o2[8];
#pragma unroll
                for (int e = 0; e < 8; ++e) { const float x2 = si[8 + e] * rstd * F.idx_k_norm_w[8 + e], cs = ic[row * 8 + e], sn = is[row * 8 + e], x1 = v[e]; v[e] = x1 * cs - x2 * sn; o2[e] = x1 * sn + x2 * cs; }
                split_store8(KIH + (size_t)row * 64 + 8, KIL + (size_t)row * 64 + 8, o2); }
            split_store8(KIH + (size_t)row * 64 + c * 8, KIL + (size_t)row * 64 + c * 8, v); }
#pragma unroll
        for (int h4 = 0; h4 < 4; ++h4) { const f32x4 a = *(const f32x4*)(IDX + (size_t)row * 1280 + 1088 + 4 * h4); *(f32x4*)(WI + (size_t)row * 16 + 4 * h4) = a * 0.03125f; }
    }
}
__device__ __forceinline__ void m1_index(Frame& F) {
    int tid_ = threadIdx.x; asm volatile("" : "+v"(tid_)); const int TID = tid_, LANE = TID & 63, WAVE = __builtin_amdgcn_readfirstlane(TID >> 6);
    const int r = LANE & 31, hh = LANE >> 5;
    LAS unsigned* sc = (LAS unsigned*)(F.lds + WAVE * 16384);
    const int gw = F.vcu * NWAVES + WAVE, NGW = F.G * NWAVES;
    const bf16* QIH = WSP(bf16, WS_QIH); const bf16* QIL = WSP(bf16, WS_QIL); const bf16* KIH = WSP(bf16, WS_KIH); const bf16* KIL = WSP(bf16, WS_KIL);
    const float* WI = WSP(float, WS_WI); int* SEL = WSP(int, WS_SEL); int* NSEL = WSP(int, WS_NSEL);
    const unsigned long long ltmask = (1ull << LANE) - 1ull;
    for (int it = 0;; ++it) {
        int pr;
        if (NGW == 2048) { if (it >= 2) break; pr = it == 0 ? gw : 4095 - gw; } else { pr = gw + it * NGW; if (pr >= 4096) break; }
        const int row0 = 2 * pr, b = row0 >> 11, qp0 = row0 & (SEQ - 1);
        if (qp0 + 1 <= 255) {
#pragma unroll 1
            for (int qq = 0; qq < 2; ++qq) { const int nv = qp0 + qq + 1; for (int i = LANE; i < nv; i += 64) SEL[(size_t)(row0 + qq) * 256 + i] = i; if (LANE == 0) NSEL[row0 + qq] = nv; }
            continue; }
        bf16x8 Ah[4], Al[4];
        { const int qq = (r >> 2) & 1, hd = (r & 3) + 4 * (r >> 3); const size_t o = (size_t)(row0 + qq) * 1024 + hd * 64 + 8 * hh;
#pragma unroll
          for (int ks = 0; ks < 4; ++ks) { Ah[ks] = *(const bf16x8*)(QIH + o + 16 * ks); Al[ks] = *(const bf16x8*)(QIL + o + 16 * ks); } }
        float wv[16];
#pragma unroll
        for (int h4 = 0; h4 < 4; ++h4) { const f32x4 a = *(const f32x4*)(WI + (size_t)(row0 + hh) * 16 + 4 * h4); wv[4 * h4] = a.x; wv[4 * h4 + 1] = a.y; wv[4 * h4 + 2] = a.z; wv[4 * h4 + 3] = a.w; }
        const int ntile = (qp0 + 1) / 32 + 1;
        bf16x8 Bh[4], Bl[4];
        { const size_t ko = ((size_t)b * SEQ + r) * 64 + 8 * hh;
#pragma unroll
          for (int ks = 0; ks < 4; ++ks) { Bh[ks] = *(const bf16x8*)(KIH + ko + 16 * ks); Bl[ks] = *(const bf16x8*)(KIL + ko + 16 * ks); } }
#pragma unroll 1
        for (int kt = 0; kt < ntile; ++kt) {
            const int ktn = (kt + 1 < ntile) ? kt + 1 : kt;
            const size_t kon = ((size_t)b * SEQ + ktn * 32 + r) * 64 + 8 * hh;
            bf16x8 Nh[4], Nl[4];
#pragma unroll
            for (int ks = 0; ks < 4; ++ks) { Nh[ks] = *(const bf16x8*)(KIH + kon + 16 * ks); Nl[ks] = *(const bf16x8*)(KIL + kon + 16 * ks); }
            f32x16 acc = zero16();
#pragma unroll
            for (int ks = 0; ks < 4; ++ks) { acc = MFMA32(Ah[ks], Bh[ks], acc); acc = MFMA32(Ah[ks], Bl[ks], acc); acc = MFMA32(Al[ks], Bh[ks], acc); }
            float s = 0.f;
#pragma unroll
            for (int i = 0; i < 16; ++i) s += fmaxf(acc[i], 0.f) * wv[i];
            s += 0.0f;
            const int key = kt * 32 + r; const unsigned uu = __float_as_uint(s); const unsigned ok = (uu & 0x80000000u) ? ~uu : (uu | 0x80000000u);
            sc[hh * 2048 + key] = (key <= qp0 + hh) ? ok : 0u;
#pragma unroll
            for (int ks = 0; ks < 4; ++ks) { Bh[ks] = Nh[ks]; Bl[ks] = Nl[ks]; }
        }
        if (ntile & 1) sc[hh * 2048 + ntile * 32 + r] = 0u;
        asm volatile("s_waitcnt lgkmcnt(0)" ::: "memory");
#pragma unroll 1
        for (int qq = 0; qq < 2; ++qq) {
            const int nv = qp0 + qq + 1, nj = (nv + 63) >> 6; const int row = row0 + qq;
            unsigned vals[32];
#pragma unroll
            for (int j = 0; j < 32; ++j) vals[j] = (j < nj) ? sc[qq * 2048 + j * 64 + LANE] : 0u;
            unsigned prefix = 0u; bool exact = false;
#pragma unroll 1
            for (int bit = 31; bit >= 0; --bit) { const unsigned cand = prefix | (1u << bit); int cnt = 0;
#pragma unroll
                for (int j = 0; j < 32; ++j) cnt += __popcll(__ballot(vals[j] >= cand));
                if (cnt >= 256) prefix = cand;
                if (cnt == 256) { exact = true; break; } }
            const unsigned T = exact ? prefix - 1u : prefix;
            int base = 0;
#pragma unroll
            for (int j = 0; j < 32; ++j) { const bool p = vals[j] > T; const unsigned long long mk = __ballot(p);
                if (p) SEL[(size_t)row * 256 + base + __popcll(mk & ltmask)] = j * 64 + LANE; base += __popcll(mk); }
            if (!exact) { int need = 256 - base;
#pragma unroll
                for (int j = 0; j < 32; ++j) { const bool p = vals[j] == T; const unsigned long long mk = __ballot(p); const int rank = __popcll(mk & ltmask);
                    if (p && rank < need) SEL[(size_t)row * 256 + base + rank] = j * 64 + LANE;
                    const int c = __popcll(mk); const int take = c < need ? c : need; base += take; need -= take; } }
            if (LANE == 0) NSEL[row] = 256;
        }
    }
}
__device__ __forceinline__ void m1_attn(Frame& F) {
    int tid_ = threadIdx.x; asm volatile("" : "+v"(tid_)); const int TID = tid_, LANE = TID & 63, WAVE = __builtin_amdgcn_readfirstlane(TID >> 6);
    const int r_ = LANE & 31, hh_ = LANE >> 5; const IdFrag I = make_id(r_, hh_);
    const int gw = F.vcu * NWAVES + WAVE, NGW = F.G * NWAVES;
    const bf16* QA = WSP(bf16, WS_QA); const bf16* KAb = WSP(bf16, WS_KAB); const bf16* VAb = WSP(bf16, WS_VAB); const int* SEL = WSP(int, WS_SEL); const int* NSEL = WSP(int, WS_NSEL); bf16* MIX = WSP(bf16, WS_MIX);
#pragma unroll 1
    for (int q = gw; q < M; q += NGW) {
        int r = r_, hh = hh_; asm volatile("" : "+v"(r), "+v"(hh));
        const int b = q >> 11, nsel = NSEL[q], ntile = (nsel + 31) >> 5;
        bf16x8 qf[8];
#pragma unroll
        for (int ks = 0; ks < 8; ++ks) qf[ks] = *(const bf16x8*)(QA + (size_t)q * 2048 + (r & 15) * 128 + 16 * ks + 8 * hh);
        float mx = -3.0e38f, sum = 0.f;
        f32x16 o[4];
#pragma unroll
        for (int dt = 0; dt < 4; ++dt) o[dt] = zero16();
#pragma unroll 1
        for (int kt = 0; kt < ntile; ++kt) {
            const int sid = (kt * 32 + r < nsel) ? SEL[(size_t)q * 256 + kt * 32 + r] : 0;
            const bf16* kp = KAb + ((size_t)b * SEQ + sid) * 128 + 8 * hh;
            const bf16* vp = VAb + ((size_t)b * SEQ + sid) * 128 + 8 * hh;
            f32x16 L = zero16();
#pragma unroll
            for (int ks = 0; ks < 8; ++ks) L = MFMA32(*(const bf16x8*)(kp + 16 * ks), qf[ks], L);
            float tm = -3.0e38f;
#pragma unroll
            for (int i = 0; i < 16; ++i) { L[i] = (kt * 32 + crow(i, hh) < nsel) ? L[i] * 0.08838834764831845f : -3.0e38f; tm = fmaxf(tm, L[i]); }
            tm = fmaxf(tm, __shfl_xor(tm, 32));
            const float mn = fmaxf(mx, tm), alpha = __expf(mx - mn); mx = mn;
            float ts = 0.f;
#pragma unroll
            for (int i = 0; i < 16; ++i) { const float e = __expf(L[i] - mn); L[i] = e; ts += e; }
            sum = sum * alpha + ts;
#pragma unroll
            for (int i = 0; i < 8; ++i) { const float ah = __shfl(alpha, crow(i, hh));
#pragma unroll
                for (int dt = 0; dt < 4; ++dt) o[dt][i] *= ah; }
            const bf16x8 P0 = pack8<0>(L), P1 = pack8<1>(L);
#pragma unroll
            for (int dt = 0; dt < 4; ++dt) { f32x16 xv = MFMA32(*(const bf16x8*)(vp + dt * 32), I.f0, zero16()); xv = MFMA32(*(const bf16x8*)(vp + dt * 32 + 16), I.f1, xv);
                o[dt] = MFMA32(P0, pack8<0>(xv), o[dt]); o[dt] = MFMA32(P1, pack8<1>(xv), o[dt]); }
        }
        sum += __shfl_xor(sum, 32);
        const float inv = 1.0f / sum;
#pragma unroll
        for (int i = 0; i < 8; ++i) { const int head = crow(i, hh); const float ih = __shfl(inv, head);
#pragma unroll
            for (int dt = 0; dt < 4; ++dt) { const float v = o[dt][i] * ih; MIX[(size_t)q * 2048 + head * 128 + dt * 32 + r] = (bf16)(pkbf(v, v) & 0xffffu); } }
    }
}
struct Args { const void* in[21]; float* out; unsigned char* ws; int ph_lo, ph_hi; };
__global__ void __launch_bounds__(NWAVES * 64, 2) mk_fwd(Args args) {
    extern __shared__ __attribute__((aligned(16))) unsigned char lds_raw[];
    Frame F;
    F.lds = (LAS unsigned char*)lds_raw;
    F.G = gridDim.x; { const int bx = blockIdx.x; F.vcu = (F.G % 8 == 0) ? (bx % 8) * (F.G / 8) + bx / 8 : bx; }
    F.x = (const float*)args.in[0]; F.c = (const float*)args.in[1]; F.positions = (const int*)args.in[2]; F.mod_w = (const float*)args.in[3]; F.mod_b = (const float*)args.in[4];
    F.norm_w = (const float*)args.in[5]; F.w_gate = (const float*)args.in[6]; F.w_up = (const float*)args.in[7]; F.w_down = (const float*)args.in[8]; F.hy_w_in = (const float*)args.in[9];
    F.conv_w = (const float*)args.in[10]; F.conv_b = (const float*)args.in[11]; F.A_log = (const float*)args.in[12]; F.dt_bias = (const float*)args.in[13]; F.ssd_D = (const float*)args.in[14];
    F.ssd_norm_w = (const float*)args.in[15]; F.ret_norm_w = (const float*)args.in[16]; F.hy_w_out = (const float*)args.in[17]; F.dsa_w_in = (const float*)args.in[18];
    F.idx_k_norm_w = (const float*)args.in[19]; F.dsa_w_out = (const float*)args.in[20];
    F.out = args.out; F.ws = args.ws;
    const int TID = threadIdx.x;
    volatile LAS unsigned* MISC = (volatile LAS unsigned*)(F.lds + MISC_OFF);
    for (int u = TID; u < (LDS_BYTES - LDSCTL_OFF) / 4; u += NWAVES * 64) ((LAS unsigned*)(F.lds + LDSCTL_OFF))[u] = 0u;
    __syncthreads();
    const int lo = args.ph_lo, hi = args.ph_hi;
    XcdBarrier bar; bar.bar = (unsigned*)(F.ws + WS_CTL) + CW_BAR; bar.x = 0; bar.st = nullptr;
    if (hi - lo > 1) bar = xcd_barrier_post((unsigned*)(F.ws + WS_CTL) + CW_BAR, MISC + 8);
#define RUN(k) (lo <= (k) && (k) < hi)
#define REPS(i) (1 + (int)((PROBE_REP_MASK >> (i)) & 1u))
#define SEAM(k) do { if (RUN(k) && RUN((k) + 1)) xcd_barrier(bar); } while (0)
    bf16* H = WSP(bf16, WS_H); bf16* ACT = WSP(bf16, WS_BIG); bf16* PB = WSP(bf16, WS_BIG); bf16* MIX = WSP(bf16, WS_MIX); bf16* Y = WSP(bf16, WS_Y); float* SSQ = WSP(float, WS_SSQ);

    if (PON(0) && RUN(0)) for (int rep_ = 0; rep_ < REPS(0); ++rep_) { p0_prologue(F); __syncthreads(); }
    SEAM(0);
    if (PON(1) && RUN(1)) thin_phase(F, -1, 0);
    SEAM(1);
    int ph = 2, q = 0;
    for (int s = 0; s < 4; ++s) {
        if (PON(2) && RUN(ph)) for (int rep_ = 0; rep_ < REPS(2); ++rep_) { pg8::Gemm g{H, WSP(bf16, WS_WGU) + (size_t)s * WGU_ELEMS, M, 2 * FF, D}; pg8::StaticOrder S; S.init(M, 2 * FF, F.G, (int)blockIdx.x);
            pg8::EpiGateUp E{ACT, FF}; pg8::gemm_phase<pg8::EpiGateUp, pg8::StaticOrder, true, true>(F.lds, g, S, E); }
        SEAM(ph); ++ph;
        if (PON(3) && RUN(ph)) for (int rep_ = 0; rep_ < REPS(3); ++rep_) { pg8::Gemm g{ACT, WSP(bf16, WS_WD) + (size_t)s * WD_ELEMS, M, D, FF}; pg8::StaticOrder S; S.init(M, D, F.G, (int)blockIdx.x);
            pg8::EpiYSsq E{Y, D, SSQ}; pg8::gemm_phase<pg8::EpiYSsq, pg8::StaticOrder, true, true>(F.lds, g, S, E); }
        SEAM(ph); ++ph;
        if (PON(1) && RUN(ph)) thin_phase(F, q, q < 5 ? q + 1 : -1);
        SEAM(ph); ++ph; ++q;
        if (s == 0) {
            if (PON(4) && RUN(ph)) for (int rep_ = 0; rep_ < REPS(4); ++rep_) { pg8::Gemm g{H, WSP(bf16, WS_WIN0), M, IN0P, D}; pg8::StaticOrder S; S.init(M, IN0P, F.G, (int)blockIdx.x);
                pg8::EpiProj0 E{PB, IN0P, WSP(float, WS_DTB), WSP(float, WS_RTC), WSP(float, WS_RTS)}; pg8::gemm_phase<pg8::EpiProj0, pg8::StaticOrder, true, true>(F.lds, g, S, E); }
            SEAM(ph); ++ph;
            if (PON(6) && RUN(ph)) for (int rep_ = 0; rep_ < REPS(6); ++rep_) { m0_states(F); __syncthreads(); }
            SEAM(ph); ++ph;
            if (PON(14) && RUN(ph)) for (int rep_ = 0; rep_ < REPS(14); ++rep_) { m0_chunkscan(F); __syncthreads(); }
            SEAM(ph); ++ph;
            if (PON(15) && RUN(ph)) for (int rep_ = 0; rep_ < REPS(15); ++rep_) { if (rep_ == 0 || PROBE_OUT_SEL != 2) m0_out_ssd(F); if (rep_ == 0 || PROBE_OUT_SEL != 1) m0_out_ret(F); }
            SEAM(ph); ++ph;
            if (PON(7) && RUN(ph)) m0_post(F);
            SEAM(ph); ++ph;
            if (PON(8) && RUN(ph)) for (int rep_ = 0; rep_ < REPS(8); ++rep_) { pg8::Gemm g{MIX, WSP(bf16, WS_WOUT0), M, D, 2 * D}; pg8::StaticOrder S; S.init(M, D, F.G, (int)blockIdx.x);
                pg8::EpiYSsq E{Y, D, SSQ}; pg8::gemm_phase<pg8::EpiYSsq, pg8::StaticOrder, true, true>(F.lds, g, S, E); }
            SEAM(ph); ++ph;
            if (PON(1) && RUN(ph)) thin_phase(F, q, q + 1);
            SEAM(ph); ++ph; ++q;
        }
        if (s == 2) {
            if (PON(9) && RUN(ph)) for (int rep_ = 0; rep_ < REPS(9); ++rep_) { pg8::Gemm g{H, WSP(bf16, WS_WIN1), M, IN1P, D}; pg8::StaticOrder S; S.init(M, IN1P, F.G, (int)blockIdx.x);
                pg8::EpiProj E{PB, 2304, 9, WSP(float, WS_IDX), 1280}; pg8::gemm_phase<pg8::EpiProj, pg8::StaticOrder, true, true>(F.lds, g, S, E); }
            SEAM(ph); ++ph;
            if (PON(10) && RUN(ph)) for (int rep_ = 0; rep_ < REPS(10); ++rep_) { m1_prep(F); __syncthreads(); }
            SEAM(ph); ++ph;
            if (PON(11) && RUN(ph)) for (int rep_ = 0; rep_ < REPS(11); ++rep_) { m1_index(F); __syncthreads(); }
            SEAM(ph); ++ph;
            if (PON(12) && RUN(ph)) for (int rep_ = 0; rep_ < REPS(12); ++rep_) { m1_attn(F); __syncthreads(); }
            SEAM(ph); ++ph;
            if (PON(13) && RUN(ph)) for (int rep_ = 0; rep_ < REPS(13); ++rep_) { pg8::Gemm g{MIX, WSP(bf16, WS_WOUT1), M, D, D}; pg8::StaticOrder S; S.init(M, D, F.G, (int)blockIdx.x);
                pg8::EpiYSsq E{Y, D, SSQ}; pg8::gemm_phase<pg8::EpiYSsq, pg8::StaticOrder, true, true>(F.lds, g, S, E); }
            SEAM(ph); ++ph;
            if (PON(1) && RUN(ph)) thin_phase(F, q, q + 1);
            SEAM(ph); ++ph; ++q;
        }
    }
#undef RUN
#undef SEAM
}

extern "C" void kernel_launch(void* const* d_in, const int* in_sizes, int n_in, void* d_out, int out_size, void* d_ws, size_t ws_size, hipStream_t stream) {
    static int grid = 0;
    if (grid == 0) {
        if (n_in != 21 || out_size != M * D || ws_size < WS_END) { fprintf(stderr, "kernel_launch: unexpected shapes (n_in %d, out %d, ws %zu < %zu)\n", n_in, out_size, ws_size, (size_t)WS_END); grid = -1; return; }
        int dev = 0, cus = 0, per_cu = 0;
        if (hipGetDevice(&dev) != hipSuccess || hipDeviceGetAttribute(&cus, hipDeviceAttributeMultiprocessorCount, dev) != hipSuccess) { grid = -1; return; }
        if (hipFuncSetAttribute((const void*)mk_fwd, hipFuncAttributeMaxDynamicSharedMemorySize, LDS_BYTES) != hipSuccess) { fprintf(stderr, "kernel_launch: hipFuncSetAttribute failed\n"); grid = -1; return; }
        if (hipOccupancyMaxActiveBlocksPerMultiprocessor(&per_cu, (const void*)mk_fwd, NWAVES * 64, LDS_BYTES) != hipSuccess || per_cu < 1) { fprintf(stderr, "kernel_launch: occupancy query says %d\n", per_cu); }
        (void)hipGetLastError();
        grid = cus;
    }
    if (grid < 0) return;
    (void)hipMemsetAsync((char*)d_ws + WS_CTL, 0, CTL_ZERO_BYTES, stream);
    Args a{};
    for (int i = 0; i < 21; ++i) a.in[i] = d_in[i];
    a.out = (float*)d_out; a.ws = (unsigned char*)d_ws;
#if MK_LAUNCH_PER_PHASE
    for (int p = 0; p < NPH; ++p) { a.ph_lo = p; a.ph_hi = p + 1; hipLaunchKernelGGL(mk_fwd, dim3(grid), dim3(NWAVES * 64), LDS_BYTES, stream, a); }
#else
    a.ph_lo = 0; a.ph_hi = NPH; hipLaunchKernelGGL(mk_fwd, dim3(grid), dim3(NWAVES * 64), LDS_BYTES, stream, a);
#endif
}
```

```cpp
#include <hip/hip_runtime.h>
#include <cstdio>
#include <cstdint>
namespace pg8 {
#define PG8_LAS __attribute__((address_space(3)))
typedef unsigned short bf16_t;
typedef short bf16x8 __attribute__((ext_vector_type(8)));
typedef float f32x4 __attribute__((ext_vector_type(4)));
typedef unsigned u32x4 __attribute__((ext_vector_type(4)));
constexpr int BM = 256, BK = 64, HALF = 128, HTB = HALF * BK * 2  , STAGE_BYTES = 8 * HTB, NXCD = 8, WGM = 8;

__host__ __device__ __forceinline__ int lds_byte(int r, int c) { const int st = (r >> 4) * 2 + (c >> 5), rr = r & 15, cc = c & 31, ob = rr * 64 + cc * 2; return st * 1024 + (ob ^ (((ob >> 9) & 1) << 5)); }
__host__ __device__ __forceinline__ void stage_rc(int b, int& R, int& C) { const int st = b / 1024, sb = b % 1024, swz = sb ^ (((sb >> 9) & 1) << 5); R = (st >> 1) * 16 + swz / 64; C = (st & 1) * 32 + (swz % 64) / 2; }
__host__ __device__ __forceinline__ int perm32(int rho) { const int n = rho >> 4, i = rho & 15; return 8 * (i >> 2) + 4 * n + (i & 3); }

struct Unit { int pm, pn; };
struct Gemm { const bf16_t* A; const bf16_t* Bt; int M, N, K; };

struct StaticOrder {
    int nM, nN, nwg, G, c;
    __host__ __device__ void init(int M, int N, int G_, int c_) { nM = M / BM; nN = N / BM; nwg = nM * nN; G = G_; c = c_; }
    __host__ __device__ bool next(int i, Unit& u) const {
        const long L = (long)i * G + c; if (L >= nwg) return false;
        int wgid = (int)L; { const int q = nwg / NXCD, r = nwg % NXCD, xcd = wgid % NXCD, off = wgid / NXCD; wgid = (xcd < r ? xcd * (q + 1) : r * (q + 1) + (xcd - r) * q) + off; }
        const int nig = WGM * nN, gid = wgid / nig, fm = gid * WGM, gsz = (nM - fm) < WGM ? (nM - fm) : WGM;
        u.pm = fm + ((wgid % nig) % gsz); u.pn = (wgid % nig) / gsz; return true;
    }
    __device__ __forceinline__ void a_ready(const Unit&) const {}
    __device__ __forceinline__ void done(const Unit&) const {}
};

__device__ __forceinline__ unsigned cvt_pk_bf16(float lo, float hi) { unsigned r; asm volatile("v_cvt_pk_bf16_f32 %0, %1, %2" : "=v"(r) : "v"(lo), "v"(hi)); return r; }
typedef float f32x2 __attribute__((ext_vector_type(2)));
__device__ __forceinline__ float silu_f(float v) { return v * __builtin_amdgcn_rcpf(1.0f + __expf(-v)); }

struct EpiGateUp {
    static constexpr bool PERM = true, AFTER_DRAIN = false;
    bf16_t* O; int ldc;
    __device__ __forceinline__ void operator()(const f32x4 (&acc)[2][2][4][2], const Unit& u, int wr, int wc, int fr, int fq) const {
        const int row0 = u.pm * BM + wr * 64 + fr, col0 = u.pn * HALF + wc * 32 + 8 * fq;
#pragma unroll
        for (int ai = 0; ai < 2; ++ai)
#pragma unroll
            for (int m = 0; m < 4; ++m) { bf16_t* rowp = O + (size_t)(row0 + ai * HALF + m * 16) * ldc + col0;
                const f32x4 g0 = acc[ai][0][m][0], g1 = acc[ai][0][m][1], u0 = acc[ai][1][m][0], u1 = acc[ai][1][m][1];
                f32x4 v0, v1;
#pragma unroll
                for (int j = 0; j < 4; ++j) { v0[j] = silu_f(g0[j]) * u0[j]; v1[j] = silu_f(g1[j]) * u1[j]; }
                u32x4 w; w.x = cvt_pk_bf16(v0[0], v0[1]); w.y = cvt_pk_bf16(v0[2], v0[3]); w.z = cvt_pk_bf16(v1[0], v1[1]); w.w = cvt_pk_bf16(v1[2], v1[3]);
                *(u32x4*)rowp = w; }
    }
};
struct EpiYSsq {
    static constexpr bool PERM = true, AFTER_DRAIN = false;
    bf16_t* C; int ldc; float* ssq;
    __device__ __forceinline__ void operator()(const f32x4 (&acc)[2][2][4][2], const Unit& u, int wr, int wc, int fr, int fq) const {
        const int row0 = u.pm * BM + wr * 64 + fr, col0 = u.pn * BM + wc * 32 + 8 * fq;
#pragma unroll
        for (int ai = 0; ai < 2; ++ai)
#pragma unroll
            for (int m = 0; m < 4; ++m) { const int row = row0 + ai * HALF + m * 16; bf16_t* rowp = C + (size_t)row * ldc + col0; float s = 0.f;
#pragma unroll
                for (int bj = 0; bj < 2; ++bj) { const f32x4 v0 = acc[ai][bj][m][0], v1 = acc[ai][bj][m][1];
                    s += ((v0[0] * v0[0] + v0[1] * v0[1]) + (v0[2] * v0[2] + v0[3] * v0[3])) + ((v1[0] * v1[0] + v1[1] * v1[1]) + (v1[2] * v1[2] + v1[3] * v1[3]));
                    u32x4 w; w.x = cvt_pk_bf16(v0[0], v0[1]); w.y = cvt_pk_bf16(v0[2], v0[3]); w.z = cvt_pk_bf16(v1[0], v1[1]); w.w = cvt_pk_bf16(v1[2], v1[3]);
                    *(u32x4*)(rowp + bj * HALF) = w; }
                s += __shfl_xor(s, 16); s += __shfl_xor(s, 32);
                if (fq == 0) ssq[(size_t)row * 32 + u.pn * 4 + wc] = s; }
    }
};
struct EpiProj {
    static constexpr bool PERM = true, AFTER_DRAIN = false;
    bf16_t* O; int ldo; int nbf; float* Fo; int ldf;
    __device__ __forceinline__ void operator()(const f32x4 (&acc)[2][2][4][2], const Unit& u, int wr, int wc, int fr, int fq) const {
        const int row0 = u.pm * BM + wr * 64 + fr;
        if (u.pn < nbf) {
            const int col0 = u.pn * BM + wc * 32 + 8 * fq;
#pragma unroll
            for (int ai = 0; ai < 2; ++ai)
#pragma unroll
                for (int m = 0; m < 4; ++m) { bf16_t* rowp = O + (size_t)(row0 + ai * HALF + m * 16) * ldo + col0;
#pragma unroll
                    for (int bj = 0; bj < 2; ++bj) { const f32x4 v0 = acc[ai][bj][m][0], v1 = acc[ai][bj][m][1];
                        u32x4 w; w.x = cvt_pk_bf16(v0[0], v0[1]); w.y = cvt_pk_bf16(v0[2], v0[3]); w.z = cvt_pk_bf16(v1[0], v1[1]); w.w = cvt_pk_bf16(v1[2], v1[3]);
                        *(u32x4*)(rowp + bj * HALF) = w; } }
        } else {
            const int col0 = (u.pn - nbf) * BM + wc * 32 + 8 * fq;
#pragma unroll
            for (int ai = 0; ai < 2; ++ai)
#pragma unroll
                for (int m = 0; m < 4; ++m) { float* rowp = Fo + (size_t)(row0 + ai * HALF + m * 16) * ldf + col0;
#pragma unroll
                    for (int bj = 0; bj < 2; ++bj) { *(f32x4*)(rowp + bj * HALF) = acc[ai][bj][m][0]; *(f32x4*)(rowp + bj * HALF + 4) = acc[ai][bj][m][1]; } }
        }
    }
};
struct EpiProj0 {
    static constexpr bool PERM = true, AFTER_DRAIN = false;
    bf16_t* O; int ldo; float* Fo; const float* rc; const float* rs;
    __device__ __forceinline__ void operator()(const f32x4 (&acc)[2][2][4][2], const Unit& u, int wr, int wc, int fr, int fq) const {
        const int row0 = u.pm * BM + wr * 64 + fr;
        if (u.pn == 56) {
            const int col0 = wc * 32 + 8 * fq;
#pragma unroll
            for (int ai = 0; ai < 2; ++ai)
#pragma unroll
                for (int m = 0; m < 4; ++m) { float* rowp = Fo + (size_t)(row0 + ai * HALF + m * 16) * 256 + col0;
#pragma unroll
                    for (int bj = 0; bj < 2; ++bj) { *(f32x4*)(rowp + bj * HALF) = acc[ai][bj][m][0]; *(f32x4*)(rowp + bj * HALF + 4) = acc[ai][bj][m][1]; } }
            return;
        }
        const int col0 = u.pn * BM + wc * 32 + 8 * fq;
        const bool rot = (u.pn >= 24 && u.pn < 40); const float sc = (u.pn >= 32) ? 0.0625f : 1.0f;
#pragma unroll
        for (int ai = 0; ai < 2; ++ai)
#pragma unroll
            for (int m = 0; m < 4; ++m) { const int row = row0 + ai * HALF + m * 16; bf16_t* rowp = O + (size_t)row * ldo + col0;
                f32x4 a0 = acc[ai][0][m][0], a1 = acc[ai][0][m][1], b0 = acc[ai][1][m][0], b1 = acc[ai][1][m][1];
                if (rot) { const int i0 = wc * 32 + 8 * fq;
                    const f32x4 c0 = *(const f32x4*)(rc + (size_t)row * 128 + i0), c1 = *(const f32x4*)(rc + (size_t)row * 128 + i0 + 4), s0 = *(const f32x4*)(rs + (size_t)row * 128 + i0), s1 = *(const f32x4*)(rs + (size_t)row * 128 + i0 + 4);
                    const f32x4 x0 = a0, x1 = a1, y0 = b0, y1 = b1;
                    a0 = (x0 * c0 - y0 * s0) * sc; a1 = (x1 * c1 - y1 * s1) * sc; b0 = (x0 * s0 + y0 * c0) * sc; b1 = (x1 * s1 + y1 * c1) * sc; }
                u32x4 w; w.x = cvt_pk_bf16(a0[0], a0[1]); w.y = cvt_pk_bf16(a0[2], a0[3]); w.z = cvt_pk_bf16(a1[0], a1[1]); w.w = cvt_pk_bf16(a1[2], a1[3]);
                *(u32x4*)rowp = w;
                w.x = cvt_pk_bf16(b0[0], b0[1]); w.y = cvt_pk_bf16(b0[2], b0[3]); w.z = cvt_pk_bf16(b1[0], b1[1]); w.w = cvt_pk_bf16(b1[2], b1[3]);
                *(u32x4*)(rowp + HALF) = w; }
    }
};
template <class Epi, class Sched, bool ALIGN_EPI = false, bool SP2 = false>
__device__ __forceinline__ void gemm_phase(PG8_LAS unsigned char* lds, const Gemm g, const Sched& S, const Epi& E) {
    int tid_ = threadIdx.x; asm volatile("" : "+v"(tid_));
    const int tid = tid_, wid = __builtin_amdgcn_readfirstlane(tid >> 6), lane = tid & 63, wr = wid >> 2, wc = wid & 3, fr = lane & 15, fq = lane >> 4;
    const int K = g.K, nt = K / BK;
    unsigned voffA[2], voffB[2];
#pragma unroll
    for (int i = 0; i < 2; ++i) { int R, C; stage_rc(tid * 16 + i * 8192, R, C); const int Rb = Epi::PERM ? ((R & ~31) + perm32(R & 31)) : R;
        voffA[i] = (unsigned)(R * K + C) * 2u; voffB[i] = (unsigned)(Rb * K + C) * 2u; }
    const size_t kstep = (size_t)(BK * 2);
    const size_t hstep = (size_t)HALF * K * 2;
    const size_t tstep = 2 * hstep;
    const unsigned ldsw = (unsigned)wid * 1024u;
    const int aoff = lds_byte(wr * 64 + fr, fq * 8), boff = lds_byte(wc * 32 + fr, fq * 8);
#define PG8_SA(b, h) (((b) * 2 + (h)) * HTB)
#define PG8_SB(b, h) ((4 + (b) * 2 + (h)) * HTB)
#define PG8_STAGE(bufoff, gbase, voff) do { _Pragma("unroll") for (int _i = 0; _i < 2; ++_i) \
        __builtin_amdgcn_global_load_lds((const unsigned*)((const char*)(gbase) + (voff)[_i]), (PG8_LAS unsigned*)(lds + (bufoff) + ldsw + _i * 8192), 16, 0, 0); } while (0)
#define PG8_LDA(dst, b, h) do { _Pragma("unroll") for (int m = 0; m < 4; ++m) _Pragma("unroll") for (int k = 0; k < 2; ++k) dst[m][k] = *(const PG8_LAS bf16x8*)(lds + PG8_SA(b, h) + aoff + m * 2048 + k * 1024); } while (0)
#define PG8_LDB(dst, b, h) do { _Pragma("unroll") for (int n = 0; n < 2; ++n) _Pragma("unroll") for (int k = 0; k < 2; ++k) dst[n][k] = *(const PG8_LAS bf16x8*)(lds + PG8_SB(b, h) + boff + n * 2048 + k * 1024); } while (0)
#define PG8_MMA(ai, bj, At, Bt) do { __builtin_amdgcn_s_setprio(1); _Pragma("unroll") for (int m = 0; m < 4; ++m) _Pragma("unroll") for (int n = 0; n < 2; ++n) _Pragma("unroll") for (int k = 0; k < 2; ++k) \
        acc[ai][bj][m][n] = __builtin_amdgcn_mfma_f32_16x16x32_bf16(Bt[n][k], At[m][k], acc[ai][bj][m][n], 0, 0, 0); __builtin_amdgcn_s_setprio(0); } while (0)
#define PG8_WAIT_V(n) asm volatile("s_waitcnt vmcnt(" #n ")" ::: "memory")
#define PG8_WAIT_L(n) asm volatile("s_waitcnt lgkmcnt(" #n ")" ::: "memory")
#define PG8_BAR __builtin_amdgcn_s_barrier()
#define PG8_SCHED __builtin_amdgcn_sched_barrier(0)
    Unit cur, nxt; int ui = 0;
    if (!S.next(0, cur)) return;
    f32x4 acc[2][2][4][2];
#pragma unroll
    for (int a = 0; a < 2; ++a)
#pragma unroll
        for (int b = 0; b < 2; ++b)
#pragma unroll
            for (int m = 0; m < 4; ++m)
#pragma unroll
                for (int n = 0; n < 2; ++n) acc[a][b][m][n] = (f32x4){0.f, 0.f, 0.f, 0.f};
    bf16x8 At[4][2], B0[2][2], B1[2][2];
    const char* cA = (const char*)g.A + (size_t)cur.pm * tstep; const char* cB = (const char*)g.Bt + (size_t)cur.pn * tstep;
    S.a_ready(cur);
    if constexpr (SP2) {
        PG8_STAGE(PG8_SB(0, 0), cB, voffB); PG8_STAGE(PG8_SB(0, 1), cB + hstep, voffB); PG8_STAGE(PG8_SA(0, 0), cA, voffA); PG8_STAGE(PG8_SA(0, 1), cA + hstep, voffA);
        if (wr == 1) PG8_BAR;
        PG8_WAIT_V(2); PG8_BAR;
        PG8_STAGE(PG8_SB(1, 0), cB + kstep, voffB); PG8_STAGE(PG8_SA(1, 0), cA + kstep, voffA); PG8_STAGE(PG8_SB(1, 1), cB + hstep + kstep, voffB);
        PG8_WAIT_V(6); PG8_BAR;
    } else {
        PG8_STAGE(PG8_SB(0, 0), cB, voffB); PG8_STAGE(PG8_SA(0, 0), cA, voffA); PG8_STAGE(PG8_SB(0, 1), cB + hstep, voffB); PG8_STAGE(PG8_SA(0, 1), cA + hstep, voffA);
        if (wr == 1) PG8_BAR;
        PG8_WAIT_V(4); PG8_BAR;
        PG8_STAGE(PG8_SB(1, 0), cB + kstep, voffB); PG8_STAGE(PG8_SA(1, 0), cA + kstep, voffA); PG8_STAGE(PG8_SB(1, 1), cB + hstep + kstep, voffB);
        PG8_WAIT_V(6); PG8_BAR;
    }
    for (;;) {
        const bool has_next = S.next(ui + 1, nxt);
        const char* nA = has_next ? (const char*)g.A + (size_t)nxt.pm * tstep : cA; const char* nB = has_next ? (const char*)g.Bt + (size_t)nxt.pn * tstep : cB;
        for (int t = 0; t < nt; t += 2) {
            const bool last = (t == nt - 2);
            const char* a1 = cA + (size_t)(t + 1) * kstep;
            const char* a2 = last ? nA : cA + (size_t)(t + 2) * kstep; const char* b2 = last ? nB : cB + (size_t)(t + 2) * kstep;
            const char* a3 = a2 + kstep; const char* b3 = b2 + kstep;
            if (last && has_next) S.a_ready(nxt);
            if constexpr (SP2) {
            PG8_LDB(B0, 0, 0); PG8_LDB(B1, 0, 1); PG8_SCHED; PG8_LDA(At, 0, 0); PG8_STAGE(PG8_SA(1, 1), a1 + hstep, voffA);
            PG8_WAIT_V(8); PG8_WAIT_L(0); PG8_BAR; PG8_MMA(0, 0, At, B0); PG8_MMA(0, 1, At, B1); PG8_BAR; PG8_SCHED;
            PG8_LDA(At, 0, 1); PG8_STAGE(PG8_SB(0, 0), b2, voffB); PG8_STAGE(PG8_SB(0, 1), b2 + hstep, voffB); PG8_STAGE(PG8_SA(0, 0), a2, voffA);
            PG8_WAIT_V(8); PG8_WAIT_L(0); PG8_BAR; PG8_MMA(1, 0, At, B0); PG8_MMA(1, 1, At, B1); PG8_BAR; PG8_SCHED;
            PG8_LDB(B0, 1, 0); PG8_LDB(B1, 1, 1); PG8_SCHED; PG8_LDA(At, 1, 0); PG8_STAGE(PG8_SA(0, 1), a2 + hstep, voffA);
            PG8_WAIT_V(8); PG8_WAIT_L(0); PG8_BAR; PG8_MMA(0, 0, At, B0); PG8_MMA(0, 1, At, B1); PG8_BAR; PG8_SCHED;
            PG8_LDA(At, 1, 1); PG8_STAGE(PG8_SB(1, 0), b3, voffB); PG8_STAGE(PG8_SB(1, 1), b3 + hstep, voffB); PG8_STAGE(PG8_SA(1, 0), a3, voffA);
            PG8_WAIT_V(8); PG8_WAIT_L(0); PG8_BAR; PG8_MMA(1, 0, At, B0); PG8_MMA(1, 1, At, B1); PG8_BAR; PG8_SCHED;
            } else {
            PG8_LDB(B0, 0, 0); PG8_SCHED; PG8_LDA(At, 0, 0); PG8_STAGE(PG8_SA(1, 1), a1 + hstep, voffA);
            PG8_WAIT_L(8); PG8_BAR; PG8_WAIT_L(0); PG8_MMA(0, 0, At, B0); PG8_BAR; PG8_SCHED;
            PG8_LDB(B1, 0, 1); PG8_STAGE(PG8_SB(0, 0), b2, voffB);
            PG8_BAR; PG8_WAIT_L(0); PG8_MMA(0, 1, At, B1); PG8_BAR;
            PG8_LDA(At, 0, 1); PG8_STAGE(PG8_SA(0, 0), a2, voffA);
            PG8_BAR; PG8_WAIT_L(0); PG8_MMA(1, 0, At, B0); PG8_BAR; PG8_SCHED;
            PG8_STAGE(PG8_SB(0, 1), b2 + hstep, voffB);
            PG8_WAIT_V(6); PG8_BAR; PG8_MMA(1, 1, At, B1); PG8_BAR;
            PG8_LDB(B0, 1, 0); PG8_SCHED; PG8_LDA(At, 1, 0); PG8_STAGE(PG8_SA(0, 1), a2 + hstep, voffA);
            PG8_WAIT_L(8); PG8_BAR; PG8_WAIT_L(0); PG8_MMA(0, 0, At, B0); PG8_BAR; PG8_SCHED;
            PG8_LDB(B1, 1, 1); PG8_STAGE(PG8_SB(1, 0), b3, voffB);
            PG8_BAR; PG8_WAIT_L(0); PG8_MMA(0, 1, At, B1); PG8_BAR;
            PG8_LDA(At, 1, 1); PG8_STAGE(PG8_SA(1, 0), a3, voffA);
            PG8_BAR; PG8_WAIT_L(0); PG8_MMA(1, 0, At, B0); PG8_BAR; PG8_SCHED;
            PG8_STAGE(PG8_SB(1, 1), b3 + hstep, voffB);
            PG8_WAIT_V(6); PG8_BAR; PG8_MMA(1, 1, At, B1); PG8_BAR;
            }
        }
        if constexpr (ALIGN_EPI) { if (wr == 0) PG8_BAR; }
        if constexpr (!Epi::AFTER_DRAIN) { E(acc, cur, wr, wc, fr, fq); S.done(cur); }
        if (!has_next) break;
#pragma unroll
        for (int a = 0; a < 2; ++a)
#pragma unroll
            for (int b = 0; b < 2; ++b)
#pragma unroll
                for (int m = 0; m < 4; ++m)
#pragma unroll
                    for (int n = 0; n < 2; ++n) acc[a][b][m][n] = (f32x4){0.f, 0.f, 0.f, 0.f};
        cur = nxt; cA = nA; cB = nB; ++ui;
        if constexpr (ALIGN_EPI) { if (wr == 1) PG8_BAR; }
    }
    PG8_WAIT_V(0);
    if constexpr (!ALIGN_EPI) { if (wr == 0) PG8_BAR; }
    PG8_BAR;
    if constexpr (Epi::AFTER_DRAIN) { E.fused(acc, cur, wr, wc, fr, fq, lds, wid, lane); S.done(cur); }
#undef PG8_SA
#undef PG8_SB
#undef PG8_STAGE
#undef PG8_LDA
#undef PG8_LDB
#undef PG8_MMA
#undef PG8_WAIT_V
#undef PG8_WAIT_L
#undef PG8_BAR
#undef PG8_SCHED
}
}
#define GAS __attribute__((address_space(1)))
#define LAS __attribute__((address_space(3)))
typedef unsigned short bf16;
typedef unsigned v4u __attribute__((ext_vector_type(4)));
typedef float f32x4 __attribute__((ext_vector_type(4)));
typedef short bf16x8 __attribute__((ext_vector_type(8)));
typedef GAS unsigned gu32;
typedef GAS unsigned long long gu64;
#define RLX_AGENT __ATOMIC_RELAXED, __HIP_MEMORY_SCOPE_AGENT
#define LDS_WAIT() asm volatile("s_waitcnt lgkmcnt(0)" ::: "memory")
#define VM_WAIT() asm volatile("s_waitcnt vmcnt(0)" ::: "memory")
__device__ __forceinline__ unsigned long long rt() { return __builtin_amdgcn_s_memrealtime(); }
__device__ __forceinline__ unsigned f2bf(float f) { unsigned u = __builtin_bit_cast(unsigned, f); return (u + 0x7fffu + ((u >> 16) & 1u)) >> 16; }
__device__ __forceinline__ unsigned pk2(float lo, float hi) { return f2bf(lo) | (f2bf(hi) << 16); }

#define XB_TMO      128
#define XB_XCNT(j)  (256  + 64 * (j))
#define XB_XSUB(j)  (1280 + 64 * (j))
#define XB_XGEN(j)  (2304 + 64 * (j))
#define XB_TOP      3328
#define XB_TOPGEN   3392
#define XCD_BAR_WORDS 3456
#define XB_SPIN_CAP (1u << 18)

__device__ __forceinline__ unsigned xb_ld(unsigned* p)              { return __hip_atomic_load(p, __ATOMIC_RELAXED, __HIP_MEMORY_SCOPE_AGENT); }
__device__ __forceinline__ unsigned xb_add(unsigned* p, unsigned v) { return __hip_atomic_fetch_add(p, v, __ATOMIC_RELAXED, __HIP_MEMORY_SCOPE_AGENT); }
__device__ __forceinline__ unsigned xb_xcc_id() { return (unsigned)__builtin_amdgcn_s_getreg((3 << 11) | 20) & 0xFu; }
#define XB_SPIN(cond, bar) do { unsigned _sp = 0; while (cond) { __builtin_amdgcn_s_sleep(1); \
    if ((++_sp & 255u) == 0u) { if (xb_ld(&(bar)[XB_TMO])) break; if (_sp > XB_SPIN_CAP) { atomicAdd(&(bar)[XB_TMO], 1u); break; } } } } while (0)

struct XcdBarrier {
    unsigned* bar; unsigned x;
    volatile LAS unsigned* st;
};

__device__ __forceinline__ XcdBarrier xcd_barrier_post(unsigned* bar, volatile LAS unsigned* st) {
    XcdBarrier b; b.bar = bar; b.x = xb_xcc_id(); b.st = st;
    if (threadIdx.x == 0) (void)xb_add(&bar[XB_XCNT(b.x)], 1u);
    return b;
}
__device__ __forceinline__ void xcd_barrier_complete(unsigned* bar, unsigned x, unsigned& nloc, unsigned& nx) {
    const unsigned G = gridDim.x * gridDim.y * gridDim.z;
    unsigned sum, cnt, mine, sp = 0u;
    for (;;) {
        sum = 0u; cnt = 0u; mine = 0u;
#pragma unroll
        for (unsigned j = 0; j < 16; ++j) { const unsigned c = xb_ld(&bar[XB_XCNT(j)]); sum += c; cnt += (c > 0u) ? 1u : 0u; mine = (j == x) ? c : mine; }
        if (sum == G) break;
        __builtin_amdgcn_s_sleep(1);
        if ((++sp & 255u) == 0u) { if (xb_ld(&bar[XB_TMO])) break; if (sp > XB_SPIN_CAP) { atomicAdd(&bar[XB_TMO], 1u); break; } }
    }
    nloc = mine > 0u ? mine : 1u; nx = cnt > 0u ? cnt : 1u;
}

__device__ __forceinline__ void xcd_barrier(const XcdBarrier& b) {
    asm volatile("s_waitcnt vmcnt(0)" ::: "memory");
    __syncthreads();
    if (threadIdx.x == 0) {
        unsigned* bar = b.bar;
        __builtin_amdgcn_s_waitcnt(0);
        unsigned nloc = b.st[0], nx = b.st[1];
        if (nloc == 0u) { xcd_barrier_complete(bar, b.x, nloc, nx); b.st[0] = nloc; b.st[1] = nx; }
        const unsigned old = xb_add(&bar[XB_XSUB(b.x)], 1u);
        const unsigned gen = old / nloc;
        if (old + 1u == (gen + 1u) * nloc) {
            __builtin_amdgcn_fence(__ATOMIC_RELEASE, "agent");
            asm volatile("s_waitcnt vmcnt(0)" ::: "memory");
            const unsigned og = xb_add(&bar[XB_TOP], 1u);
            const unsigned tg = og / nx;
            if (og + 1u == (tg + 1u) * nx) xb_add(&bar[XB_TOPGEN], 1u);
            else XB_SPIN(xb_ld(&bar[XB_TOPGEN]) == tg, bar);
            __builtin_amdgcn_fence(__ATOMIC_ACQUIRE, "agent");
            xb_add(&bar[XB_XGEN(b.x)], 1u);
            asm volatile("s_waitcnt vmcnt(0)" ::: "memory");
        } else {
            XB_SPIN(xb_ld(&bar[XB_XGEN(b.x)]) == gen, bar);
            __builtin_amdgcn_fence(__ATOMIC_ACQUIRE, "agent");
            asm volatile("s_waitcnt vmcnt(0)" ::: "memory");
        }
    }
    __syncthreads();
}


#ifndef MK_LAUNCH_PER_PHASE
#define MK_LAUNCH_PER_PHASE 0
#endif
constexpr int NWAVES = 8;
#ifndef PHASE_MASK
#define PHASE_MASK 0xFFFFFFFFu
#endif
#define PON(i) ((PHASE_MASK >> (i)) & 1u)
#ifndef PROBE_REP_MASK
#define PROBE_REP_MASK 0u
#endif
#ifndef PROBE_OUT_SEL
#define PROBE_OUT_SEL 0
#endif
#ifndef PROBE_DBG
#define PROBE_DBG 1
#endif

constexpr int NB = 4, SEQ = 2048, D = 2048, M = NB * SEQ, FF = 5632;
constexpr int IN0 = 14368, IN0P = 14592, IN1 = 3408, IN1P = 3584;
constexpr int MODW = 9 * D;
constexpr float EPS = 1e-6f;
constexpr int NPH = 27;

constexpr size_t MiB = 1u << 20;
constexpr size_t WS_CTL = 0, CTL_ZERO_BYTES = 1 * MiB;
constexpr size_t WS_MODS = 1 * MiB;
constexpr size_t WS_RTC = 2 * MiB, WS_RTS = 6 * MiB;
constexpr size_t WS_RTQ = 10 * MiB;
constexpr size_t WS_RTI = 11 * MiB;
constexpr size_t WS_SSQ = 12 * MiB;
constexpr size_t WS_DTB = 13 * MiB;
constexpr size_t WS_WGU = 24 * MiB;
constexpr size_t WS_WD = 200 * MiB;
constexpr size_t WS_WIN0 = 288 * MiB;
constexpr size_t WS_WOUT0 = 345 * MiB;
constexpr size_t WS_WIN1 = 361 * MiB;
constexpr size_t WS_WOUT1 = 375 * MiB;
constexpr size_t WS_H = 384 * MiB;
constexpr size_t WS_Y = 416 * MiB;
constexpr size_t WS_MIX = 480 * MiB;
constexpr size_t WS_BIG = 544 * MiB;
constexpr size_t WS_CD = 21 * MiB;
constexpr size_t WS_XC = 772 * MiB;
constexpr size_t WS_QR = 836 * MiB, WS_KR = 868 * MiB;
constexpr size_t WS_RST = 900 * MiB;
constexpr size_t WS_RPT = 1028 * MiB;
constexpr size_t WS_SST = WS_Y;
constexpr size_t WS_HP = WS_H;
constexpr size_t WS_IDX = 772 * MiB;
constexpr size_t WS_QA = 812 * MiB;
constexpr size_t WS_KAB = 844 * MiB, WS_VAB = 846 * MiB;
constexpr size_t WS_QIH = 848 * MiB, WS_QIL = 864 * MiB;
constexpr size_t WS_KIH = 880 * MiB, WS_KIL = 881 * MiB;
constexpr size_t WS_WI = 882 * MiB;
constexpr size_t WS_SEL = 884 * MiB;
constexpr size_t WS_NSEL = 892 * MiB;
constexpr size_t WS_END = 1092 * MiB;
constexpr size_t WGU_ELEMS = (size_t)2 * FF * D, WD_ELEMS = (size_t)D * FF;
constexpr int CW_BAR = 4096;

constexpr int RING_BYTES = 131072;
constexpr int LDSCTL_OFF = 146432, MISC_OFF = LDSCTL_OFF + 320;
constexpr int LDS_BYTES = 147456;

__device__ __forceinline__ float bf2f(unsigned short b) { return __uint_as_float(((unsigned)b) << 16); }
__device__ __forceinline__ float bflo(unsigned w) { return __uint_as_float(w << 16); }
__device__ __forceinline__ float bfhi(unsigned w) { return __uint_as_float(w & 0xffff0000u); }
__device__ __forceinline__ float silu(float v) { return v / (1.0f + __expf(-v)); }
__device__ __forceinline__ float wave_sum(float v) {
#pragma unroll
    for (int o = 1; o < 64; o <<= 1) v += __shfl_xor(v, o);
    return v;
}

struct Frame {
    LAS unsigned char* lds;
    int vcu, G;
    const float *x, *c, *mod_w, *mod_b, *norm_w, *w_gate, *w_up, *w_down, *hy_w_in, *conv_w, *conv_b, *A_log, *dt_bias, *ssd_D, *ssd_norm_w, *ret_norm_w, *hy_w_out, *dsa_w_in, *idx_k_norm_w, *dsa_w_out;
    const int* positions;
    float* out;
    unsigned char* ws;
};
#define WSP(T, off) ((T*)(F.ws + (off)))

template <class DMap> __device__ __forceinline__ void tr_item(const float* W, int ldn, int K, int k0, int sc, int ncl, bf16* WT, const DMap& dmap, LAS float* scr, int lane) {
    int cq = sc + 4 * (lane & 15); cq = cq < ncl - 4 ? cq : ncl - 4;
#pragma unroll 4
    for (int i = 0; i < 16; ++i) { const int kk = 4 * i + (lane >> 4); const f32x4 v = __builtin_nontemporal_load((const f32x4*)(W + (size_t)(k0 + kk) * ldn + cq));
        LAS float* d = scr + kk * 65 + 4 * (lane & 15); d[0] = v.x; d[1] = v.y; d[2] = v.z; d[3] = v.w; }
    LDS_WAIT(); asm volatile("" ::: "memory");
    const int c = lane & 7;
#pragma unroll
    for (int j = 0; j < 8; ++j) { const int n = (lane >> 3) + 8 * j; const LAS float* s = scr + (8 * c) * 65 + n;
        v4u o; o.x = pk2(s[0 * 65], s[1 * 65]); o.y = pk2(s[2 * 65], s[3 * 65]); o.z = pk2(s[4 * 65], s[5 * 65]); o.w = pk2(s[6 * 65], s[7 * 65]);
        if (sc + n < ncl) *(GAS v4u*)(WT + (size_t)dmap(sc + n) * K + k0 + 8 * c) = o; }
    LDS_WAIT(); asm volatile("" ::: "memory");
}
struct MapId { __device__ __forceinline__ int operator()(int c) const { return c; } };
struct MapGU { int up; __device__ __forceinline__ int operator()(int c) const { return 256 * (c >> 7) + 128 * up + (c & 127); } };
struct MapIn0 { __device__ __forceinline__ int operator()(int c) const { return c < 6144 ? c : (c < 6176 ? 14336 + (c - 6144) : c - 32); } };
constexpr int I_G = 32 * 88, I_D = 88 * 32, I_FFN = 2 * I_G + I_D, I_IN0 = 32 * 225, I_OUT0 = 64 * 32, I_IN1 = 32 * 54, I_OUT1 = 32 * 32;
constexpr int IT_IN0 = 4 * I_FFN, IT_OUT0 = IT_IN0 + I_IN0, IT_IN1 = IT_OUT0 + I_OUT0, IT_OUT1 = IT_IN1 + I_IN1, NITEMS = IT_OUT1 + I_OUT1;
#ifndef MK_TAILS
#define MK_TAILS 0
#endif
constexpr bool TAILS = MK_TAILS != 0;
constexpr int TGU = 4900, TGU2B = 2164, TIN1 = 3050;
constexpr int CV_P0A_LO = 0, CV_P0A_N = I_FFN;
constexpr int CV_P0B_LO = IT_IN0, CV_P0B_N = 2300;
constexpr int CV_P0C_LO = 2 * I_FFN + TGU, CV_P0C_N = I_FFN - TGU;
constexpr int CV_P0D_LO = 3 * I_FFN + TGU2B + TIN1, CV_P0D_N = I_FFN - TGU2B - TIN1;
constexpr int CV_GU0_LO = IT_IN0 + CV_P0B_N, CV_GU0_N = I_IN0 - CV_P0B_N;
constexpr int CV_IN0A_LO = IT_OUT0, CV_IN0A_N = I_OUT0;
constexpr int CV_IN0B_LO = I_FFN, CV_IN0B_N = I_FFN;
constexpr int CV_GU1_LO = 2 * I_FFN, CV_GU1_N = TGU;
constexpr int CV_GU2A_LO = IT_IN1, CV_GU2A_N = I_IN1 + I_OUT1;
constexpr int CV_GU2B_LO = 3 * I_FFN, CV_GU2B_N = TGU2B;
constexpr int CV_IN1_LO = 3 * I_FFN + TGU2B, CV_IN1_N = TIN1;
static_assert(CV_GU2B_LO + CV_GU2B_N == CV_IN1_LO && CV_IN1_LO + CV_IN1_N == CV_P0D_LO && CV_GU1_LO + CV_GU1_N == CV_P0C_LO && CV_P0B_LO + CV_P0B_N == CV_GU0_LO, "conversion schedule covers every item once");
__device__ __forceinline__ void conv_items(Frame& F, int first, int count, int widx, int nworkers) {
    int tid_ = threadIdx.x; asm volatile("" : "+v"(tid_)); const int TID = tid_, LANE = TID & 63, WAVE = __builtin_amdgcn_readfirstlane(TID >> 6);
    LAS float* scr = (LAS float*)(F.lds + WAVE * 16640);
    bf16* Wgu = WSP(bf16, WS_WGU); bf16* Wd = WSP(bf16, WS_WD);
    for (int k = widx * NWAVES + WAVE; k < count; k += nworkers * NWAVES) {
        int r = first + k;
        if (r < 4 * I_FFN) { const int s = r / I_FFN; r -= s * I_FFN;
            if (r < 2 * I_G) { const int up = r / I_G; r -= up * I_G; const int kb = r / 88, nb = r % 88;
                const float* W = (up ? F.w_up : F.w_gate) + (size_t)s * D * FF;
                tr_item(W, FF, D, 64 * kb, 64 * nb, FF, Wgu + (size_t)s * WGU_ELEMS, MapGU{up}, scr, LANE); }
            else { r -= 2 * I_G; const int kb = r / 32, nb = r % 32;
                tr_item(F.w_down + (size_t)s * FF * D, D, FF, 64 * kb, 64 * nb, D, Wd + (size_t)s * WD_ELEMS, MapId{}, scr, LANE); }
            continue; }
        r -= 4 * I_FFN;
        if (r < I_IN0) { const int kb = r / 225, nb = r % 225; tr_item(F.hy_w_in, IN0, D, 64 * kb, 64 * nb, IN0, WSP(bf16, WS_WIN0), MapIn0{}, scr, LANE); continue; }
        r -= I_IN0;
        if (r < I_OUT0) { const int kb = r / 32, nb = r % 32; tr_item(F.hy_w_out, D, 2 * D, 64 * kb, 64 * nb, D, WSP(bf16, WS_WOUT0), MapId{}, scr, LANE); continue; }
        r -= I_OUT0;
        if (r < I_IN1) { const int kb = r / 54, nb = r % 54; tr_item(F.dsa_w_in, IN1, D, 64 * kb, 64 * nb, IN1, WSP(bf16, WS_WIN1), MapId{}, scr, LANE); continue; }
        r -= I_IN1;
        { const int kb = r / 32, nb = r % 32; tr_item(F.dsa_w_out, D, D, 64 * kb, 64 * nb, D, WSP(bf16, WS_WOUT1), MapId{}, scr, LANE); }
    }
}
__device__ __forceinline__ void p0_prologue(Frame& F) {
    int tid_ = threadIdx.x; asm volatile("" : "+v"(tid_)); const int TID = tid_, LANE = TID & 63, WAVE = __builtin_amdgcn_readfirstlane(TID >> 6); (void)LANE; (void)WAVE;

    {
        LAS float* cond = (LAS float*)F.lds;
        LAS float* red = (LAS float*)(F.lds + 32768);
        for (int i = TID; i < NB * D; i += NWAVES * 64) cond[i] = silu(F.c[i]);
        __syncthreads();
        float* MODS = WSP(float, WS_MODS);
        for (int u = F.vcu; u < 256; u += F.G) {
            const int col0 = 144 * u, layer = col0 / MODW, j0 = col0 % MODW;
            const int cq = TID % 36, ks = TID / 36;
            if (ks < 14) {
                f32x4 a0 = {0.f, 0.f, 0.f, 0.f}, a1 = a0, a2 = a0, a3 = a0;
                const int kb = ks * 147, ke = (kb + 147 < D) ? kb + 147 : D;
                const float* wp = F.mod_w + (size_t)layer * D * MODW + j0 + 4 * cq;
#pragma unroll 4
                for (int k = kb; k < ke; ++k) { const f32x4 w = *(const f32x4*)(wp + (size_t)k * MODW);
                    a0 += cond[k] * w; a1 += cond[D + k] * w; a2 += cond[2 * D + k] * w; a3 += cond[3 * D + k] * w; }
                LAS float* r = red + (ks * 36 + cq) * 16;
                *(LAS f32x4*)(r) = a0; *(LAS f32x4*)(r + 4) = a1; *(LAS f32x4*)(r + 8) = a2; *(LAS f32x4*)(r + 12) = a3;
            }
            __syncthreads();
            for (int o = TID; o < 576; o += NWAVES * 64) { const int cq2 = o / 16, r = o % 16, b = r / 4, e = r % 4; float s = 0.f;
#pragma unroll
                for (int k2 = 0; k2 < 14; ++k2) s += red[(k2 * 36 + cq2) * 16 + r];
                const int j = j0 + 4 * cq2 + e;
                MODS[(size_t)(layer * 4 + b) * MODW + j] = s + F.mod_b[layer * MODW + j]; }
            __syncthreads();
        }
    }
    {
        const int gt = F.vcu * NWAVES * 64 + TID, NT = F.G * NWAVES * 64;
        const double INV2PI = 0.15915494309189535;
        float* rc = WSP(float, WS_RTC); float* rs = WSP(float, WS_RTS);
        for (int idx = gt; idx < M * 128; idx += NT) { const int row = idx >> 7, i = idx & 127;
            const double inv = exp2(-(double)i * (13.287712379549449 / 128.0));
            const double rev = (double)F.positions[row] * inv * INV2PI; const float fr = (float)(rev - rint(rev));
            rc[idx] = __builtin_amdgcn_cosf(fr); rs[idx] = __builtin_amdgcn_sinf(fr); }
        float* qc = WSP(float, WS_RTQ); float* qs = qc + M * 16;
        for (int idx = gt; idx < M * 16; idx += NT) { const int row = idx >> 4, i = idx & 15;
            const double inv = exp2(-(double)i * (18.931568569324174 / 16.0));
            const double rev = (double)F.positions[row] * inv * INV2PI; const float fr = (float)(rev - rint(rev));
            qc[idx] = __builtin_amdgcn_cosf(fr); qs[idx] = __builtin_amdgcn_sinf(fr); }
        float* ic = WSP(float, WS_RTI); float* is = ic + M * 8;
        for (int idx = gt; idx < M * 8; idx += NT) { const int row = idx >> 3, i = idx & 7;
            const double inv = exp2(-(double)i * (18.931568569324174 / 8.0));
            const double rev = (double)F.positions[row] * inv * INV2PI; const float fr = (float)(rev - rint(rev));
            ic[idx] = __builtin_amdgcn_cosf(fr); is[idx] = __builtin_amdgcn_sinf(fr); }
    }
    __syncthreads();
    if (!TAILS) conv_items(F, 0, NITEMS, F.vcu, F.G);
    else { conv_items(F, CV_P0A_LO, CV_P0A_N, F.vcu, F.G); conv_items(F, CV_P0B_LO, CV_P0B_N, F.vcu, F.G); conv_items(F, CV_P0C_LO, CV_P0C_N, F.vcu, F.G); conv_items(F, CV_P0D_LO, CV_P0D_N, F.vcu, F.G); }
}
__device__ __forceinline__ void thin_phase(Frame& F, int prevq, int nextq) {
    int tid_ = threadIdx.x; asm volatile("" : "+v"(tid_)); const int TID = tid_, LANE = TID & 63, WAVE = __builtin_amdgcn_readfirstlane(TID >> 6);
    const int gw = F.vcu * NWAVES + WAVE, NGW = F.G * NWAVES;
    const float* xin = (prevq <= 0) ? F.x : F.out;
    const bf16* Y = WSP(bf16, WS_Y); const float* SSQ = WSP(float, WS_SSQ); const float* MODS = WSP(float, WS_MODS); bf16* H = WSP(bf16, WS_H);
    for (int rg = gw; rg < M / 2; rg += NGW) {
        const int row0 = rg * 2, b = row0 >> 11;
        f32x4 xv[2][8];
#pragma unroll
        for (int rr = 0; rr < 2; ++rr) { const f32x4* xr = (const f32x4*)(xin + (size_t)(row0 + rr) * D) + LANE;
#pragma unroll
            for (int j = 0; j < 8; ++j) xv[rr][j] = xr[64 * j]; }
        if (prevq >= 0) {
            const int pl = prevq / 3, pj = prevq % 3; const float rw = (pj == 1) ? 1.0f : 0.5f;
            float sc[2];
#pragma unroll
            for (int rr = 0; rr < 2; ++rr) { float s = (LANE < 32) ? SSQ[(size_t)(row0 + rr) * 32 + LANE] : 0.f; s = wave_sum(s); sc[rr] = rw * rsqrtf(s * (1.0f / D) + EPS); }
            const f32x4* pw = (const f32x4*)(F.norm_w + (size_t)(pl * 6 + 2 * pj + 1) * D) + LANE;
            const f32x4* gt = (const f32x4*)(MODS + (size_t)(pl * 4 + b) * MODW + (3 * pj + 2) * D) + LANE;
#pragma unroll
            for (int j = 0; j < 8; ++j) { const f32x4 gp = gt[64 * j] * pw[64 * j];
#pragma unroll
                for (int rr = 0; rr < 2; ++rr) { const unsigned long long yy = *((const unsigned long long*)(Y + (size_t)(row0 + rr) * D) + LANE + 64 * j); const unsigned y0 = (unsigned)yy, y1 = (unsigned)(yy >> 32);
                    const f32x4 yv = {bflo(y0), bfhi(y0), bflo(y1), bfhi(y1)};
                    xv[rr][j] = xv[rr][j] + sc[rr] * (gp * yv); *((f32x4*)(F.out + (size_t)(row0 + rr) * D) + LANE + 64 * j) = xv[rr][j]; }
                if (j & 1) asm volatile("" ::: "memory"); }
        }
        if (nextq >= 0) {
            const int nl = nextq / 3, nj = nextq % 3;
            float rstd[2];
#pragma unroll
            for (int rr = 0; rr < 2; ++rr) { float s = 0.f;
#pragma unroll
                for (int j = 0; j < 8; ++j) s += (xv[rr][j].x * xv[rr][j].x + xv[rr][j].y * xv[rr][j].y) + (xv[rr][j].z * xv[rr][j].z + xv[rr][j].w * xv[rr][j].w);
                rstd[rr] = rsqrtf(wave_sum(s) * (1.0f / D) + EPS); }
            const f32x4* pw = (const f32x4*)(F.norm_w + (size_t)(nl * 6 + 2 * nj) * D) + LANE;
            const f32x4* sh = (const f32x4*)(MODS + (size_t)(nl * 4 + b) * MODW + (3 * nj) * D) + LANE;
            const f32x4* scp = (const f32x4*)(MODS + (size_t)(nl * 4 + b) * MODW + (3 * nj + 1) * D) + LANE;
#pragma unroll
            for (int j = 0; j < 8; ++j) { const f32x4 ps = pw[64 * j] * (scp[64 * j] + 1.0f), sv = sh[64 * j];
#pragma unroll
                for (int rr = 0; rr < 2; ++rr) { const f32x4 h = (xv[rr][j] * rstd[rr]) * ps + sv;
                    *((unsigned long long*)(H + (size_t)(row0 + rr) * D) + LANE + 64 * j) = (unsigned long long)pk2(h.x, h.y) | ((unsigned long long)pk2(h.z, h.w) << 32); }
                if (j & 1) asm volatile("" ::: "memory"); }
        }
    }
}

typedef float f32x16 __attribute__((ext_vector_type(16)));
typedef float f32x2v __attribute__((ext_vector_type(2)));
typedef __bf16 bf16x2v __attribute__((ext_vector_type(2)));
__device__ __forceinline__ unsigned pkbf(float lo, float hi) { return __builtin_bit_cast(unsigned, __builtin_convertvector((f32x2v){lo, hi}, bf16x2v)); }
#define MFMA32(a, b, c) __builtin_amdgcn_mfma_f32_32x32x16_bf16((a), (b), (c), 0, 0, 0)
template <int S> __device__ __forceinline__ bf16x8 pack8(const f32x16& x) {
    v4u p; p.x = pkbf(x[8 * S + 0], x[8 * S + 1]); p.y = pkbf(x[8 * S + 2], x[8 * S + 3]); p.z = pkbf(x[8 * S + 4], x[8 * S + 5]); p.w = pkbf(x[8 * S + 6], x[8 * S + 7]);
    return __builtin_bit_cast(bf16x8, p);
}
__device__ __forceinline__ f32x16 zero16() { f32x16 z;
#pragma unroll
    for (int i = 0; i < 16; ++i) z[i] = 0.f;
    return z; }
struct IdFrag { bf16x8 f0, f1; };
__device__ __forceinline__ IdFrag make_id(int r, int hh) { IdFrag I;
#pragma unroll
    for (int j = 0; j < 8; ++j) { I.f0[j] = (r == 8 * hh + j) ? (short)0x3F80 : (short)0; I.f1[j] = (r == 16 + 8 * hh + j) ? (short)0x3F80 : (short)0; }
    return I; }
__device__ __forceinline__ bf16x8 lfrag(const LAS unsigned char* img, int stride, int row, int col) { return *(const LAS bf16x8*)(img + row * stride + col * 2); }
__device__ __forceinline__ f32x16 to_acc_lds(const LAS unsigned char* img, int stride, int row0, int col0, int r, int hh, const IdFrag& I) {
    f32x16 x = MFMA32(lfrag(img, stride, row0 + r, col0 + 8 * hh), I.f0, zero16());
    return MFMA32(lfrag(img, stride, row0 + r, col0 + 16 + 8 * hh), I.f1, x);
}
__device__ __forceinline__ f32x16 to_acc_glb(const bf16* base, size_t ld, int r, int hh, const IdFrag& I) {
    f32x16 x = MFMA32(*(const bf16x8*)(base + (size_t)r * ld + 8 * hh), I.f0, zero16());
    return MFMA32(*(const bf16x8*)(base + (size_t)r * ld + 16 + 8 * hh), I.f1, x);
}
__device__ __forceinline__ int crow(int i, int hh) { return (i & 3) + 8 * (i >> 2) + 4 * hh; }

constexpr int XS_STRIDE = 528, BC_STRIDE = 272;
constexpr int L0_XS = 0, L0_BM = 128 * XS_STRIDE, L0_CM = L0_BM + 128 * BC_STRIDE, L0_TAB = L0_CM + 128 * BC_STRIDE;
constexpr int L0_K = 0, L0_V = 128 * XS_STRIDE, L0_Q = 128 * XS_STRIDE, L0_RS = 2 * 128 * XS_STRIDE;
static_assert(L0_TAB + 3 * 2048 <= LDSCTL_OFF && L0_RS + 4096 + 512 <= LDSCTL_OFF, "LDS map (layer-0 mixer)");

__device__ __forceinline__ void stage_conv(Frame& F, int TID, size_t R0, int g, bool withC) {
    const int ci = TID & 63, rg = TID >> 6;
    if (!withC && ci >= 48) return;
    const int xc = ci < 32 ? g * 256 + 8 * ci : (ci < 48 ? 2048 + g * 128 + 8 * (ci - 32) : 3072 + g * 128 + 8 * (ci - 48));
    LAS unsigned char* dst = F.lds + (ci < 32 ? L0_XS + ci * 16 : (ci < 48 ? L0_BM + (ci - 32) * 16 : L0_CM + (ci - 48) * 16));
    const int dstride = ci < 32 ? XS_STRIDE : BC_STRIDE;
    float w[4][8], a0[8];
#pragma unroll
    for (int j = 0; j < 4; ++j) { const f32x4 p = *(const f32x4*)(F.conv_w + (size_t)j * 4096 + xc), q = *(const f32x4*)(F.conv_w + (size_t)j * 4096 + xc + 4);
        w[j][0] = p.x; w[j][1] = p.y; w[j][2] = p.z; w[j][3] = p.w; w[j][4] = q.x; w[j][5] = q.y; w[j][6] = q.z; w[j][7] = q.w; }
    { const f32x4 p = *(const f32x4*)(F.conv_b + xc), q = *(const f32x4*)(F.conv_b + xc + 4); a0[0] = p.x; a0[1] = p.y; a0[2] = p.z; a0[3] = p.w; a0[4] = q.x; a0[5] = q.y; a0[6] = q.z; a0[7] = q.w; }
    const bf16* src = WSP(bf16, WS_BIG) + (R0 + rg * 16) * IN0P + 2048 + xc;
    const int t0 = (int)(R0 & (SEQ - 1)) + rg * 16;
    float h[3][8];
#pragma unroll
    for (int k = 0; k < 3; ++k) { v4u u = {0u, 0u, 0u, 0u}; if (t0 - 3 + k >= 0) u = *(const v4u*)(src + (ptrdiff_t)(k - 3) * IN0P);
        h[k][0] = bflo(u.x); h[k][1] = bfhi(u.x); h[k][2] = bflo(u.y); h[k][3] = bfhi(u.y); h[k][4] = bflo(u.z); h[k][5] = bfhi(u.z); h[k][6] = bflo(u.w); h[k][7] = bfhi(u.w); }
#pragma unroll 4
    for (int i = 0; i < 16; ++i) { const v4u u = *(const v4u*)(src + (size_t)i * IN0P);
        const float c[8] = {bflo(u.x), bfhi(u.x), bflo(u.y), bfhi(u.y), bflo(u.z), bfhi(u.z), bflo(u.w), bfhi(u.w)};
        float o[8];
#pragma unroll
        for (int e = 0; e < 8; ++e) { o[e] = silu(a0[e] + w[0][e] * h[0][e] + w[1][e] * h[1][e] + w[2][e] * h[2][e] + w[3][e] * c[e]); h[0][e] = h[1][e]; h[1][e] = h[2][e]; h[2][e] = c[e]; }
        v4u p; p.x = pkbf(o[0], o[1]); p.y = pkbf(o[2], o[3]); p.z = pkbf(o[4], o[5]); p.w = pkbf(o[6], o[7]);
        *(LAS v4u*)(dst + (rg * 16 + i) * dstride) = p; }
}
__device__ __forceinline__ void ssd_tables(Frame& F, int TID, int LANE, int WAVE, LAS float* tab, size_t R0, int g, float* cd) {
    LAS float* cuml = tab; LAS float* dtl = tab + 512; LAS float* wl = tab + 1024;
    { const int row = TID >> 2, hd = TID & 3, h2 = g * 4 + hd; const float v = WSP(float, WS_DTB)[(R0 + row) * 256 + h2] + F.dt_bias[h2];
      const float dt = v > 20.f ? v : log1pf(__expf(v)); dtl[hd * 128 + row] = dt; wl[hd * 128 + row] = -dt * __expf(F.A_log[h2]); }
    __syncthreads();
    if (WAVE < 4) { const float a0 = wl[WAVE * 128 + 2 * LANE], a1 = wl[WAVE * 128 + 2 * LANE + 1]; float p = a0 + a1;
#pragma unroll
        for (int o = 1; o < 64; o <<= 1) { const float t = __shfl_up(p, o); if (LANE >= o) p += t; }
        const float tot = __shfl(p, 63), c0 = p - a1;
        cuml[WAVE * 128 + 2 * LANE] = c0; cuml[WAVE * 128 + 2 * LANE + 1] = p;
        wl[WAVE * 128 + 2 * LANE] = dtl[WAVE * 128 + 2 * LANE] * __expf(tot - c0); wl[WAVE * 128 + 2 * LANE + 1] = dtl[WAVE * 128 + 2 * LANE + 1] * __expf(tot - p);
        if (cd != nullptr && LANE == 0) cd[WAVE] = __expf(tot); }
    __syncthreads();
}
__device__ __forceinline__ void m0_states(Frame& F) {
    int tid_ = threadIdx.x; asm volatile("" : "+v"(tid_)); const int TID = tid_, LANE = TID & 63, WAVE = __builtin_amdgcn_readfirstlane(TID >> 6);
    const int r_ = LANE & 31, hh_ = LANE >> 5; const IdFrag I = make_id(r_, hh_);
    for (int u = F.vcu; u < 1024; u += F.G) {
        __syncthreads();
        int r = r_, hh = hh_; asm volatile("" : "+v"(r), "+v"(hh));
        if (u < 512) {
            const int bc = u >> 3, g = u & 7; const size_t R0 = (size_t)bc * 128;
            stage_conv(F, TID, R0, g, false);
            LAS float* tab = (LAS float*)(F.lds + L0_TAB);
            ssd_tables(F, TID, LANE, WAVE, tab, R0, g, WSP(float, WS_CD) + bc * 32 + g * 4);
            const LAS float* wl = tab + 1024;
            const int head = WAVE >> 1, pt = WAVE & 1;
            f32x16 acc[4];
#pragma unroll
            for (int t = 0; t < 4; ++t) acc[t] = zero16();
#pragma unroll 1
            for (int sb = 0; sb < 4; ++sb) {
                f32x16 X = to_acc_lds(F.lds + L0_XS, XS_STRIDE, sb * 32, head * 64 + pt * 32, r, hh, I);
#pragma unroll
                for (int g4 = 0; g4 < 4; ++g4) { const f32x4 wv = *(const LAS f32x4*)(wl + head * 128 + sb * 32 + 8 * g4 + 4 * hh);
#pragma unroll
                    for (int e = 0; e < 4; ++e) X[4 * g4 + e] *= wv[e]; }
                const bf16x8 A0 = pack8<0>(X), A1 = pack8<1>(X);
#pragma unroll
                for (int nt = 0; nt < 4; ++nt) { const f32x16 XB = to_acc_lds(F.lds + L0_BM, BC_STRIDE, sb * 32, nt * 32, r, hh, I);
                    acc[nt] = MFMA32(A0, pack8<0>(XB), acc[nt]); acc[nt] = MFMA32(A1, pack8<1>(XB), acc[nt]); }
            }
            bf16* dst = WSP(bf16, WS_SST) + ((size_t)(bc * 32 + g * 4 + head) * 64 + pt * 32) * 128;
#pragma unroll
            for (int nt = 0; nt < 4; ++nt)
#pragma unroll
                for (int i = 0; i < 16; ++i) dst[(size_t)crow(i, hh) * 128 + nt * 32 + r] = (bf16)(pkbf(acc[nt][i], acc[nt][i]) & 0xffffu);
        } else {
            const int u2 = u - 512, bc = u2 >> 3, h = u2 & 7; const size_t R0 = (size_t)bc * 128;
            const bf16* PB = WSP(bf16, WS_BIG);
            for (int i = TID; i < 4096; i += NWAVES * 64) { const int row = i >> 5, ch = i & 31;
                *(LAS v4u*)(F.lds + L0_K + row * XS_STRIDE + ch * 16) = *(const v4u*)(PB + (R0 + row) * IN0P + 8192 + h * 256 + ch * 8);
                *(LAS v4u*)(F.lds + L0_V + row * XS_STRIDE + ch * 16) = *(const v4u*)(PB + (R0 + row) * IN0P + 10240 + h * 256 + ch * 8); }
            __syncthreads();
            const float lg = log2f(1.0f - exp2f(-5.0f - (float)h));
            bf16* dstb = WSP(bf16, WS_RST) + ((size_t)(bc * 8 + h) * 256 + WAVE * 32) * 256;
#pragma unroll 1
            for (int half = 0; half < 2; ++half) {
                f32x16 acc[4];
#pragma unroll
                for (int t = 0; t < 4; ++t) acc[t] = zero16();
#pragma unroll 1
                for (int sb = 0; sb < 4; ++sb) {
                    const f32x16 XV = to_acc_lds(F.lds + L0_V, XS_STRIDE, sb * 32, WAVE * 32, r, hh, I);
                    const bf16x8 A0 = pack8<0>(XV), A1 = pack8<1>(XV);
#pragma unroll
                    for (int t = 0; t < 4; ++t) { f32x16 XK = to_acc_lds(F.lds + L0_K, XS_STRIDE, sb * 32, (half * 4 + t) * 32, r, hh, I);
#pragma unroll
                        for (int i = 0; i < 16; ++i) XK[i] *= exp2f((float)(127 - (sb * 32 + crow(i, hh))) * lg);
                        acc[t] = MFMA32(A0, pack8<0>(XK), acc[t]); acc[t] = MFMA32(A1, pack8<1>(XK), acc[t]); }
                }
#pragma unroll
                for (int t = 0; t < 4; ++t)
#pragma unroll
                    for (int i = 0; i < 16; ++i) dstb[(size_t)crow(i, hh) * 256 + (half * 4 + t) * 32 + r] = (bf16)(pkbf(acc[t][i], acc[t][i]) & 0xffffu);
            }
        }
    }
}
__device__ __forceinline__ void m0_chunkscan(Frame& F) {
    int tid_ = threadIdx.x; asm volatile("" : "+v"(tid_)); const int TID = tid_;
    const int gt = F.vcu * NWAVES * 64 + TID, NT = F.G * NWAVES * 64;
    const bf16* SST = WSP(bf16, WS_SST); const float* CD = WSP(float, WS_CD); bf16* HP = WSP(bf16, WS_HP);
    for (int idx = gt; idx < NB * 32 * 64 * 32; idx += NT) {
        const int b = idx >> 16, rem = idx & 65535, h = rem >> 11;
        f32x4 st = {0.f, 0.f, 0.f, 0.f};
        for (int c = 0; c < 16; ++c) { const size_t off = ((size_t)((b * 16 + c) * 32) * 2048 + rem) * 4;
            *(unsigned long long*)(HP + off) = (unsigned long long)pkbf(st.x, st.y) | ((unsigned long long)pkbf(st.z, st.w) << 32);
            const float a = CD[(b * 16 + c) * 32 + h]; const unsigned long long sv = *(const unsigned long long*)(SST + off); const unsigned s0 = (unsigned)sv, s1 = (unsigned)(sv >> 32);
            st = st * a + (f32x4){bflo(s0), bfhi(s0), bflo(s1), bfhi(s1)}; }
    }
    const bf16* RST = WSP(bf16, WS_RST); bf16* RPT = WSP(bf16, WS_RPT);
    for (int idx = gt; idx < NB * 8 * 256 * 64; idx += NT) {
        const int b = idx >> 17, rem = idx & 131071, h = rem >> 14;
        const float gc = exp2f(128.0f * log2f(1.0f - exp2f(-5.0f - (float)h)));
        f32x4 st = {0.f, 0.f, 0.f, 0.f};
        for (int c = 0; c < 16; ++c) { const size_t off = ((size_t)((b * 16 + c) * 8) * 16384 + rem) * 4;
            *(unsigned long long*)(RPT + off) = (unsigned long long)pkbf(st.x, st.y) | ((unsigned long long)pkbf(st.z, st.w) << 32);
            const unsigned long long sv = *(const unsigned long long*)(RST + off); const unsigned s0 = (unsigned)sv, s1 = (unsigned)(sv >> 32);
            st = st * gc + (f32x4){bflo(s0), bfhi(s0), bflo(s1), bfhi(s1)}; }
    }
}
__device__ __forceinline__ void m0_out_ssd(Frame& F, const int dbg) {
    int tid_ = threadIdx.x; asm volatile("" : "+v"(tid_)); const int TID = tid_, LANE = TID & 63, WAVE = __builtin_amdgcn_readfirstlane(TID >> 6);
    const int r_ = LANE & 31, hh_ = LANE >> 5; const IdFrag I = make_id(r_, hh_);
    const bf16* PB = WSP(bf16, WS_BIG); bf16* MIX = WSP(bf16, WS_MIX);
    for (int u = F.vcu; u < 512; u += F.G) {
        __syncthreads();
        int r = r_, hh = hh_; asm volatile("" : "+v"(r), "+v"(hh));
        {
            const int bc = u >> 3, g = u & 7; const size_t R0 = (size_t)bc * 128;
            if (!(dbg & 32)) stage_conv(F, TID, R0, g, true);
            LAS float* tab = (LAS float*)(F.lds + L0_TAB);
            if (!(dbg & 64)) ssd_tables(F, TID, LANE, WAVE, tab, R0, g, nullptr);
            const int head = WAVE >> 1, pt = WAVE & 1, hd = g * 4 + head;
            const LAS float* cuml = tab + head * 128; const LAS float* dtl = tab + 512 + head * 128;
            const float Dh = F.ssd_D[hd];
            bf16x8 hpf[8];
            { const bf16* hp = WSP(bf16, WS_HP) + ((size_t)(bc * 32 + hd) * 64 + pt * 32 + r) * 128 + 8 * hh;
#pragma unroll
              for (int ks = 0; ks < 8; ++ks) hpf[ks] = *(const bf16x8*)(hp + 16 * ks); }
#pragma unroll 1
            for (int lt = 0; lt < 4; ++lt) {
                f32x16 y = zero16();
#pragma unroll
                for (int ks = 0; ks < 8; ++ks) if (!(dbg & 2)) y = MFMA32(lfrag(F.lds + L0_CM, BC_STRIDE, lt * 32 + r, 16 * ks + 8 * hh), hpf[ks], y);
#pragma unroll
                for (int i = 0; i < 16; ++i) y[i] *= __expf(cuml[lt * 32 + crow(i, hh)]);
                const float cl = cuml[lt * 32 + r];
                f32x16 XS = zero16();
#pragma unroll 1
                for (int st = 0; st <= lt; ++st) { if (dbg & 4) break;
                    f32x16 cbt = zero16();
#pragma unroll
                    for (int ks = 0; ks < 8; ++ks) cbt = MFMA32(lfrag(F.lds + L0_BM, BC_STRIDE, st * 32 + r, 16 * ks + 8 * hh), lfrag(F.lds + L0_CM, BC_STRIDE, lt * 32 + r, 16 * ks + 8 * hh), cbt);
#pragma unroll
                    for (int g4 = 0; g4 < 4; ++g4) { const f32x4 cs = *(const LAS f32x4*)(cuml + st * 32 + 8 * g4 + 4 * hh), ds = *(const LAS f32x4*)(dtl + st * 32 + 8 * g4 + 4 * hh);
#pragma unroll
                        for (int e = 0; e < 4; ++e) { const int s = st * 32 + 8 * g4 + 4 * hh + e; const float v = cbt[4 * g4 + e] * __expf(cl - cs[e]) * ds[e]; cbt[4 * g4 + e] = (s <= lt * 32 + r) ? v : 0.f; } }
                    XS = to_acc_lds(F.lds + L0_XS, XS_STRIDE, st * 32, head * 64 + pt * 32, r, hh, I);
                    y = MFMA32(pack8<0>(cbt), pack8<0>(XS), y); y = MFMA32(pack8<1>(cbt), pack8<1>(XS), y);
                }
                f32x16 Z = zero16(); if (!(dbg & 16)) Z = to_acc_glb(PB + (R0 + lt * 32) * IN0P + hd * 64 + pt * 32, IN0P, r, hh, I);
                bf16* dst = MIX + (R0 + lt * 32) * 4096 + hd * 64 + pt * 32 + r;
#pragma unroll
                for (int i = 0; i < 16; ++i) { const float v = (y[i] + Dh * XS[i]) * silu(Z[i]); if (!(dbg & 1)) dst[(size_t)crow(i, hh) * 4096] = (bf16)(pkbf(v, v) & 0xffffu); else if (v == 1.2345e30f) dst[0] = 0; }
            }
        }
    }
    __syncthreads();
}
__device__ __forceinline__ void m0_out_ret(Frame& F, const int dbg) {
    int tid_ = threadIdx.x; asm volatile("" : "+v"(tid_)); const int TID = tid_, LANE = TID & 63, WAVE = __builtin_amdgcn_readfirstlane(TID >> 6);
    const int r_ = LANE & 31, hh_ = LANE >> 5; const IdFrag I = make_id(r_, hh_);
    const bf16* PB = WSP(bf16, WS_BIG); bf16* MIX = WSP(bf16, WS_MIX);
    for (int u = 512 + F.vcu; u < 1024; u += F.G) {
        __syncthreads();
        int r = r_, hh = hh_; asm volatile("" : "+v"(r), "+v"(hh));
        const int u2 = u - 512, bc = u2 >> 3, h = u2 & 7; const size_t R0 = (size_t)bc * 128;
        if (!(dbg & 32)) for (int i = TID; i < 4096; i += NWAVES * 64) { const int row = i >> 5, ch = i & 31;
            *(LAS v4u*)(F.lds + L0_K + row * XS_STRIDE + ch * 16) = *(const v4u*)(PB + (R0 + row) * IN0P + 8192 + h * 256 + ch * 8);
            *(LAS v4u*)(F.lds + L0_Q + row * XS_STRIDE + ch * 16) = *(const v4u*)(PB + (R0 + row) * IN0P + 6144 + h * 256 + ch * 8); }
        __syncthreads();
        const float lg = log2f(1.0f - exp2f(-5.0f - (float)h));
        const int dv0 = WAVE * 32;
        f32x16 y[4];
        {
            const bf16* rpt = WSP(bf16, WS_RPT) + ((size_t)(bc * 8 + h) * 256 + dv0 + r) * 256 + 8 * hh;
#pragma unroll
            for (int lt = 0; lt < 4; ++lt) y[lt] = zero16();
#pragma unroll 2
            for (int ks = 0; ks < 16; ++ks) { if (dbg & 2) break; const bf16x8 rf = *(const bf16x8*)(rpt + 16 * ks);
#pragma unroll
                for (int lt = 0; lt < 4; ++lt) y[lt] = MFMA32(lfrag(F.lds + L0_Q, XS_STRIDE, lt * 32 + r, 16 * ks + 8 * hh), rf, y[lt]); }
#pragma unroll
            for (int lt = 0; lt < 4; ++lt)
#pragma unroll
                for (int i = 0; i < 16; ++i) y[lt][i] *= exp2f((float)(lt * 32 + crow(i, hh) + 1) * lg);
        }
#pragma unroll
        for (int lt = 0; lt < 4; ++lt) {
#pragma unroll 1
            for (int st = 0; st <= lt; ++st) { if (dbg & 4) break;
                const f32x16 XV = to_acc_glb(PB + (R0 + st * 32) * IN0P + 10240 + h * 256 + dv0, IN0P, r, hh, I);
                f32x16 sct = zero16();
#pragma unroll 4
                for (int ks = 0; ks < 16; ++ks) sct = MFMA32(lfrag(F.lds + L0_K, XS_STRIDE, st * 32 + r, 16 * ks + 8 * hh), lfrag(F.lds + L0_Q, XS_STRIDE, lt * 32 + r, 16 * ks + 8 * hh), sct);
#pragma unroll
                for (int i = 0; i < 16; ++i) { const int d = (lt - st) * 32 + r - crow(i, hh); sct[i] = (d >= 0) ? sct[i] * exp2f((float)d * lg) : 0.f; }
                y[lt] = MFMA32(pack8<0>(sct), pack8<0>(XV), y[lt]); y[lt] = MFMA32(pack8<1>(sct), pack8<1>(XV), y[lt]);
            }
        }
        asm volatile("" : "+v"(r), "+v"(hh));
        LAS float* rsum = (LAS float*)(F.lds + L0_RS);
        if (!(dbg & 8))
#pragma unroll
        for (int lt = 0; lt < 4; ++lt)
#pragma unroll
            for (int i = 0; i < 16; ++i) { float s = y[lt][i] * y[lt][i];
#pragma unroll
                for (int o = 1; o < 32; o <<= 1) s += __shfl_xor(s, o);
                if (r == 0) rsum[(lt * 32 + crow(i, hh)) * 8 + WAVE] = s; }
        __syncthreads();
        if (TID < 128) { const f32x4 s0 = *(const LAS f32x4*)(rsum + TID * 8), s1 = *(const LAS f32x4*)(rsum + TID * 8 + 4);
            rsum[1024 + TID] = rsqrtf((((s0.x + s0.y) + (s0.z + s0.w)) + ((s1.x + s1.y) + (s1.z + s1.w))) * (1.0f / 256.0f) + EPS); }
        __syncthreads();
        asm volatile("" : "+v"(r), "+v"(hh));
        const float w = F.ret_norm_w[h * 256 + dv0 + r];
#pragma unroll
        for (int lt = 0; lt < 4; ++lt) {
            f32x16 G = zero16(); if (!(dbg & 16)) G = to_acc_glb(PB + (R0 + lt * 32) * IN0P + 12288 + h * 256 + dv0, IN0P, r, hh, I);
            bf16* dst = MIX + (R0 + lt * 32) * 4096 + 2048 + h * 256 + dv0 + r;
#pragma unroll
            for (int i = 0; i < 16; ++i) { const float rstd = rsum[1024 + lt * 32 + crow(i, hh)];
                const float v = silu(G[i]) * (y[lt][i] * rstd * w); if (!(dbg & 1)) dst[(size_t)crow(i, hh) * 4096] = (bf16)(pkbf(v, v) & 0xffffu); else if (v == 1.2345e30f) dst[0] = 0; }
        }
    }
    __syncthreads();
}
__device__ __forceinline__ void m0_post(Frame& F) {
    int tid_ = threadIdx.x; asm volatile("" : "+v"(tid_)); const int TID = tid_, LANE = TID & 63, WAVE = __builtin_amdgcn_readfirstlane(TID >> 6);
    const int gw = F.vcu * NWAVES + WAVE, NGW = F.G * NWAVES;
    bf16* MIX = WSP(bf16, WS_MIX);
    for (int row = gw; row < M; row += NGW) {
        v4u v[4]; float s = 0.f;
#pragma unroll
        for (int j = 0; j < 4; ++j) { v[j] = *(const v4u*)(MIX + (size_t)row * 4096 + 8 * LANE + 512 * j);
            const float a0 = bflo(v[j].x), a1 = bfhi(v[j].x), a2 = bflo(v[j].y), a3 = bfhi(v[j].y), a4 = bflo(v[j].z), a5 = bfhi(v[j].z), a6 = bflo(v[j].w), a7 = bfhi(v[j].w);
            s += ((a0 * a0 + a1 * a1) + (a2 * a2 + a3 * a3)) + ((a4 * a4 + a5 * a5) + (a6 * a6 + a7 * a7)); }
        const float rstd = rsqrtf(wave_sum(s) * (1.0f / 2048.0f) + EPS);
#pragma unroll
        for (int j = 0; j < 4; ++j) { const int c = 8 * LANE + 512 * j; const f32x4 w0 = *(const f32x4*)(F.ssd_norm_w + c), w1 = *(const f32x4*)(F.ssd_norm_w + c + 4);
            v4u o; o.x = pkbf(bflo(v[j].x) * rstd * w0.x, bfhi(v[j].x) * rstd * w0.y); o.y = pkbf(bflo(v[j].y) * rstd * w0.z, bfhi(v[j].y) * rstd * w0.w);
            o.z = pkbf(bflo(v[j].z) * rstd * w1.x, bfhi(v[j].z) * rstd * w1.y); o.w = pkbf(bflo(v[j].w) * rstd * w1.z, bfhi(v[j].w) * rstd * w1.w);
            *(v4u*)(MIX + (size_t)row * 4096 + c) = o; }
    }
}
__device__ __forceinline__ void split_store8(bf16* hi, bf16* lo, const float (&v)[8]) {
    v4u h, l; unsigned hw[4], lw[4];
#pragma unroll
    for (int e = 0; e < 4; ++e) { hw[e] = pkbf(v[2 * e], v[2 * e + 1]); lw[e] = pkbf(v[2 * e] - bflo(hw[e]), v[2 * e + 1] - bfhi(hw[e])); }
    h.x = hw[0]; h.y = hw[1]; h.z = hw[2]; h.w = hw[3]; l.x = lw[0]; l.y = lw[1]; l.z = lw[2]; l.w = lw[3];
    *(v4u*)hi = h; *(v4u*)lo = l;
}
__device__ __forceinline__ void m1_prep(Frame& F) {
    int tid_ = threadIdx.x; asm volatile("" : "+v"(tid_)); const int TID = tid_;
    const int gt = F.vcu * NWAVES * 64 + TID, NT = F.G * NWAVES * 64;
    const bf16* PB = WSP(bf16, WS_BIG); const float* IDX = WSP(float, WS_IDX);
    const float* qc = WSP(float, WS_RTQ); const float* qs = qc + M * 16; const float* ic = WSP(float, WS_RTI); const float* is = ic + M * 8;
    bf16* QA = WSP(bf16, WS_QA); bf16* KAb = WSP(bf16, WS_KAB); bf16* VAb = WSP(bf16, WS_VAB);
    for (int idx = gt; idx < M * 288; idx += NT) {
        const int row = idx / 288, ch = idx % 288, hd = ch >> 4, c = ch & 15;
        const bf16* src = PB + (size_t)row * 2304 + ch * 8;
        bf16* dst = hd < 16 ? QA + (size_t)row * 2048 + ch * 8 : (hd == 16 ? KAb + (size_t)row * 128 + c * 8 : VAb + (size_t)row * 128 + c * 8);
        if (hd == 17 || c >= 4) { *(v4u*)dst = *(const v4u*)src; continue; }
        if (c >= 2) continue;
        const v4u u1 = *(const v4u*)src, u2 = *(const v4u*)(src + 16);
        const float x1[8] = {bflo(u1.x), bfhi(u1.x), bflo(u1.y), bfhi(u1.y), bflo(u1.z), bfhi(u1.z), bflo(u1.w), bfhi(u1.w)};
        const float x2[8] = {bflo(u2.x), bfhi(u2.x), bflo(u2.y), bfhi(u2.y), bflo(u2.z), bfhi(u2.z), bflo(u2.w), bfhi(u2.w)};
        float o1[8], o2[8];
#pragma unroll
        for (int e = 0; e < 8; ++e) { const float cs = qc[row * 16 + c * 8 + e], sn = qs[row * 16 + c * 8 + e]; o1[e] = x1[e] * cs - x2[e] * sn; o2[e] = x1[e] * sn + x2[e] * cs; }
        v4u w1, w2; w1.x = pkbf(o1[0], o1[1]); w1.y = pkbf(o1[2], o1[3]); w1.z = pkbf(o1[4], o1[5]); w1.w = pkbf(o1[6], o1[7]);
        w2.x = pkbf(o2[0], o2[1]); w2.y = pkbf(o2[2], o2[3]); w2.z = pkbf(o2[4], o2[5]); w2.w = pkbf(o2[6], o2[7]);
        *(v4u*)dst = w1; *(v4u*)(dst + 16) = w2;
    }
    bf16* QIH = WSP(bf16, WS_QIH); bf16* QIL = WSP(bf16, WS_QIL);
    for (int idx = gt; idx < M * 128; idx += NT) {
        const int row = idx >> 7, ch = idx & 127, c = ch & 7;
        const float* src = IDX + (size_t)row * 1280 + ch * 8;
        if (c == 1) continue;
        float v[8]; { const f32x4 a = *(const f32x4*)src, b = *(const f32x4*)(src + 4); v[0] = a.x; v[1] = a.y; v[2] = a.z; v[3] = a.w; v[4] = b.x; v[5] = b.y; v[6] = b.z; v[7] = b.w; }
        if (c == 0) { float x2[8], o2[8]; { const f32x4 a = *(const f32x4*)(src + 8), b = *(const f32x4*)(src + 12); x2[0] = a.x; x2[1] = a.y; x2[2] = a.z; x2[3] = a.w; x2[4] = b.x; x2[5] = b.y; x2[6] = b.z; x2[7] = b.w; }
#pragma unroll
            for (int e = 0; e < 8; ++e) { const float cs = ic[row * 8 + e], sn = is[row * 8 + e]; const float x1 = v[e]; v[e] = x1 * cs - x2[e] * sn; o2[e] = x1 * sn + x2[e] * cs; }
            split_store8(QIH + (size_t)row * 1024 + ch * 8 + 8, QIL + (size_t)row * 1024 + ch * 8 + 8, o2); }
        split_store8(QIH + (size_t)row * 1024 + ch * 8, QIL + (size_t)row * 1024 + ch * 8, v);
    }
    bf16* KIH = WSP(bf16, WS_KIH); bf16* KIL = WSP(bf16, WS_KIL); float* WI = WSP(float, WS_WI);
    for (int row = gt; row < M; row += NT) {
        const float* si = IDX + (size_t)row * 1280 + 1024;
        float ss = 0.f;
#pragma unroll 4
        for (int i = 0; i < 64; i += 4) { const f32x4 a = *(const f32x4*)(si + i); ss += (a.x * a.x + a.y * a.y) + (a.z * a.z + a.w * a.w); }
        const float rstd = rsqrtf(ss * (1.0f / 64.0f) + EPS);
#pragma unroll 1
        for (int c = 0; c < 8; ++c) { if (c == 1) continue;
            float v[8];
#pragma unroll
            for (int e = 0; e < 8; ++e) v[e] = si[c * 8 + e] * rstd * F.idx_k_norm_w[c * 8 + e];
            if (c == 0) { float o2[8];
#pragma unroll
                for (int e = 0; e < 8; ++e) { const float x2 = si[8 + e] * rstd * F.idx_k_norm_w[8 + e], cs = ic[row * 8 + e], sn = is[row * 8 + e], x1 = v[e]; v[e] = x1 * cs - x2 * sn; o2[e] = x1 * sn + x2 * cs; }
                split_store8(KIH + (size_t)row * 64 + 8, KIL + (size_t)row * 64 + 8, o2); }
            split_store8(KIH + (size_t)row * 64 + c * 8, KIL + (size_t)row * 64 + c * 8, v); }
#pragma unroll
        for (int h4 = 0; h4 < 4; ++h4) { const f32x4 a = *(const f32x4*)(IDX + (size_t)row * 1280 + 1088 + 4 * h4); *(f32x4*)(WI + (size_t)row * 16 + 4 * h4) = a * 0.03125f; }
    }
}
__device__ __forceinline__ void m1_index(Frame& F) {
    int tid_ = threadIdx.x; asm volatile("" : "+v"(tid_)); const int TID = tid_, LANE = TID & 63, WAVE = __builtin_amdgcn_readfirstlane(TID >> 6);
    const int r = LANE & 31, hh = LANE >> 5;
    LAS unsigned* sc = (LAS unsigned*)(F.lds + WAVE * 16384);
    const int gw = F.vcu * NWAVES + WAVE, NGW = F.G * NWAVES;
    const bf16* QIH = WSP(bf16, WS_QIH); const bf16* QIL = WSP(bf16, WS_QIL); const bf16* KIH = WSP(bf16, WS_KIH); const bf16* KIL = WSP(bf16, WS_KIL);
    const float* WI = WSP(float, WS_WI); int* SEL = WSP(int, WS_SEL); int* NSEL = WSP(int, WS_NSEL);
    const unsigned long long ltmask = (1ull << LANE) - 1ull;
    for (int it = 0;; ++it) {
        int pr;
        if (NGW == 2048) { if (it >= 2) break; pr = it == 0 ? gw : 4095 - gw; } else { pr = gw + it * NGW; if (pr >= 4096) break; }
        const int row0 = 2 * pr, b = row0 >> 11, qp0 = row0 & (SEQ - 1);
        if (qp0 + 1 <= 255) {
#pragma unroll 1
            for (int qq = 0; qq < 2; ++qq) { const int nv = qp0 + qq + 1; for (int i = LANE; i < nv; i += 64) SEL[(size_t)(row0 + qq) * 256 + i] = i; if (LANE == 0) NSEL[row0 + qq] = nv; }
            continue; }
        bf16x8 Ah[4], Al[4];
        { const int qq = (r >> 2) & 1, hd = (r & 3) + 4 * (r >> 3); const size_t o = (size_t)(row0 + qq) * 1024 + hd * 64 + 8 * hh;
#pragma unroll
          for (int ks = 0; ks < 4; ++ks) { Ah[ks] = *(const bf16x8*)(QIH + o + 16 * ks); Al[ks] = *(const bf16x8*)(QIL + o + 16 * ks); } }
        float wv[16];
#pragma unroll
        for (int h4 = 0; h4 < 4; ++h4) { const f32x4 a = *(const f32x4*)(WI + (size_t)(row0 + hh) * 16 + 4 * h4); wv[4 * h4] = a.x; wv[4 * h4 + 1] = a.y; wv[4 * h4 + 2] = a.z; wv[4 * h4 + 3] = a.w; }
        const int ntile = (qp0 + 1) / 32 + 1;
        bf16x8 Bh[4], Bl[4];
        { const size_t ko = ((size_t)b * SEQ + r) * 64 + 8 * hh;
#pragma unroll
          for (int ks = 0; ks < 4; ++ks) { Bh[ks] = *(const bf16x8*)(KIH + ko + 16 * ks); Bl[ks] = *(const bf16x8*)(KIL + ko + 16 * ks); } }
#pragma unroll 1
        for (int kt = 0; kt < ntile; ++kt) {
            const int ktn = (kt + 1 < ntile) ? kt + 1 : kt;
            const size_t kon = ((size_t)b * SEQ + ktn * 32 + r) * 64 + 8 * hh;
            bf16x8 Nh[4], Nl[4];
#pragma unroll
            for (int ks = 0; ks < 4; ++ks) { Nh[ks] = *(const bf16x8*)(KIH + kon + 16 * ks); Nl[ks] = *(const bf16x8*)(KIL + kon + 16 * ks); }
            f32x16 acc = zero16();
#pragma unroll
            for (int ks = 0; ks < 4; ++ks) { acc = MFMA32(Ah[ks], Bh[ks], acc); acc = MFMA32(Ah[ks], Bl[ks], acc); acc = MFMA32(Al[ks], Bh[ks], acc); }
            float s = 0.f;
#pragma unroll
            for (int i = 0; i < 16; ++i) s += fmaxf(acc[i], 0.f) * wv[i];
            s += 0.0f;
            const int key = kt * 32 + r; const unsigned uu = __float_as_uint(s); const unsigned ok = (uu & 0x80000000u) ? ~uu : (uu | 0x80000000u);
            sc[hh * 2048 + key] = (key <= qp0 + hh) ? ok : 0u;
#pragma unroll
            for (int ks = 0; ks < 4; ++ks) { Bh[ks] = Nh[ks]; Bl[ks] = Nl[ks]; }
        }
        if (ntile & 1) sc[hh * 2048 + ntile * 32 + r] = 0u;
        asm volatile("s_waitcnt lgkmcnt(0)" ::: "memory");
#pragma unroll 1
        for (int qq = 0; qq < 2; ++qq) {
            const int nv = qp0 + qq + 1, nj = (nv + 63) >> 6; const int row = row0 + qq;
            unsigned vals[32];
#pragma unroll
            for (int j = 0; j < 32; ++j) vals[j] = (j < nj) ? sc[qq * 2048 + j * 64 + LANE] : 0u;
            unsigned prefix = 0u; bool exact = false;
#pragma unroll 1
            for (int bit = 31; bit >= 0; --bit) { const unsigned cand = prefix | (1u << bit); int cnt = 0;
#pragma unroll
                for (int j = 0; j < 32; ++j) cnt += __popcll(__ballot(vals[j] >= cand));
                if (cnt >= 256) prefix = cand;
                if (cnt == 256) { exact = true; break; } }
            const unsigned T = exact ? prefix - 1u : prefix;
            int base = 0;
#pragma unroll
            for (int j = 0; j < 32; ++j) { const bool p = vals[j] > T; const unsigned long long mk = __ballot(p);
                if (p) SEL[(size_t)row * 256 + base + __popcll(mk & ltmask)] = j * 64 + LANE; base += __popcll(mk); }
            if (!exact) { int need = 256 - base;
#pragma unroll
                for (int j = 0; j < 32; ++j) { const bool p = vals[j] == T; const unsigned long long mk = __ballot(p); const int rank = __popcll(mk & ltmask);
                    if (p && rank < need) SEL[(size_t)row * 256 + base + rank] = j * 64 + LANE;
                    const int c = __popcll(mk); const int take = c < need ? c : need; base += take; need -= take; } }
            if (LANE == 0) NSEL[row] = 256;
        }
    }
}
__device__ __forceinline__ void m1_attn(Frame& F) {
    int tid_ = threadIdx.x; asm volatile("" : "+v"(tid_)); const int TID = tid_, LANE = TID & 63, WAVE = __builtin_amdgcn_readfirstlane(TID >> 6);
    const int r_ = LANE & 31, hh_ = LANE >> 5; const IdFrag I = make_id(r_, hh_);
    const int gw = F.vcu * NWAVES + WAVE, NGW = F.G * NWAVES;
    const bf16* QA = WSP(bf16, WS_QA); const bf16* KAb = WSP(bf16, WS_KAB); const bf16* VAb = WSP(bf16, WS_VAB); const int* SEL = WSP(int, WS_SEL); const int* NSEL = WSP(int, WS_NSEL); bf16* MIX = WSP(bf16, WS_MIX);
#pragma unroll 1
    for (int q = gw; q < M; q += NGW) {
        int r = r_, hh = hh_; asm volatile("" : "+v"(r), "+v"(hh));
        const int b = q >> 11, nsel = NSEL[q], ntile = (nsel + 31) >> 5;
        bf16x8 qf[8];
#pragma unroll
        for (int ks = 0; ks < 8; ++ks) qf[ks] = *(const bf16x8*)(QA + (size_t)q * 2048 + (r & 15) * 128 + 16 * ks + 8 * hh);
        float mx = -3.0e38f, sum = 0.f;
        f32x16 o[4];
#pragma unroll
        for (int dt = 0; dt < 4; ++dt) o[dt] = zero16();
#pragma unroll 1
        for (int kt = 0; kt < ntile; ++kt) {
            const int sid = (kt * 32 + r < nsel) ? SEL[(size_t)q * 256 + kt * 32 + r] : 0;
            const bf16* kp = KAb + ((size_t)b * SEQ + sid) * 128 + 8 * hh;
            const bf16* vp = VAb + ((size_t)b * SEQ + sid) * 128 + 8 * hh;
            f32x16 L = zero16();
#pragma unroll
            for (int ks = 0; ks < 8; ++ks) L = MFMA32(*(const bf16x8*)(kp + 16 * ks), qf[ks], L);
            float tm = -3.0e38f;
#pragma unroll
            for (int i = 0; i < 16; ++i) { L[i] = (kt * 32 + crow(i, hh) < nsel) ? L[i] * 0.08838834764831845f : -3.0e38f; tm = fmaxf(tm, L[i]); }
            tm = fmaxf(tm, __shfl_xor(tm, 32));
            const float mn = fmaxf(mx, tm), alpha = __expf(mx - mn); mx = mn;
            float ts = 0.f;
#pragma unroll
            for (int i = 0; i < 16; ++i) { const float e = __expf(L[i] - mn); L[i] = e; ts += e; }
            sum = sum * alpha + ts;
#pragma unroll
            for (int i = 0; i < 8; ++i) { const float ah = __shfl(alpha, crow(i, hh));
#pragma unroll
                for (int dt = 0; dt < 4; ++dt) o[dt][i] *= ah; }
            const bf16x8 P0 = pack8<0>(L), P1 = pack8<1>(L);
#pragma unroll
            for (int dt = 0; dt < 4; ++dt) { f32x16 xv = MFMA32(*(const bf16x8*)(vp + dt * 32), I.f0, zero16()); xv = MFMA32(*(const bf16x8*)(vp + dt * 32 + 16), I.f1, xv);
                o[dt] = MFMA32(P0, pack8<0>(xv), o[dt]); o[dt] = MFMA32(P1, pack8<1>(xv), o[dt]); }
        }
        sum += __shfl_xor(sum, 32);
        const float inv = 1.0f / sum;
#pragma unroll
        for (int i = 0; i < 8; ++i) { const int head = crow(i, hh); const float ih = __shfl(inv, head);
#pragma unroll
            for (int dt = 0; dt < 4; ++dt) { const float v = o[dt][i] * ih; MIX[(size_t)q * 2048 + head * 128 + dt * 32 + r] = (bf16)(pkbf(v, v) & 0xffffu); } }
    }
}
struct Args { const void* in[21]; float* out; unsigned char* ws; int ph_lo, ph_hi; };
__global__ void __launch_bounds__(NWAVES * 64, 2) mk_fwd(Args args) {
    extern __shared__ __attribute__((aligned(16))) unsigned char lds_raw[];
    Frame F;
    F.lds = (LAS unsigned char*)lds_raw;
    F.G = gridDim.x; { const int bx = blockIdx.x; F.vcu = (F.G % 8 == 0) ? (bx % 8) * (F.G / 8) + bx / 8 : bx; }
    F.x = (const float*)args.in[0]; F.c = (const float*)args.in[1]; F.positions = (const int*)args.in[2]; F.mod_w = (const float*)args.in[3]; F.mod_b = (const float*)args.in[4];
    F.norm_w = (const float*)args.in[5]; F.w_gate = (const float*)args.in[6]; F.w_up = (const float*)args.in[7]; F.w_down = (const float*)args.in[8]; F.hy_w_in = (const float*)args.in[9];
    F.conv_w = (const float*)args.in[10]; F.conv_b = (const float*)args.in[11]; F.A_log = (const float*)args.in[12]; F.dt_bias = (const float*)args.in[13]; F.ssd_D = (const float*)args.in[14];
    F.ssd_norm_w = (const float*)args.in[15]; F.ret_norm_w = (const float*)args.in[16]; F.hy_w_out = (const float*)args.in[17]; F.dsa_w_in = (const float*)args.in[18];
    F.idx_k_norm_w = (const float*)args.in[19]; F.dsa_w_out = (const float*)args.in[20];
    F.out = args.out; F.ws = args.ws;
    const int TID = threadIdx.x;
    volatile LAS unsigned* MISC = (volatile LAS unsigned*)(F.lds + MISC_OFF);
    for (int u = TID; u < (LDS_BYTES - LDSCTL_OFF) / 4; u += NWAVES * 64) ((LAS unsigned*)(F.lds + LDSCTL_OFF))[u] = 0u;
    __syncthreads();
    const int lo = args.ph_lo, hi = args.ph_hi;
    XcdBarrier bar; bar.bar = (unsigned*)(F.ws + WS_CTL) + CW_BAR; bar.x = 0; bar.st = nullptr;
    if (hi - lo > 1) bar = xcd_barrier_post((unsigned*)(F.ws + WS_CTL) + CW_BAR, MISC + 8);
#define RUN(k) (lo <= (k) && (k) < hi)
#define REPS(i) (1 + (int)((PROBE_REP_MASK >> (i)) & 1u))
#define SEAM(k) do { if (RUN(k) && RUN((k) + 1)) xcd_barrier(bar); } while (0)
    bf16* H = WSP(bf16, WS_H); bf16* ACT = WSP(bf16, WS_BIG); bf16* PB = WSP(bf16, WS_BIG); bf16* MIX = WSP(bf16, WS_MIX); bf16* Y = WSP(bf16, WS_Y); float* SSQ = WSP(float, WS_SSQ);

    if (PON(0) && RUN(0)) for (int rep_ = 0; rep_ < REPS(0); ++rep_) { p0_prologue(F); __syncthreads(); }
    SEAM(0);
    if (PON(1) && RUN(1)) thin_phase(F, -1, 0);
    SEAM(1);
    int ph = 2, q = 0;
    for (int s = 0; s < 4; ++s) {
        if (PON(2) && RUN(ph)) for (int rep_ = 0; rep_ < REPS(2); ++rep_) { pg8::Gemm g{H, WSP(bf16, WS_WGU) + (size_t)s * WGU_ELEMS, M, 2 * FF, D}; pg8::StaticOrder S; S.init(M, 2 * FF, F.G, (int)blockIdx.x);
            pg8::EpiGateUp E{ACT, FF}; pg8::gemm_phase<pg8::EpiGateUp, pg8::StaticOrder, true, true>(F.lds, g, S, E);
            if (TAILS && rep_ == 0 && (int)blockIdx.x >= 128 && s < 3) {
                const int w = (int)blockIdx.x - 128, nw = F.G - 128;
                if (s == 0) conv_items(F, CV_GU0_LO, CV_GU0_N, w, nw);
                if (s == 1) conv_items(F, CV_GU1_LO, CV_GU1_N, w, nw);
                if (s == 2) { conv_items(F, CV_GU2A_LO, CV_GU2A_N, w, nw); conv_items(F, CV_GU2B_LO, CV_GU2B_N, w, nw); } } }
        SEAM(ph); ++ph;
        if (PON(3) && RUN(ph)) for (int rep_ = 0; rep_ < REPS(3); ++rep_) { pg8::Gemm g{ACT, WSP(bf16, WS_WD) + (size_t)s * WD_ELEMS, M, D, FF}; pg8::StaticOrder S; S.init(M, D, F.G, (int)blockIdx.x);
            pg8::EpiYSsq E{Y, D, SSQ}; pg8::gemm_phase<pg8::EpiYSsq, pg8::StaticOrder, true, true>(F.lds, g, S, E); }
        SEAM(ph); ++ph;
        if (PON(1) && RUN(ph)) thin_phase(F, q, q < 5 ? q + 1 : -1);
        SEAM(ph); ++ph; ++q;
        if (s == 0) {
            if (PON(4) && RUN(ph)) for (int rep_ = 0; rep_ < REPS(4); ++rep_) { pg8::Gemm g{H, WSP(bf16, WS_WIN0), M, IN0P, D}; pg8::StaticOrder S; S.init(M, IN0P, F.G, (int)blockIdx.x);
                pg8::EpiProj0 E{PB, IN0P, WSP(float, WS_DTB), WSP(float, WS_RTC), WSP(float, WS_RTS)}; pg8::gemm_phase<pg8::EpiProj0, pg8::StaticOrder, true, true>(F.lds, g, S, E);
                if (TAILS && rep_ == 0 && (int)blockIdx.x >= 32) { conv_items(F, CV_IN0A_LO, CV_IN0A_N, (int)blockIdx.x - 32, F.G - 32); conv_items(F, CV_IN0B_LO, CV_IN0B_N, (int)blockIdx.x - 32, F.G - 32); } }
            SEAM(ph); ++ph;
            if (PON(6) && RUN(ph)) for (int rep_ = 0; rep_ < REPS(6); ++rep_) { m0_states(F); __syncthreads(); }
            SEAM(ph); ++ph;
            if (PON(14) && RUN(ph)) for (int rep_ = 0; rep_ < REPS(14); ++rep_) { m0_chunkscan(F); __syncthreads(); }
            SEAM(ph); ++ph;
            if (PON(15) && RUN(ph)) for (int rep_ = 0; rep_ < REPS(15); ++rep_) { if (rep_ == 0) { m0_out_ssd(F, 0); m0_out_ret(F, 0); } else { if (PROBE_OUT_SEL != 2) m0_out_ssd(F, PROBE_DBG); if (PROBE_OUT_SEL != 1) m0_out_ret(F, PROBE_DBG); } }
            SEAM(ph); ++ph;
            if (PON(7) && RUN(ph)) m0_post(F);
            SEAM(ph); ++ph;
            if (PON(8) && RUN(ph)) for (int rep_ = 0; rep_ < REPS(8); ++rep_) { pg8::Gemm g{MIX, WSP(bf16, WS_WOUT0), M, D, 2 * D}; pg8::StaticOrder S; S.init(M, D, F.G, (int)blockIdx.x);
                pg8::EpiYSsq E{Y, D, SSQ}; pg8::gemm_phase<pg8::EpiYSsq, pg8::StaticOrder, true, true>(F.lds, g, S, E); }
            SEAM(ph); ++ph;
            if (PON(1) && RUN(ph)) thin_phase(F, q, q + 1);
            SEAM(ph); ++ph; ++q;
        }
        if (s == 2) {
            if (PON(9) && RUN(ph)) for (int rep_ = 0; rep_ < REPS(9); ++rep_) { pg8::Gemm g{H, WSP(bf16, WS_WIN1), M, IN1P, D}; pg8::StaticOrder S; S.init(M, IN1P, F.G, (int)blockIdx.x);
                pg8::EpiProj E{PB, 2304, 9, WSP(float, WS_IDX), 1280}; pg8::gemm_phase<pg8::EpiProj, pg8::StaticOrder, true, true>(F.lds, g, S, E);
                if (TAILS && rep_ == 0 && (int)blockIdx.x >= 192) conv_items(F, CV_IN1_LO, CV_IN1_N, (int)blockIdx.x - 192, F.G - 192); }
            SEAM(ph); ++ph;
            if (PON(10) && RUN(ph)) for (int rep_ = 0; rep_ < REPS(10); ++rep_) { m1_prep(F); __syncthreads(); }
            SEAM(ph); ++ph;
            if (PON(11) && RUN(ph)) for (int rep_ = 0; rep_ < REPS(11); ++rep_) { m1_index(F); __syncthreads(); }
            SEAM(ph); ++ph;
            if (PON(12) && RUN(ph)) for (int rep_ = 0; rep_ < REPS(12); ++rep_) { m1_attn(F); __syncthreads(); }
            SEAM(ph); ++ph;
            if (PON(13) && RUN(ph)) for (int rep_ = 0; rep_ < REPS(13); ++rep_) { pg8::Gemm g{MIX, WSP(bf16, WS_WOUT1), M, D, D}; pg8::StaticOrder S; S.init(M, D, F.G, (int)blockIdx.x);
                pg8::EpiYSsq E{Y, D, SSQ}; pg8::gemm_phase<pg8::EpiYSsq, pg8::StaticOrder, true, true>(F.lds, g, S, E); }
            SEAM(ph); ++ph;
            if (PON(1) && RUN(ph)) thin_phase(F, q, q + 1);
            SEAM(ph); ++ph; ++q;
        }
    }
#undef RUN
#undef SEAM
}

extern "C" void kernel_launch(void* const* d_in, const int* in_sizes, int n_in, void* d_out, int out_size, void* d_ws, size_t ws_size, hipStream_t stream) {
    static int grid = 0;
    if (grid == 0) {
        if (n_in != 21 || out_size != M * D || ws_size < WS_END) { fprintf(stderr, "kernel_launch: unexpected shapes (n_in %d, out %d, ws %zu < %zu)\n", n_in, out_size, ws_size, (size_t)WS_END); grid = -1; return; }
        int dev = 0, cus = 0, per_cu = 0;
        if (hipGetDevice(&dev) != hipSuccess || hipDeviceGetAttribute(&cus, hipDeviceAttributeMultiprocessorCount, dev) != hipSuccess) { grid = -1; return; }
        if (hipFuncSetAttribute((const void*)mk_fwd, hipFuncAttributeMaxDynamicSharedMemorySize, LDS_BYTES) != hipSuccess) { fprintf(stderr, "kernel_launch: hipFuncSetAttribute failed\n"); grid = -1; return; }
        if (hipOccupancyMaxActiveBlocksPerMultiprocessor(&per_cu, (const void*)mk_fwd, NWAVES * 64, LDS_BYTES) != hipSuccess || per_cu < 1) { fprintf(stderr, "kernel_launch: occupancy query says %d\n", per_cu); }
        (void)hipGetLastError();
        grid = cus;
    }
    if (grid < 0) return;
    (void)hipMemsetAsync((char*)d_ws + WS_CTL, 0, CTL_ZERO_BYTES, stream);
    Args a{};
    for (int i = 0; i < 21; ++i) a.in[i] = d_in[i];
    a.out = (float*)d_out; a.ws = (unsigned char*)d_ws;
#if MK_LAUNCH_PER_PHASE
    for (int p = 0; p < NPH; ++p) { a.ph_lo = p; a.ph_hi = p + 1; hipLaunchKernelGGL(mk_fwd, dim3(grid), dim3(NWAVES * 64), LDS_BYTES, stream, a); }
#else
    a.ph_lo = 0; a.ph_hi = NPH; hipLaunchKernelGGL(mk_fwd, dim3(grid), dim3(NWAVES * 64), LDS_BYTES, stream, a);
#endif
}
```
